# Optimizing an MI355X kernel written in HIP

```python
import math
import jax
import jax.numpy as jnp
from jax import lax
import numpy as np

D_MODEL = 4096
BATCH = 2
SEQ = 8192
DEPTH = 2

MEM_LEN = 256
N_MIXERS = 2
N_POOL_LAYERS = (DEPTH + N_MIXERS - 1) // N_MIXERS
N_NSA_LAYERS = DEPTH // N_MIXERS

POOL_WINDOWS = (2, 4, 8, 16)
POOL_GROUPS = len(POOL_WINDOWS)
POOL_GC = D_MODEL // POOL_GROUPS

HEAD_DIM = 128
NSA_HEADS = D_MODEL // HEAD_DIM
NSA_KV_GROUPS = 4
NSA_HPG = NSA_HEADS // NSA_KV_GROUPS
NSA_BRANCHES = 3
CMP_LEN = 32
CMP_STRIDE = 16
CMP_HIDDEN = 512
SEL_BLOCK = 64
N_SELECT = 16
WINDOW = 512
NSA_Q_BLOCK = 64
Q_WIDTH = NSA_HEADS * HEAD_DIM
KV_WIDTH = NSA_BRANCHES * 2 * NSA_KV_GROUPS * HEAD_DIM
GATE_WIDTH = NSA_BRANCHES * NSA_HEADS
NSA_IN_WIDTH = Q_WIDTH + KV_WIDTH + GATE_WIDTH
FORCED_SCORE = 1e6

XA_HEADS = 4
XA_WIDTH = XA_HEADS * HEAD_DIM

D_FF = 11008
CONV_WIDTH = 3

RMS_EPS = 1e-6
NEG_BIG = -1e30

kernel_name = "hybrid_pool_nsa_memxattn_convffn"


def rmsnorm(x, g):
    xf = x.astype(jnp.float32)
    y = xf * lax.rsqrt(jnp.mean(xf * xf, axis=-1, keepdims=True) + RMS_EPS)
    return (y * g.astype(jnp.float32)).astype(x.dtype)


def alibi_slopes(n):
    return 2.0 ** (-8.0 * jnp.arange(1, n + 1, dtype=jnp.float32) / n)


def masked_softmax(s, mask):
    s = jnp.where(mask, s, NEG_BIG)
    m = jnp.max(s, axis=-1, keepdims=True)
    e = jnp.exp(s - m) * mask
    return e / jnp.maximum(jnp.sum(e, axis=-1, keepdims=True), 1e-30)


def pool_mixer(h, w, scale):
    B, S, D = h.shape
    hf = h.astype(jnp.float32)
    csum = jnp.cumsum(hf, axis=1)
    t1 = jnp.arange(1, S + 1, dtype=jnp.float32)
    parts = []
    for g, win in enumerate(POOL_WINDOWS):
        c = csum[..., g * POOL_GC:(g + 1) * POOL_GC]
        c_prev = jnp.pad(c, ((0, 0), (win, 0), (0, 0)))[:, :S]
        cnt = jnp.minimum(t1, float(win))
        parts.append((c - c_prev) / cnt[None, :, None])
    pooled = jnp.concatenate(parts, axis=-1)
    d = (pooled - hf).astype(h.dtype).reshape(B, S, POOL_GROUPS, POOL_GC)
    y = jnp.einsum('bsgc,gcd->bsgd', d, w).reshape(B, S, D)
    return y * scale


def compress_blocks(raw, pos, w1, b1, w2):
    B, S, G, dh = raw.shape
    ratio = CMP_LEN // CMP_STRIDE
    nch = S // CMP_STRIDE
    nc = nch - ratio + 1
    chunks = raw.reshape(B, nch, CMP_STRIDE, G, dh)
    blocks = jnp.concatenate([chunks[:, r:r + nc] for r in range(ratio)], axis=2)
    blocks = blocks + pos[None, None, :, None, :]
    flat = blocks.transpose(0, 1, 3, 2, 4).reshape(B, nc, G, CMP_LEN * dh)
    hid = jax.nn.gelu(flat @ w1 + b1)
    return hid @ w2


def nsa_mixer(h, w_in, w_out, cmp_pos, cmp_w1, cmp_b1, cmp_w2):
    B, S, _ = h.shape
    G, J, dh = NSA_KV_GROUPS, NSA_HPG, HEAD_DIM
    proj = h @ w_in
    q = proj[..., :Q_WIDTH].reshape(B, S, G, J, dh)
    kv = proj[..., Q_WIDTH:Q_WIDTH + KV_WIDTH].reshape(B, S, NSA_BRANCHES, 2, G, dh)
    gates = jax.nn.sigmoid(proj[..., Q_WIDTH + KV_WIDTH:].astype(jnp.float32)).reshape(B, S, NSA_BRANCHES, G, J)

    k_cmp = compress_blocks(kv[:, :, 0, 0], cmp_pos[0], cmp_w1[0], cmp_b1[0], cmp_w2[0])
    v_cmp = compress_blocks(kv[:, :, 0, 1], cmp_pos[1], cmp_w1[1], cmp_b1[1], cmp_w2[1])
    nc = k_cmp.shape[1]
    ns = S // SEL_BLOCK
    n_top = min(N_SELECT, ns)
    k_sel = kv[:, :, 1, 0].reshape(B, ns, SEL_BLOCK, G, dh).transpose(0, 3, 1, 2, 4)
    v_sel = kv[:, :, 1, 1].reshape(B, ns, SEL_BLOCK, G, dh).transpose(0, 3, 1, 2, 4)
    k_win = jnp.pad(kv[:, :, 2, 0], ((0, 0), (WINDOW, 0), (0, 0), (0, 0)))
    v_win = jnp.pad(kv[:, :, 2, 1], ((0, 0), (WINDOW, 0), (0, 0), (0, 0)))

    slope_b = alibi_slopes(NSA_HEADS).reshape(G, J)[None, :, :, None, None]
    scale = HEAD_DIM ** -0.5
    cmp_start = jnp.arange(nc) * CMP_STRIDE
    cmp_end = (cmp_start + CMP_LEN - 1).astype(jnp.float32)
    sel_start = jnp.arange(ns) * SEL_BLOCK
    overlap = ((cmp_start[:, None] < sel_start[None, :] + SEL_BLOCK)
               & (cmp_start[:, None] + CMP_LEN > sel_start[None, :])).astype(jnp.float32)
    blk_ids = jnp.arange(ns)
    bi = jnp.arange(B)[:, None, None, None]
    gi = jnp.arange(G)[None, :, None, None]
    sel_off = jnp.arange(SEL_BLOCK)
    win_off = jnp.arange(WINDOW + NSA_Q_BLOCK)
    QB = NSA_Q_BLOCK

    def block(qb):
        start = qb * QB
        t = start + jnp.arange(QB)
        tf = t.astype(jnp.float32)
        q_blk = lax.dynamic_slice_in_dim(q, start, QB, axis=1)
        g_blk = lax.dynamic_slice_in_dim(gates, start, QB, axis=1)
        d_c = tf[:, None] - cmp_end[None, :]
        s_c = jnp.einsum('bqgjd,bcgd->bgjqc', q_blk, k_cmp).astype(jnp.float32) * scale - slope_b * d_c
        p_c = masked_softmax(s_c, d_c >= 0)
        o_c = jnp.einsum('bgjqc,bcgd->bqgjd', p_c.astype(v_cmp.dtype), v_cmp)
        score = jnp.einsum('bgqc,cn->bgqn', jnp.sum(p_c, axis=2), overlap)
        cur = t // SEL_BLOCK
        forced = (blk_ids[None, :] == 0) | (blk_ids[None, :] == cur[:, None]) | (blk_ids[None, :] == cur[:, None] - 1)
        future = blk_ids[None, :] > cur[:, None]
        score = jnp.where(future, -1.0, jnp.where(forced, FORCED_SCORE, score))
        _, idx = lax.top_k(score, n_top)
        kg = k_sel[bi, gi, idx].reshape(B, G, QB, n_top * SEL_BLOCK, dh)
        vg = v_sel[bi, gi, idx].reshape(B, G, QB, n_top * SEL_BLOCK, dh)
        pos = (idx[..., None] * SEL_BLOCK + sel_off).reshape(B, G, QB, n_top * SEL_BLOCK)
        d_s = (t[None, None, :, None] - pos).astype(jnp.float32)[:, :, None]
        s_s = jnp.einsum('bqgjd,bgqkd->bgjqk', q_blk, kg).astype(jnp.float32) * scale - slope_b * d_s
        p_s = masked_softmax(s_s, d_s >= 0)
        o_s = jnp.einsum('bgjqk,bgqkd->bqgjd', p_s.astype(vg.dtype), vg)
        kw = lax.dynamic_slice_in_dim(k_win, start, WINDOW + QB, axis=1)
        vw = lax.dynamic_slice_in_dim(v_win, start, WINDOW + QB, axis=1)
        pos_w = start - WINDOW + win_off
        d_w = t[:, None] - pos_w[None, :]
        mask_w = (d_w >= 0) & (d_w < WINDOW) & (pos_w[None, :] >= 0)
        s_w = jnp.einsum('bqgjd,bkgd->bgjqk', q_blk, kw).astype(jnp.float32) * scale - slope_b * d_w.astype(jnp.float32)
        p_w = masked_softmax(s_w, mask_w)
        o_w = jnp.einsum('bgjqk,bkgd->bqgjd', p_w.astype(vw.dtype), vw)
        g = g_blk[..., None]
        o = g[:, :, 0] * o_c + g[:, :, 1] * o_s + g[:, :, 2] * o_w
        return o.astype(h.dtype)

    o = lax.map(block, jnp.arange(S // QB))
    o = o.transpose(1, 0, 2, 3, 4, 5).reshape(B, S, Q_WIDTH)
    return o @ w_out


def mem_cross_attn(h, memn, wq, wkv, wo):
    B, S, _ = h.shape
    M = memn.shape[1]
    q = (h @ wq).reshape(B, S, XA_HEADS, HEAD_DIM)
    kv = (memn @ wkv).reshape(B, M, 2, XA_HEADS, HEAD_DIM)
    k, v = kv[:, :, 0], kv[:, :, 1]
    s = jnp.einsum('bshd,bmhd->bhsm', q, k).astype(jnp.float32) * (HEAD_DIM ** -0.5)
    p = jax.nn.softmax(s, axis=-1)
    o = jnp.einsum('bhsm,bmhd->bshd', p.astype(v.dtype), v).reshape(B, S, XA_WIDTH)
    return o @ wo


def conv_ffn(h, w_gu, conv_w, conv_b, w_down):
    gu = h @ w_gu
    gate, up = gu[..., :D_FF], gu[..., D_FF:]
    gp = jnp.pad(gate, ((0, 0), (CONV_WIDTH - 1, 0), (0, 0)))
    gate = conv_w[0] * gp[:, :-2] + conv_w[1] * gp[:, 1:-1] + conv_w[2] * gp[:, 2:] + conv_b
    return (jax.nn.silu(gate) * up) @ w_down


def setup_inputs(seed: int = 0) -> dict:
    key = jax.random.key(seed)
    ks = jax.random.split(key, 24)
    f32 = jnp.float32

    def nrm(k, shape, s):
        return jax.random.normal(k, shape, f32) * s

    return {
        "x": nrm(ks[0], (BATCH, SEQ, D_MODEL), 1.0),
        "mem": nrm(ks[1], (BATCH, MEM_LEN, D_MODEL), 1.0),
        "ln_mix": 1.0 + nrm(ks[2], (DEPTH, 2, D_MODEL), 0.05),
        "ln_xa": 1.0 + nrm(ks[3], (DEPTH, 2, D_MODEL), 0.05),
        "ln_ffn": 1.0 + nrm(ks[4], (DEPTH, 2, D_MODEL), 0.05),
        "mem_norm": 1.0 + nrm(ks[5], (D_MODEL,), 0.05),
        "pool_w": nrm(ks[6], (N_POOL_LAYERS, POOL_GROUPS, POOL_GC, POOL_GC), POOL_GC ** -0.5),
        "pool_scale": 1.0 + nrm(ks[7], (N_POOL_LAYERS, D_MODEL), 0.1),
        "nsa_w_in": nrm(ks[8], (N_NSA_LAYERS, D_MODEL, NSA_IN_WIDTH), D_MODEL ** -0.5),
        "nsa_w_out": nrm(ks[9], (N_NSA_LAYERS, Q_WIDTH, D_MODEL), Q_WIDTH ** -0.5),
        "nsa_cmp_pos": nrm(ks[10], (N_NSA_LAYERS, 2, CMP_LEN, HEAD_DIM), 0.5),
        "nsa_cmp_w1": nrm(ks[11], (N_NSA_LAYERS, 2, CMP_LEN * HEAD_DIM, CMP_HIDDEN), (CMP_LEN * HEAD_DIM) ** -0.5),
        "nsa_cmp_b1": nrm(ks[12], (N_NSA_LAYERS, 2, CMP_HIDDEN), 0.01),
        "nsa_cmp_w2": nrm(ks[13], (N_NSA_LAYERS, 2, CMP_HIDDEN, HEAD_DIM), CMP_HIDDEN ** -0.5),
        "xa_wq": nrm(ks[14], (DEPTH, D_MODEL, XA_WIDTH), D_MODEL ** -0.5),
        "xa_wkv": nrm(ks[15], (DEPTH, D_MODEL, 2 * XA_WIDTH), D_MODEL ** -0.5),
        "xa_wo": nrm(ks[16], (DEPTH, XA_WIDTH, D_MODEL), XA_WIDTH ** -0.5),
        "ffn_w_gu": nrm(ks[17], (DEPTH, D_MODEL, 2 * D_FF), D_MODEL ** -0.5),
        "ffn_conv_w": nrm(ks[18], (DEPTH, CONV_WIDTH, D_FF), CONV_WIDTH ** -0.5),
        "ffn_conv_b": nrm(ks[19], (DEPTH, D_FF), 0.01),
        "ffn_w_down": nrm(ks[20], (DEPTH, D_FF, D_MODEL), D_FF ** -0.5),
    }


def reference(x, mem, ln_mix, ln_xa, ln_ffn, mem_norm, pool_w, pool_scale, nsa_w_in, nsa_w_out,
              nsa_cmp_pos, nsa_cmp_w1, nsa_cmp_b1, nsa_cmp_w2, xa_wq, xa_wkv, xa_wo,
              ffn_w_gu, ffn_conv_w, ffn_conv_b, ffn_w_down):
    memn = rmsnorm(mem, mem_norm)
    h = x
    for i in range(DEPTH):
        j = i // N_MIXERS
        a = rmsnorm(h, ln_mix[i, 0])
        if i % N_MIXERS == 0:
            a = pool_mixer(a, pool_w[j], pool_scale[j])
        else:
            a = nsa_mixer(a, nsa_w_in[j], nsa_w_out[j], nsa_cmp_pos[j], nsa_cmp_w1[j],
                          nsa_cmp_b1[j], nsa_cmp_w2[j])
        h = h + rmsnorm(a, ln_mix[i, 1])
        c = mem_cross_attn(rmsnorm(h, ln_xa[i, 0]), memn, xa_wq[i], xa_wkv[i], xa_wo[i])
        h = h + rmsnorm(c, ln_xa[i, 1])
        f = conv_ffn(rmsnorm(h, ln_ffn[i, 0]), ffn_w_gu[i], ffn_conv_w[i], ffn_conv_b[i], ffn_w_down[i])
        h = h + rmsnorm(f, ln_ffn[i, 1])
    return h
```

```cpp
#include <hip/hip_runtime.h>
#include <cstdio>
#include <cstdint>

#ifndef MK_N_LAUNCHES
#define MK_N_LAUNCHES 1
#endif

#define GAS __attribute__((address_space(1)))
#define LAS __attribute__((address_space(3)))
typedef unsigned short bf16_t;
typedef short bf16x8 __attribute__((ext_vector_type(8)));
typedef short s16x4 __attribute__((ext_vector_type(4)));
typedef float f32x4 __attribute__((ext_vector_type(4)));
typedef float f32x2 __attribute__((ext_vector_type(2)));
typedef float f32x16 __attribute__((ext_vector_type(16)));
typedef unsigned u32x4 __attribute__((ext_vector_type(4)));
typedef unsigned u32x2 __attribute__((ext_vector_type(2)));

constexpr int NWAVES = 8, NTHR = 512;
constexpr int BATCH = 2, SEQ = 8192, DM = 4096, MTOK = BATCH * SEQ;
constexpr int MEMLEN = 256, MMEM = BATCH * MEMLEN;
constexpr int PGC = 1024;
constexpr int HD = 128, NSA_G = 4, NSA_J = 8;
constexpr int QW = 4096, KVW = 3072, GW_ = 96, NSA_INW = QW + KVW + GW_;
constexpr int NSA_INP = 7424;
constexpr int CMP_HID = 512, NCMP = 511, NSEL = 128;
constexpr int XAW = 512;
constexpr int DFF = 11008, DFF2 = 22016;
constexpr float RMS_EPS = 1e-6f;
constexpr float LOG2E = 1.4426950408889634f;
constexpr float QK_C2 = 1.4426950408889634f * 0.08838834764831845f;

constexpr size_t MiB = 1u << 20;
constexpr size_t WS_CTL = 0, CTL_ZERO_BYTES = 1 * MiB;
constexpr size_t WS_POOLW = 1 * MiB;
constexpr size_t WS_NSAIN = 9 * MiB;
constexpr size_t WS_NSAOUT = 67 * MiB;
constexpr size_t WS_CMPW1 = 99 * MiB;
constexpr size_t WS_CMPW2 = 107 * MiB;
constexpr size_t WS_XAQ = 108 * MiB;
constexpr size_t WS_XAKV = 116 * MiB;
constexpr size_t WS_XAO = 132 * MiB;
constexpr size_t WS_WGU = 140 * MiB;
constexpr size_t WS_WDN = 484 * MiB;
constexpr size_t WS_HN = 656 * MiB;
constexpr size_t WS_Y = 784 * MiB;
constexpr size_t WS_SSP = 912 * MiB;
constexpr size_t WS_XR = 916 * MiB;
constexpr size_t WS_RS = 916 * MiB + 256 * 1024;
constexpr size_t WS_CMPB = 916 * MiB + 512 * 1024;
constexpr size_t WS_MEMN = 917 * MiB;
constexpr size_t WS_KVMEM = 921 * MiB;
constexpr size_t WS_QX = 923 * MiB;
constexpr size_t WS_OX = 939 * MiB;
constexpr size_t WS_GU = 955 * MiB;
constexpr size_t WS_ACT = 1643 * MiB;
constexpr size_t WS_NQ = 1987 * MiB;
constexpr size_t WS_NKV = 2115 * MiB;
constexpr size_t WS_GATES = 2212 * MiB;
constexpr size_t WS_HID = 2218 * MiB;
constexpr size_t WS_KVC = 2226 * MiB;
constexpr size_t WS_NO = 2228 * MiB;
constexpr size_t WS_STASH = 2356 * MiB;
constexpr size_t WS_HALO = 2420 * MiB;
constexpr size_t WS_EDGE = 2426 * MiB;
constexpr size_t WS_END = 2438 * MiB;
constexpr int CW_BAR = 4096;

constexpr int RING_BYTES = 131072;
constexpr int LDSCTL_OFF = RING_BYTES, MISC_OFF = LDSCTL_OFF + 320;
constexpr int XCH_OFF = LDSCTL_OFF + 1024;
constexpr int LDS_BYTES = 147456;

#define LDS_WAIT() asm volatile("s_waitcnt lgkmcnt(0)" ::: "memory")
#define VM_WAIT() asm volatile("s_waitcnt vmcnt(0)" ::: "memory")
__device__ __forceinline__ unsigned cvtpk(float lo, float hi) { unsigned r; asm volatile("v_cvt_pk_bf16_f32 %0, %1, %2" : "=v"(r) : "v"(lo), "v"(hi)); return r; }
__device__ __forceinline__ float bflo(unsigned w) { return __uint_as_float(w << 16); }
__device__ __forceinline__ float bfhi(unsigned w) { return __uint_as_float(w & 0xffff0000u); }
__device__ __forceinline__ int otid() { int t; asm volatile("v_mov_b32 %0, %1" : "=v"(t) : "v"((int)threadIdx.x)); return t; }
__device__ __forceinline__ float wave_sum(float v) {
#pragma unroll
    for (int o = 1; o < 64; o <<= 1) v += __shfl_xor(v, o);
    return v;
}
#define DPPF(v, ctrl) __int_as_float(__builtin_amdgcn_update_dpp(__float_as_int(v), __float_as_int(v), (ctrl), 0xF, 0xF, false))
__device__ __forceinline__ float wave_max(float v) {
    v = fmaxf(v, DPPF(v, 0xB1)); v = fmaxf(v, DPPF(v, 0x4E)); v = fmaxf(v, DPPF(v, 0x141)); v = fmaxf(v, DPPF(v, 0x140));
    v = fmaxf(v, DPPF(v, 0x142)); v = fmaxf(v, DPPF(v, 0x143));
    return __int_as_float(__builtin_amdgcn_readlane(__float_as_int(v), 63));
}
__device__ __forceinline__ float sigmoidf_(float x) { return __builtin_amdgcn_rcpf(1.0f + __builtin_amdgcn_exp2f(-x * LOG2E)); }
__device__ __forceinline__ float gelu_tanh(float x) { const float u = 0.7978845608028654f * (x + 0.044715f * x * x * x); return x * __builtin_amdgcn_rcpf(1.0f + __builtin_amdgcn_exp2f(-2.0f * LOG2E * u)); }

#define XB_TMO      128
#define XB_XCNT(j)  (256  + 64 * (j))
#define XB_XSUB(j)  (1280 + 64 * (j))
#define XB_XGEN(j)  (2304 + 64 * (j))
#define XB_TOP      3328
#define XB_TOPGEN   3392
#define XCD_BAR_WORDS 3456
#define XB_SPIN_CAP (1u << 18)
__device__ __forceinline__ unsigned xb_ld(unsigned* p)              { return __hip_atomic_load(p, __ATOMIC_RELAXED, __HIP_MEMORY_SCOPE_AGENT); }
__device__ __forceinline__ unsigned xb_add(unsigned* p, unsigned v) { return __hip_atomic_fetch_add(p, v, __ATOMIC_RELAXED, __HIP_MEMORY_SCOPE_AGENT); }
__device__ __forceinline__ unsigned xb_xcc_id() { return (unsigned)__builtin_amdgcn_s_getreg((3 << 11) | 20) & 0xFu; }
#define XB_SPIN(cond, bar) do { unsigned _sp = 0; while (cond) { __builtin_amdgcn_s_sleep(1); \
    if ((++_sp & 255u) == 0u) { if (xb_ld(&(bar)[XB_TMO])) break; if (_sp > XB_SPIN_CAP) { atomicAdd(&(bar)[XB_TMO], 1u); break; } } } } while (0)
struct XcdBarrier { unsigned* bar; unsigned x; volatile LAS unsigned* st; };
__device__ __forceinline__ XcdBarrier xcd_barrier_post(unsigned* bar, volatile LAS unsigned* st) {
    XcdBarrier b; b.bar = bar; b.x = xb_xcc_id(); b.st = st;
    if (threadIdx.x == 0) (void)xb_add(&bar[XB_XCNT(b.x)], 1u);
    return b;
}
__device__ __forceinline__ void xcd_barrier_complete(unsigned* bar, unsigned x, unsigned& nloc, unsigned& nx) {
    const unsigned G = gridDim.x * gridDim.y * gridDim.z;
    unsigned sum, cnt, mine, sp = 0u;
    for (;;) {
        sum = 0u; cnt = 0u; mine = 0u;
#pragma unroll
        for (unsigned j = 0; j < 16; ++j) { const unsigned c = xb_ld(&bar[XB_XCNT(j)]); sum += c; cnt += (c > 0u) ? 1u : 0u; mine = (j == x) ? c : mine; }
        if (sum == G) break;
        __builtin_amdgcn_s_sleep(1);
        if ((++sp & 255u) == 0u) { if (xb_ld(&bar[XB_TMO])) break; if (sp > XB_SPIN_CAP) { atomicAdd(&bar[XB_TMO], 1u); break; } }
    }
    nloc = mine > 0u ? mine : 1u; nx = cnt > 0u ? cnt : 1u;
}
__device__ __forceinline__ void xcd_barrier(const XcdBarrier& b) {
    asm volatile("s_waitcnt vmcnt(0)" ::: "memory");
    __syncthreads();
    if (threadIdx.x == 0) {
        unsigned* bar = b.bar;
        __builtin_amdgcn_s_waitcnt(0);
        unsigned nloc = b.st[0], nx = b.st[1];
        if (nloc == 0u) { xcd_barrier_complete(bar, b.x, nloc, nx); b.st[0] = nloc; b.st[1] = nx; }
        const unsigned old = xb_add(&bar[XB_XSUB(b.x)], 1u);
        const unsigned gen = old / nloc;
        if (old + 1u == (gen + 1u) * nloc) {
            __builtin_amdgcn_fence(__ATOMIC_RELEASE, "agent");
            asm volatile("s_waitcnt vmcnt(0)" ::: "memory");
            const unsigned og = xb_add(&bar[XB_TOP], 1u);
            const unsigned tg = og / nx;
            if (og + 1u == (tg + 1u) * nx) xb_add(&bar[XB_TOPGEN], 1u);
            else XB_SPIN(xb_ld(&bar[XB_TOPGEN]) == tg, bar);
            __builtin_amdgcn_fence(__ATOMIC_ACQUIRE, "agent");
            xb_add(&bar[XB_XGEN(b.x)], 1u);
            asm volatile("s_waitcnt vmcnt(0)" ::: "memory");
        } else {
            XB_SPIN(xb_ld(&bar[XB_XGEN(b.x)]) == gen, bar);
            __builtin_amdgcn_fence(__ATOMIC_ACQUIRE, "agent");
            asm volatile("s_waitcnt vmcnt(0)" ::: "memory");
        }
    }
    __syncthreads();
}

namespace pg8 {
constexpr int BM = 256, BK = 64, HALF = 128, HTB = HALF * BK * 2, STAGE_BYTES = 8 * HTB, NXCD = 8, WGM = 8;
__host__ __device__ __forceinline__ int lds_byte(int r, int c) { const int st = (r >> 4) * 2 + (c >> 5), rr = r & 15, cc = c & 31, ob = rr * 64 + cc * 2; return st * 1024 + (ob ^ (((ob >> 9) & 1) << 5)); }
__host__ __device__ __forceinline__ void stage_rc(int b, int& R, int& C) { const int st = b / 1024, sb = b % 1024, swz = sb ^ (((sb >> 9) & 1) << 5); R = (st >> 1) * 16 + swz / 64; C = (st & 1) * 32 + (swz % 64) / 2; }
__host__ __device__ __forceinline__ int perm32(int rho) { const int n = rho >> 4, i = rho & 15; return 8 * (i >> 2) + 4 * n + (i & 3); }

struct Unit { int pm, pn; };
struct Gemm { const bf16_t* A; const bf16_t* Bt; int lda, K, npg; size_t a_gs; };

struct StaticOrder {
    int nM, nN, nwg, G, c;
    __device__ void init(int M, int N, int G_, int c_) { nM = M / BM; nN = N / BM; nwg = nM * nN; G = G_; c = c_; }
    __device__ bool next(int i, Unit& u) const {
        const long L = (long)i * G + c; if (L >= nwg) return false;
        int wgid = (int)L; { const int q = nwg / NXCD, r = nwg % NXCD, xcd = wgid % NXCD, off = wgid / NXCD; wgid = (xcd < r ? xcd * (q + 1) : r * (q + 1) + (xcd - r) * q) + off; }
        const int nig = WGM * nN, gid = wgid / nig, fm = gid * WGM, gsz = (nM - fm) < WGM ? (nM - fm) : WGM;
        u.pm = fm + ((wgid % nig) % gsz); u.pn = (wgid % nig) / gsz; return true;
    }
};

template <class Epi, bool ALIGN_EPI = true, bool SP2 = true>
__device__ __forceinline__ void gemm_phase(LAS unsigned char* lds, const Gemm g, const StaticOrder& S, const Epi& E) {
    const int tid = otid(), wid = __builtin_amdgcn_readfirstlane(tid >> 6), lane = tid & 63, wr = wid >> 2, wc = wid & 3, fr = lane & 15, fq = lane >> 4;
    const int K = g.K, nt = K / BK, lda = g.lda;
    unsigned voffA[2], voffB[2];
#pragma unroll
    for (int i = 0; i < 2; ++i) { int R, C; stage_rc(tid * 16 + i * 8192, R, C); const int Rb = (R & ~31) + perm32(R & 31);
        voffA[i] = (unsigned)(R * lda + C) * 2u; voffB[i] = (unsigned)(Rb * K + C) * 2u; }
    const size_t kstep = (size_t)(BK * 2);
    const size_t hstepA = (size_t)HALF * lda * 2, hstepB = (size_t)HALF * K * 2;
    const unsigned ldsw = (unsigned)wid * 1024u;
    const int aoff = lds_byte(wr * 64 + fr, fq * 8), boff = lds_byte(wc * 32 + fr, fq * 8);
#define PG8_SA(b, h) (((b) * 2 + (h)) * HTB)
#define PG8_SB(b, h) ((4 + (b) * 2 + (h)) * HTB)
#define PG8_STAGE(bufoff, gbase, voff) do { _Pragma("unroll") for (int _i = 0; _i < 2; ++_i) \
        __builtin_amdgcn_global_load_lds((const unsigned*)((const char*)(gbase) + (voff)[_i]), (LAS unsigned*)(lds + (bufoff) + ldsw + _i * 8192), 16, 0, 0); } while (0)
#define PG8_LDA(dst, b, h) do { _Pragma("unroll") for (int m = 0; m < 4; ++m) _Pragma("unroll") for (int k = 0; k < 2; ++k) dst[m][k] = *(const LAS bf16x8*)(lds + PG8_SA(b, h) + aoff + m * 2048 + k * 1024); } while (0)
#define PG8_LDB(dst, b, h) do { _Pragma("unroll") for (int n = 0; n < 2; ++n) _Pragma("unroll") for (int k = 0; k < 2; ++k) dst[n][k] = *(const LAS bf16x8*)(lds + PG8_SB(b, h) + boff + n * 2048 + k * 1024); } while (0)
#define PG8_MMA(ai, bj, At, Bt) do { __builtin_amdgcn_s_setprio(1); _Pragma("unroll") for (int m = 0; m < 4; ++m) _Pragma("unroll") for (int n = 0; n < 2; ++n) _Pragma("unroll") for (int k = 0; k < 2; ++k) \
        acc[ai][bj][m][n] = __builtin_amdgcn_mfma_f32_16x16x32_bf16(Bt[n][k], At[m][k], acc[ai][bj][m][n], 0, 0, 0); __builtin_amdgcn_s_setprio(0); } while (0)
#define PG8_WAIT_V(n) asm volatile("s_waitcnt vmcnt(" #n ")" ::: "memory")
#define PG8_WAIT_L(n) asm volatile("s_waitcnt lgkmcnt(" #n ")" ::: "memory")
#define PG8_BAR __builtin_amdgcn_s_barrier()
#define PG8_SCHED __builtin_amdgcn_sched_barrier(0)
#define PG8_APTR(u) ((const char*)g.A + ((size_t)(u).pm * BM * lda + (g.npg ? (size_t)((u).pn / g.npg) * g.a_gs : (size_t)0)) * 2)
#define PG8_BPTR(u) ((const char*)g.Bt + (size_t)(u).pn * BM * K * 2)
    Unit cur, nxt; int ui = 0;
    if (!S.next(0, cur)) return;
    f32x4 acc[2][2][4][2];
#pragma unroll
    for (int a = 0; a < 2; ++a)
#pragma unroll
        for (int b = 0; b < 2; ++b)
#pragma unroll
            for (int m = 0; m < 4; ++m)
#pragma unroll
                for (int n = 0; n < 2; ++n) acc[a][b][m][n] = (f32x4){0.f, 0.f, 0.f, 0.f};
    bf16x8 At[4][2], B0[2][2], B1[2][2];
    const char* cA = PG8_APTR(cur); const char* cB = PG8_BPTR(cur);
    if constexpr (SP2) {
        PG8_STAGE(PG8_SB(0, 0), cB, voffB); PG8_STAGE(PG8_SB(0, 1), cB + hstepB, voffB); PG8_STAGE(PG8_SA(0, 0), cA, voffA); PG8_STAGE(PG8_SA(0, 1), cA + hstepA, voffA);
        if (wr == 1) PG8_BAR;
        PG8_WAIT_V(2); PG8_BAR;
        PG8_STAGE(PG8_SB(1, 0), cB + kstep, voffB); PG8_STAGE(PG8_SA(1, 0), cA + kstep, voffA); PG8_STAGE(PG8_SB(1, 1), cB + hstepB + kstep, voffB);
        PG8_WAIT_V(6); PG8_BAR;
    } else {
        PG8_STAGE(PG8_SB(0, 0), cB, voffB); PG8_STAGE(PG8_SA(0, 0), cA, voffA); PG8_STAGE(PG8_SB(0, 1), cB + hstepB, voffB); PG8_STAGE(PG8_SA(0, 1), cA + hstepA, voffA);
        if (wr == 1) PG8_BAR;
        PG8_WAIT_V(4); PG8_BAR;
        PG8_STAGE(PG8_SB(1, 0), cB + kstep, voffB); PG8_STAGE(PG8_SA(1, 0), cA + kstep, voffA); PG8_STAGE(PG8_SB(1, 1), cB + hstepB + kstep, voffB);
        PG8_WAIT_V(6); PG8_BAR;
    }
    for (;;) {
        const bool has_next = S.next(ui + 1, nxt);
        const char* nA = has_next ? PG8_APTR(nxt) : cA; const char* nB = has_next ? PG8_BPTR(nxt) : cB;
        for (int t = 0; t < nt; t += 2) {
            const bool last = (t == nt - 2);
            const char* a1 = cA + (size_t)(t + 1) * kstep;
            const char* a2 = last ? nA : cA + (size_t)(t + 2) * kstep; const char* b2 = last ? nB : cB + (size_t)(t + 2) * kstep;
            const char* a3 = a2 + kstep; const char* b3 = b2 + kstep;
            if constexpr (SP2) {
            PG8_LDB(B0, 0, 0); PG8_LDB(B1, 0, 1); PG8_SCHED; PG8_LDA(At, 0, 0); PG8_STAGE(PG8_SA(1, 1), a1 + hstepA, voffA);
            PG8_WAIT_V(8); PG8_WAIT_L(0); PG8_BAR; PG8_MMA(0, 0, At, B0); PG8_MMA(0, 1, At, B1); PG8_BAR; PG8_SCHED;
            PG8_LDA(At, 0, 1); PG8_STAGE(PG8_SB(0, 0), b2, voffB); PG8_STAGE(PG8_SB(0, 1), b2 + hstepB, voffB); PG8_STAGE(PG8_SA(0, 0), a2, voffA);
            PG8_WAIT_V(8); PG8_WAIT_L(0); PG8_BAR; PG8_MMA(1, 0, At, B0); PG8_MMA(1, 1, At, B1); PG8_BAR; PG8_SCHED;
            PG8_LDB(B0, 1, 0); PG8_LDB(B1, 1, 1); PG8_SCHED; PG8_LDA(At, 1, 0); PG8_STAGE(PG8_SA(0, 1), a2 + hstepA, voffA);
            PG8_WAIT_V(8); PG8_WAIT_L(0); PG8_BAR; PG8_MMA(0, 0, At, B0); PG8_MMA(0, 1, At, B1); PG8_BAR; PG8_SCHED;
            PG8_LDA(At, 1, 1); PG8_STAGE(PG8_SB(1, 0), b3, voffB); PG8_STAGE(PG8_SB(1, 1), b3 + hstepB, voffB); PG8_STAGE(PG8_SA(1, 0), a3, voffA);
            PG8_WAIT_V(8); PG8_WAIT_L(0); PG8_BAR; PG8_MMA(1, 0, At, B0); PG8_MMA(1, 1, At, B1); PG8_BAR; PG8_SCHED;
            } else {
            PG8_LDB(B0, 0, 0); PG8_SCHED; PG8_LDA(At, 0, 0); PG8_STAGE(PG8_SA(1, 1), a1 + hstepA, voffA);
            PG8_WAIT_L(8); PG8_BAR; PG8_WAIT_L(0); PG8_MMA(0, 0, At, B0); PG8_BAR; PG8_SCHED;
            PG8_LDB(B1, 0, 1); PG8_STAGE(PG8_SB(0, 0), b2, voffB);
            PG8_BAR; PG8_WAIT_L(0); PG8_MMA(0, 1, At, B1); PG8_BAR;
            PG8_LDA(At, 0, 1); PG8_STAGE(PG8_SA(0, 0), a2, voffA);
            PG8_BAR; PG8_WAIT_L(0); PG8_MMA(1, 0, At, B0); PG8_BAR; PG8_SCHED;
            PG8_STAGE(PG8_SB(0, 1), b2 + hstepB, voffB);
            PG8_WAIT_V(6); PG8_BAR; PG8_MMA(1, 1, At, B1); PG8_BAR;
            PG8_LDB(B0, 1, 0); PG8_SCHED; PG8_LDA(At, 1, 0); PG8_STAGE(PG8_SA(0, 1), a2 + hstepA, voffA);
            PG8_WAIT_L(8); PG8_BAR; PG8_WAIT_L(0); PG8_MMA(0, 0, At, B0); PG8_BAR; PG8_SCHED;
            PG8_LDB(B1, 1, 1); PG8_STAGE(PG8_SB(1, 0), b3, voffB);
            PG8_BAR; PG8_WAIT_L(0); PG8_MMA(0, 1, At, B1); PG8_BAR;
            PG8_LDA(At, 1, 1); PG8_STAGE(PG8_SA(1, 0), a3, voffA);
            PG8_BAR; PG8_WAIT_L(0); PG8_MMA(1, 0, At, B0); PG8_BAR; PG8_SCHED;
            PG8_STAGE(PG8_SB(1, 1), b3 + hstepB, voffB);
            PG8_WAIT_V(6); PG8_BAR; PG8_MMA(1, 1, At, B1); PG8_BAR;
            }
        }
        if constexpr (ALIGN_EPI) { if (wr == 0) PG8_BAR; }
        E(acc, cur, wr, wc, fr, fq);
        if (!has_next) break;
#pragma unroll
        for (int a = 0; a < 2; ++a)
#pragma unroll
            for (int b = 0; b < 2; ++b)
#pragma unroll
                for (int m = 0; m < 4; ++m)
#pragma unroll
                    for (int n = 0; n < 2; ++n) acc[a][b][m][n] = (f32x4){0.f, 0.f, 0.f, 0.f};
        cur = nxt; cA = nA; cB = nB; ++ui;
        if constexpr (ALIGN_EPI) { if (wr == 1) PG8_BAR; }
    }
    PG8_WAIT_V(0);
    if constexpr (!ALIGN_EPI) { if (wr == 0) PG8_BAR; }
    PG8_BAR;
#undef PG8_SA
#undef PG8_SB
#undef PG8_STAGE
#undef PG8_LDA
#undef PG8_LDB
#undef PG8_MMA
#undef PG8_WAIT_V
#undef PG8_WAIT_L
#undef PG8_BAR
#undef PG8_SCHED
#undef PG8_APTR
#undef PG8_BPTR
}

__device__ __forceinline__ u32x4 pack8(const f32x4 a, const f32x4 b) { u32x4 w; w.x = cvtpk(a[0], a[1]); w.y = cvtpk(a[2], a[3]); w.z = cvtpk(b[0], b[1]); w.w = cvtpk(b[2], b[3]); return w; }

struct EpiPlain {
    bf16_t* O; int ldc; int split_cols; size_t split_stride; const float* rowscale;
    __device__ __forceinline__ void operator()(const f32x4 (&acc)[2][2][4][2], const Unit& u, int wr, int wc, int fr, int fq) const {
        const int row0 = u.pm * BM + wr * 64 + fr, col0 = u.pn * BM + wc * 32 + 8 * fq;
        bf16_t* Ob = O; if (split_cols) { const int tsp = (u.pn * BM) / split_cols; Ob = O + (size_t)tsp * split_stride - (size_t)tsp * split_cols; }
#pragma unroll
        for (int ai = 0; ai < 2; ++ai)
#pragma unroll
            for (int m = 0; m < 4; ++m) { const int row = row0 + ai * HALF + m * 16; bf16_t* rowp = Ob + (size_t)row * ldc + col0; const float rs = rowscale ? rowscale[row] : 1.0f;
#pragma unroll
                for (int bj = 0; bj < 2; ++bj) *(u32x4*)(rowp + bj * HALF) = pack8(acc[ai][bj][m][0] * rs, acc[ai][bj][m][1] * rs); }
    }
};
struct EpiGelu {
    bf16_t* O; int ldc; const float* bias; int split_cols; size_t split_stride;
    __device__ __forceinline__ void operator()(const f32x4 (&acc)[2][2][4][2], const Unit& u, int wr, int wc, int fr, int fq) const {
        const int row0 = u.pm * BM + wr * 64 + fr, col0 = u.pn * BM + wc * 32 + 8 * fq;
        const int tsp = (u.pn * BM) / split_cols; bf16_t* Ob = O + (size_t)tsp * split_stride - (size_t)tsp * split_cols;
        f32x4 bv[2][2];
#pragma unroll
        for (int bj = 0; bj < 2; ++bj)
#pragma unroll
            for (int n = 0; n < 2; ++n) bv[bj][n] = *(const f32x4*)(bias + col0 + bj * HALF + 4 * n);
#pragma unroll
        for (int ai = 0; ai < 2; ++ai)
#pragma unroll
            for (int m = 0; m < 4; ++m) { bf16_t* rowp = Ob + (size_t)(row0 + ai * HALF + m * 16) * ldc + col0;
#pragma unroll
                for (int bj = 0; bj < 2; ++bj) { f32x4 v0 = acc[ai][bj][m][0] + bv[bj][0], v1 = acc[ai][bj][m][1] + bv[bj][1];
#pragma unroll
                    for (int j = 0; j < 4; ++j) { v0[j] = gelu_tanh(v0[j]); v1[j] = gelu_tanh(v1[j]); }
                    *(u32x4*)(rowp + bj * HALF) = pack8(v0, v1); } }
    }
};
struct EpiY {
    bf16_t* O; int ldc; const float* colscale; float* ssp; int nsp;
    __device__ __forceinline__ void operator()(const f32x4 (&acc)[2][2][4][2], const Unit& u, int wr, int wc, int fr, int fq) const {
        const int row0 = u.pm * BM + wr * 64 + fr, col0 = u.pn * BM + wc * 32 + 8 * fq;
        f32x4 sv[2][2];
#pragma unroll
        for (int bj = 0; bj < 2; ++bj)
#pragma unroll
            for (int n = 0; n < 2; ++n) sv[bj][n] = colscale ? *(const f32x4*)(colscale + col0 + bj * HALF + 4 * n) : (f32x4){1.f, 1.f, 1.f, 1.f};
#pragma unroll
        for (int ai = 0; ai < 2; ++ai)
#pragma unroll
            for (int m = 0; m < 4; ++m) { const int row = row0 + ai * HALF + m * 16; bf16_t* rowp = O + (size_t)row * ldc + col0; float ss = 0.f;
#pragma unroll
                for (int bj = 0; bj < 2; ++bj) { const f32x4 v0 = acc[ai][bj][m][0] * sv[bj][0], v1 = acc[ai][bj][m][1] * sv[bj][1];
                    ss += (v0[0] * v0[0] + v0[1] * v0[1]) + (v0[2] * v0[2] + v0[3] * v0[3]) + (v1[0] * v1[0] + v1[1] * v1[1]) + (v1[2] * v1[2] + v1[3] * v1[3]);
                    *(u32x4*)(rowp + bj * HALF) = pack8(v0, v1); }
                ss += __shfl_xor(ss, 16); ss += __shfl_xor(ss, 32);
                if (fq == 0) ssp[(size_t)row * nsp + u.pn * 4 + wc] = ss; }
    }
};
struct EpiNsaIn {
    bf16_t* Q; bf16_t* KV; float* GT; const float* rowscale;
    __device__ __forceinline__ void operator()(const f32x4 (&acc)[2][2][4][2], const Unit& u, int wr, int wc, int fr, int fq) const {
        const int row0 = u.pm * BM + wr * 64 + fr, col0 = u.pn * BM + wc * 32 + 8 * fq;
#pragma unroll
        for (int ai = 0; ai < 2; ++ai)
#pragma unroll
            for (int m = 0; m < 4; ++m) { const int row = row0 + ai * HALF + m * 16; const float rs = rowscale[row];
#pragma unroll
                for (int bj = 0; bj < 2; ++bj) { const int col = col0 + bj * HALF; const f32x4 v0 = acc[ai][bj][m][0] * rs, v1 = acc[ai][bj][m][1] * rs;
                    if (u.pn < 16) { *(u32x4*)(Q + (size_t)row * QW + col) = pack8(v0, v1); }
                    else if (u.pn < 28) { const int idx = col - QW, br = idx >> 10, rem = idx & 1023, kvs = rem >> 9, gg = (rem >> 7) & 3, dh = rem & 127, b = row >> 13, s = row & (SEQ - 1);
                        *(u32x4*)(KV + ((size_t)((((br * 2 + kvs) * 2 + b) * 4 + gg)) * SEQ + s) * HD + dh) = pack8(v0, v1); }
                    else if (col < NSA_INW) { float* gp = GT + (size_t)row * GW_ + (col - QW - KVW); f32x4 a, c;
#pragma unroll
                        for (int j = 0; j < 4; ++j) { a[j] = sigmoidf_(v0[j]); c[j] = sigmoidf_(v1[j]); }
                        *(f32x4*)gp = a; *(f32x4*)(gp + 4) = c; } } }
    }
};

#define DPP4(dst, oldv, srcv, ctrl) do { _Pragma("unroll") for (int j_ = 0; j_ < 4; ++j_) dst[j_] = __int_as_float(__builtin_amdgcn_update_dpp(__float_as_int(oldv[j_]), __float_as_int(srcv[j_]), (ctrl), 0xF, 0xF, false)); } while (0)
struct EpiGateUp {
    bf16_t* ACT; const float* cw; const float* cb; float* HALO; float* EDGE; LAS unsigned char* lds; const float* rowscale;
    __device__ __forceinline__ void operator()(const f32x4 (&acc_in)[2][2][4][2], const Unit& u, int wr, int wc, int fr, int fq) const {
        const int chl = wc * 32 + 8 * fq, ch = u.pn * 128 + chl;
        f32x4 acc[2][2][4][2];
#pragma unroll
        for (int ai = 0; ai < 2; ++ai)
#pragma unroll
            for (int m = 0; m < 4; ++m) { const float rs = rowscale[u.pm * BM + ai * HALF + wr * 64 + m * 16 + fr];
#pragma unroll
                for (int bj = 0; bj < 2; ++bj) { acc[ai][bj][m][0] = acc_in[ai][bj][m][0] * rs; acc[ai][bj][m][1] = acc_in[ai][bj][m][1] * rs; } }
        LAS float* XCH = (LAS float*)(lds + XCH_OFF);
        if (fr >= 14) {
#pragma unroll
            for (int ai = 0; ai < 2; ++ai) { const int q = 2 * ai + wr; LAS float* x = XCH + ((q * 2 + (fr - 14)) * 128 + chl);
                *(LAS f32x4*)x = acc[ai][0][3][0]; *(LAS f32x4*)(x + 4) = acc[ai][0][3][1];
                if (q == 3) { float* hp = HALO + ((size_t)(u.pm * 2 + (fr - 14))) * DFF + ch; *(f32x4*)hp = acc[ai][0][3][0]; *(f32x4*)(hp + 4) = acc[ai][0][3][1]; } }
        }
        asm volatile("s_waitcnt lgkmcnt(0)" ::: "memory"); __builtin_amdgcn_s_barrier(); asm volatile("" ::: "memory");
        const f32x4 w0a = *(const f32x4*)(cw + ch), w0b = *(const f32x4*)(cw + ch + 4), w1a = *(const f32x4*)(cw + DFF + ch), w1b = *(const f32x4*)(cw + DFF + ch + 4);
        const f32x4 w2a = *(const f32x4*)(cw + 2 * DFF + ch), w2b = *(const f32x4*)(cw + 2 * DFF + ch + 4), bba = *(const f32x4*)(cb + ch), bbb = *(const f32x4*)(cb + ch + 4);
        const bool seqstart = (u.pm & 31) == 0;
        const f32x4 zero4 = (f32x4){0.f, 0.f, 0.f, 0.f};
#pragma unroll
        for (int ai = 0; ai < 2; ++ai) { const int q = 2 * ai + wr;
            f32x4 r63a = zero4, r63b = zero4, r62a = zero4, r62b = zero4;
            if (q > 0) { const LAS float* x = XCH + (((q - 1) * 2) * 128 + chl); r62a = *(const LAS f32x4*)x; r62b = *(const LAS f32x4*)(x + 4); r63a = *(const LAS f32x4*)(x + 128); r63b = *(const LAS f32x4*)(x + 132); }
#pragma unroll
            for (int m = 0; m < 4; ++m) {
                const f32x4 ca = acc[ai][0][m][0], cb_ = acc[ai][0][m][1], ua = acc[ai][1][m][0], ub = acc[ai][1][m][1];
                f32x4 x1a, x1b, x2a, x2b;
                if (m == 0) { x1a = r63a; x1b = r63b; x2a = fr == 0 ? r62a : r63a; x2b = fr == 0 ? r62b : r63b; }
                else { DPP4(x1a, zero4, acc[ai][0][m - 1][0], 0x121); DPP4(x1b, zero4, acc[ai][0][m - 1][1], 0x121); DPP4(x2a, zero4, acc[ai][0][m - 1][0], 0x122); DPP4(x2b, zero4, acc[ai][0][m - 1][1], 0x122); }
                f32x4 p1a, p1b, p2a, p2b;
                DPP4(p1a, x1a, ca, 0x111); DPP4(p1b, x1b, cb_, 0x111); DPP4(p2a, x2a, ca, 0x112); DPP4(p2b, x2b, cb_, 0x112);
                const int lrow = ai * HALF + wr * 64 + m * 16 + fr;
                if (q == 0 && m == 0 && fr < 2 && !seqstart) {
                    float* ep = EDGE + ((size_t)((u.pm * 2 + fr) * 2)) * DFF + ch;
                    *(f32x4*)ep = ca; *(f32x4*)(ep + 4) = cb_; *(f32x4*)(ep + DFF) = ua; *(f32x4*)(ep + DFF + 4) = ub;
                } else {
                    f32x4 za = w0a * p2a + w1a * p1a + w2a * ca + bba, zb = w0b * p2b + w1b * p1b + w2b * cb_ + bbb;
#pragma unroll
                    for (int j = 0; j < 4; ++j) { za[j] = za[j] * sigmoidf_(za[j]) * ua[j]; zb[j] = zb[j] * sigmoidf_(zb[j]) * ub[j]; }
                    *(u32x4*)(ACT + (size_t)(u.pm * BM + lrow) * DFF + ch) = pack8(za, zb);
                }
            }
        }
    }
};
}

struct Args { const float* in[21]; float* out; unsigned char* ws; int ph_lo, ph_hi; };
struct Frame {
    LAS unsigned char* lds; volatile LAS unsigned* MISC; unsigned* ctl;
    int G, bid;
    unsigned char* ws; float* out;
};
enum { IN_X = 0, IN_MEM, IN_LN_MIX, IN_LN_XA, IN_LN_FFN, IN_MEM_NORM, IN_POOL_W, IN_POOL_SCALE, IN_NSA_W_IN, IN_NSA_W_OUT, IN_CMP_POS, IN_CMP_W1, IN_CMP_B1, IN_CMP_W2,
       IN_XA_WQ, IN_XA_WKV, IN_XA_WO, IN_FFN_WGU, IN_FFN_CONVW, IN_FFN_CONVB, IN_FFN_WDN };

template <int MODE>
__device__ __forceinline__ void p0_transpose_item(const float* W, int K, int N, bf16_t* WT, const float* gk  , LAS float* scr, int item, int lane) {
    const int nblk = N / 32, kb = item / nblk, nb = item % nblk, k0 = 64 * kb, n0 = 32 * nb;
#pragma unroll 8
    for (int i = 0; i < 32; ++i) { const int kk = 2 * i + (lane >> 5); const float gv = gk ? gk[k0 + kk] : 1.0f; scr[kk * 33 + (lane & 31)] = W[(size_t)(k0 + kk) * N + n0 + (lane & 31)] * gv; }
    LDS_WAIT(); asm volatile("" ::: "memory");
    int r0 = n0;
    if (MODE == 1) { const int up = n0 >= DFF ? 1 : 0, ch = n0 - up * DFF; r0 = (ch >> 7) * 256 + up * 128 + (ch & 127); }
    const int c = lane & 7;
#pragma unroll
    for (int j = 0; j < 4; ++j) { const int n = (lane >> 3) + 8 * j; const LAS float* s = scr + (8 * c) * 33 + n;
        u32x4 o; o.x = cvtpk(s[0 * 33], s[1 * 33]); o.y = cvtpk(s[2 * 33], s[3 * 33]); o.z = cvtpk(s[4 * 33], s[5 * 33]); o.w = cvtpk(s[6 * 33], s[7 * 33]);
        *(u32x4*)(WT + (size_t)(r0 + n) * K + k0 + 8 * c) = o; }
    LDS_WAIT(); asm volatile("" ::: "memory");
}
__device__ __forceinline__ float row_sumsq(const float* row, int lane) {
    const f32x4* xr = (const f32x4*)row + lane; float s = 0.f;
#pragma unroll
    for (int j = 0; j < 16; ++j) { const f32x4 v = xr[64 * j]; s += (v[0] * v[0] + v[1] * v[1]) + (v[2] * v[2] + v[3] * v[3]); }
    return wave_sum(s);
}
__device__ __forceinline__ void phase_p0(Frame& F, const Args& A) {
    const int tid = otid(), lane = tid & 63, wave = __builtin_amdgcn_readfirstlane(tid >> 6);
    LAS float* scr = (LAS float*)(F.lds + wave * 16384);
    const int gw = F.bid * NWAVES + wave, NGW = F.G * NWAVES;
    unsigned char* ws = F.ws;
    int it = gw;
#define P0_MAT(MODE, src, K_, N_, dst, gk_) do { const int n_ = ((K_) / 64) * ((N_) / 32); for (; it < n_; it += NGW) p0_transpose_item<MODE>((src), (K_), (N_), (bf16_t*)(dst), (gk_), scr, it, lane); it -= n_; } while (0)
    for (int l = 0; l < 2; ++l) P0_MAT(1, A.in[IN_FFN_WGU] + (size_t)l * DM * DFF2, DM, DFF2, ws + WS_WGU + (size_t)l * DFF2 * DM * 2, A.in[IN_LN_FFN] + (size_t)l * 2 * DM);
    for (int l = 0; l < 2; ++l) P0_MAT(0, A.in[IN_FFN_WDN] + (size_t)l * DFF * DM, DFF, DM, ws + WS_WDN + (size_t)l * DM * DFF * 2, nullptr);
    P0_MAT(0, A.in[IN_NSA_W_IN], DM, NSA_INW, ws + WS_NSAIN, A.in[IN_LN_MIX] + (size_t)2 * DM);
    P0_MAT(0, A.in[IN_NSA_W_OUT], QW, DM, ws + WS_NSAOUT, nullptr);
    for (int g = 0; g < 4; ++g) P0_MAT(0, A.in[IN_POOL_W] + (size_t)g * PGC * PGC, PGC, PGC, ws + WS_POOLW + (size_t)g * PGC * PGC * 2, nullptr);
    for (int l = 0; l < 2; ++l) P0_MAT(0, A.in[IN_CMP_W1] + (size_t)l * 4096 * CMP_HID, 4096, CMP_HID, ws + WS_CMPW1 + (size_t)l * CMP_HID * 4096 * 2, nullptr);
    for (int l = 0; l < 2; ++l) P0_MAT(0, A.in[IN_CMP_W2] + (size_t)l * CMP_HID * HD, CMP_HID, HD, ws + WS_CMPW2 + (size_t)l * HD * CMP_HID * 2, nullptr);
    for (int l = 0; l < 2; ++l) P0_MAT(0, A.in[IN_XA_WQ] + (size_t)l * DM * XAW, DM, XAW, ws + WS_XAQ + (size_t)l * XAW * DM * 2, A.in[IN_LN_XA] + (size_t)l * 2 * DM);
    for (int l = 0; l < 2; ++l) P0_MAT(0, A.in[IN_XA_WKV] + (size_t)l * DM * 2 * XAW, DM, 2 * XAW, ws + WS_XAKV + (size_t)l * 2 * XAW * DM * 2, nullptr);
    for (int l = 0; l < 2; ++l) P0_MAT(0, A.in[IN_XA_WO] + (size_t)l * XAW * DM, XAW, DM, ws + WS_XAO + (size_t)l * DM * XAW * 2, nullptr);
#undef P0_MAT
    { u32x4* z = (u32x4*)(ws + WS_NSAIN + (size_t)NSA_INW * DM * 2); const int n16 = (NSA_INP - NSA_INW) * DM * 2 / 16;
      for (int i = gw * 64 + lane; i < n16; i += NGW * 64) z[i] = (u32x4){0u, 0u, 0u, 0u}; }
    for (int r = gw; r < MMEM; r += NGW) {
        const float* row = A.in[IN_MEM] + (size_t)r * DM; const float rs = 1.0f / sqrtf(row_sumsq(row, lane) * (1.0f / DM) + RMS_EPS);
        bf16_t* o = (bf16_t*)(ws + WS_MEMN) + (size_t)r * DM;
#pragma unroll
        for (int j = 0; j < 8; ++j) { const int c8 = (j * 64 + lane) * 8; const f32x4 a = *(const f32x4*)(row + c8), b = *(const f32x4*)(row + c8 + 4);
            const f32x4 ga = *(const f32x4*)(A.in[IN_MEM_NORM] + c8), gb = *(const f32x4*)(A.in[IN_MEM_NORM] + c8 + 4);
            *(u32x4*)(o + c8) = pg8::pack8(a * rs * ga, b * rs * gb); }
    }
    { float* part = (float*)(ws + WS_CMPB + 65536);
      for (int tk = gw; tk < 256; tk += NGW) { const int kv = tk >> 7, ng = (tk >> 4) & 7, ks = tk & 15, n = ng * 64 + lane;
          const float* pos = A.in[IN_CMP_POS] + (size_t)kv * 4096 + ks * 256; const float* w1 = A.in[IN_CMP_W1] + ((size_t)kv * 4096 + ks * 256) * CMP_HID + n; float s = 0.f;
#pragma unroll 8
          for (int k = 0; k < 256; ++k) s += pos[k] * w1[(size_t)k * CMP_HID];
          part[(kv * 16 + ks) * CMP_HID + n] = s; } }
    { float* xr = (float*)(ws + WS_XR);
      for (int r = gw; r < MTOK; r += NGW) { const float ss = row_sumsq(A.in[IN_X] + (size_t)r * DM, lane); if (lane == 0) xr[r] = 1.0f / sqrtf(ss * (1.0f / DM) + RMS_EPS); } }
}

__device__ __forceinline__ void phase_poolprep(Frame& F, const Args& A) {
    const float* X = A.in[IN_X]; const float* g0 = A.in[IN_LN_MIX]; const float* xr = (const float*)(F.ws + WS_XR); bf16_t* D0 = (bf16_t*)(F.ws + WS_HN);
    const int tid = otid();
    for (int ch = F.bid; ch < MTOK / 64; ch += F.G) {
        const int t0 = ch * 64, tin0 = t0 & (SEQ - 1);
#pragma unroll 1
        for (int qq = tid; qq < DM / 4; qq += NTHR) {
            const int c = 4 * qq, win = 2 << (c >> 10); const f32x4 gv = *(const f32x4*)(g0 + c);
            f32x4 s = (f32x4){0.f, 0.f, 0.f, 0.f};
            for (int i = win; i >= 1; --i) if (tin0 - i >= 0) s += *(const f32x4*)(X + (size_t)(t0 - i) * DM + c) * xr[t0 - i] * gv;
            for (int r = 0; r < 64; ++r) { const int t = t0 + r, tin = tin0 + r;
                const f32x4 av = *(const f32x4*)(X + (size_t)t * DM + c) * xr[t] * gv; s += av;
                if (tin >= win) s -= *(const f32x4*)(X + (size_t)(t - win) * DM + c) * xr[t - win] * gv;
                const float ic = 1.0f / (float)(tin + 1 < win ? tin + 1 : win);
                const f32x4 d = s * ic - av; u32x2 w; w.x = cvtpk(d[0], d[1]); w.y = cvtpk(d[2], d[3]);
                *(u32x2*)(D0 + (size_t)t * DM + c) = w; }
        }
    }
}

template <bool FIRST, bool LAST>
__device__ __forceinline__ void phase_resid(Frame& F, const float* x, const float* g1) {
    const int tid = otid(), lane = tid & 63, wave = __builtin_amdgcn_readfirstlane(tid >> 6);
    const int gw = F.bid * NWAVES + wave, NGW = F.G * NWAVES;
    const bf16_t* Y = (const bf16_t*)(F.ws + WS_Y); const float* ssp = (const float*)(F.ws + WS_SSP); bf16_t* H = (bf16_t*)(F.ws + WS_HN); float* RS = (float*)(F.ws + WS_RS);
    for (int row = gw; row < MTOK; row += NGW) {
        const float ss = wave_sum(ssp[(size_t)row * 64 + lane]); const float rs = 1.0f / sqrtf(ss * (1.0f / DM) + RMS_EPS);
        float s2 = 0.f;
#pragma unroll
        for (int j = 0; j < 8; ++j) { const int c8 = (j * 64 + lane) * 8; const size_t off = (size_t)row * DM + c8;
            const u32x4 yw = *(const u32x4*)(Y + off); f32x4 h0, h1;
            if (FIRST) { h0 = *(const f32x4*)(x + off); h1 = *(const f32x4*)(x + off + 4); }
            else { const u32x4 hw = *(const u32x4*)(H + off); h0 = (f32x4){bflo(hw.x), bfhi(hw.x), bflo(hw.y), bfhi(hw.y)}; h1 = (f32x4){bflo(hw.z), bfhi(hw.z), bflo(hw.w), bfhi(hw.w)}; }
            const f32x4 ga = *(const f32x4*)(g1 + c8), gb = *(const f32x4*)(g1 + c8 + 4);
            const f32x4 y0 = (f32x4){bflo(yw.x), bfhi(yw.x), bflo(yw.y), bfhi(yw.y)}, y1 = (f32x4){bflo(yw.z), bfhi(yw.z), bflo(yw.w), bfhi(yw.w)};
            const f32x4 a = h0 + y0 * rs * ga, b = h1 + y1 * rs * gb;
            if (LAST) { *(f32x4*)(F.out + off) = a; *(f32x4*)(F.out + off + 4) = b; }
            else { *(u32x4*)(H + off) = pg8::pack8(a, b);
                s2 += (a[0] * a[0] + a[1] * a[1]) + (a[2] * a[2] + a[3] * a[3]) + (b[0] * b[0] + b[1] * b[1]) + (b[2] * b[2] + b[3] * b[3]); } }
        if (!LAST) { const float t2 = wave_sum(s2); if (lane == 0) RS[row] = 1.0f / sqrtf(t2 * (1.0f / DM) + RMS_EPS); }
    }
}

__device__ __forceinline__ void unpack8(const u32x4 w, float (&f)[8]) { f[0] = bflo(w.x); f[1] = bfhi(w.x); f[2] = bflo(w.y); f[3] = bfhi(w.y); f[4] = bflo(w.z); f[5] = bfhi(w.z); f[6] = bflo(w.w); f[7] = bfhi(w.w); }
__device__ __forceinline__ void phase_act(Frame& F, const float* cw, const float* cb) {
    const bf16_t* GU = (const bf16_t*)(F.ws + WS_GU); bf16_t* ACT = (bf16_t*)(F.ws + WS_ACT);
    constexpr int NCG = DFF / 8, RCH = 32, TOTAL = (MTOK / RCH) * NCG;
    const int tid = otid();
    for (int it = F.bid * NTHR + tid; it < TOTAL; it += F.G * NTHR) {
        const int chunk = it / NCG, cg = it - chunk * NCG, ch = cg * 8, colg = (ch >> 7) * 256 + (ch & 127), colu = colg + 128;
        const int t0 = chunk * RCH, tin0 = t0 & (SEQ - 1);
        float w0[8], w1[8], w2[8], bb[8], g2[8], g1[8];
#pragma unroll
        for (int j = 0; j < 8; ++j) { w0[j] = cw[ch + j]; w1[j] = cw[DFF + ch + j]; w2[j] = cw[2 * DFF + ch + j]; bb[j] = cb[ch + j]; g2[j] = 0.f; g1[j] = 0.f; }
        if (tin0 >= 2) { unpack8(*(const u32x4*)(GU + (size_t)(t0 - 2) * DFF2 + colg), g2); unpack8(*(const u32x4*)(GU + (size_t)(t0 - 1) * DFF2 + colg), g1); }
#pragma unroll 2
        for (int r = 0; r < RCH; ++r) { const size_t ro = (size_t)(t0 + r) * DFF2; float gc[8], up[8], o[8];
            unpack8(*(const u32x4*)(GU + ro + colg), gc); unpack8(*(const u32x4*)(GU + ro + colu), up);
#pragma unroll
            for (int j = 0; j < 8; ++j) { const float z = w0[j] * g2[j] + w1[j] * g1[j] + w2[j] * gc[j] + bb[j]; o[j] = z * sigmoidf_(z) * up[j]; g2[j] = g1[j]; g1[j] = gc[j]; }
            u32x4 w; w.x = cvtpk(o[0], o[1]); w.y = cvtpk(o[2], o[3]); w.z = cvtpk(o[4], o[5]); w.w = cvtpk(o[6], o[7]);
            *(u32x4*)(ACT + (size_t)(t0 + r) * DFF + ch) = w; }
    }
}

__device__ __forceinline__ void phase_actfix(Frame& F, const float* cw, const float* cb) {
    const float* HALO = (const float*)(F.ws + WS_HALO); const float* EDGE = (const float*)(F.ws + WS_EDGE); bf16_t* ACT = (bf16_t*)(F.ws + WS_ACT);
    constexpr int NC4 = DFF / 4, TOTAL = 64 * 2 * NC4;
    const int tid = otid();
    for (int it = F.bid * NTHR + tid; it < TOTAL; it += F.G * NTHR) {
        const int c4 = it % NC4, pr = it / NC4, r = pr & 1, pm = pr >> 1, ch = 4 * c4;
        if ((pm & 31) == 0) continue;
        const float* e = EDGE + ((size_t)((pm * 2 + r) * 2)) * DFF + ch; const float* hprev = HALO + ((size_t)((pm - 1) * 2)) * DFF + ch;
        const f32x4 cur = *(const f32x4*)e, up = *(const f32x4*)(e + DFF);
        const f32x4 p1 = r == 0 ? *(const f32x4*)(hprev + DFF) : *(const f32x4*)(EDGE + ((size_t)((pm * 2) * 2)) * DFF + ch);
        const f32x4 p2 = r == 0 ? *(const f32x4*)hprev : *(const f32x4*)(hprev + DFF);
        f32x4 z = *(const f32x4*)(cw + ch) * p2 + *(const f32x4*)(cw + DFF + ch) * p1 + *(const f32x4*)(cw + 2 * DFF + ch) * cur + *(const f32x4*)(cb + ch);
#pragma unroll
        for (int j = 0; j < 4; ++j) z[j] = z[j] * sigmoidf_(z[j]) * up[j];
        u32x2 w; w.x = cvtpk(z[0], z[1]); w.y = cvtpk(z[2], z[3]);
        *(u32x2*)(ACT + (size_t)(pm * 256 + r) * DFF + ch) = w;
    }
}

__device__ __forceinline__ void phase_cmp2(Frame& F) {
    const int tid = otid(), lane = tid & 63, wave = __builtin_amdgcn_readfirstlane(tid >> 6);
    const int gw = F.bid * NWAVES + wave, NGW = F.G * NWAVES;
    const bf16_t* HID = (const bf16_t*)(F.ws + WS_HID); const bf16_t* W2 = (const bf16_t*)(F.ws + WS_CMPW2); bf16_t* KVC = (bf16_t*)(F.ws + WS_KVC);
    for (int r = gw; r < 2 * 4096; r += NGW) { const int kv = r >> 12;
        const bf16_t* h = HID + (size_t)r * CMP_HID; const bf16_t* wa = W2 + ((size_t)kv * HD + 2 * lane) * CMP_HID; const bf16_t* wb = wa + CMP_HID;
        float s0 = 0.f, s1 = 0.f;
#pragma unroll 4
        for (int k = 0; k < CMP_HID; k += 8) { float hf[8], a[8], b[8]; unpack8(*(const u32x4*)(h + k), hf); unpack8(*(const u32x4*)(wa + k), a); unpack8(*(const u32x4*)(wb + k), b);
#pragma unroll
            for (int j = 0; j < 8; ++j) { s0 += hf[j] * a[j]; s1 += hf[j] * b[j]; } }
        if ((r & 511) == 511) { s0 = 0.f; s1 = 0.f; }
        *(unsigned*)(KVC + (size_t)r * HD + 2 * lane) = cvtpk(s0, s1);
    }
}


namespace att {
constexpr int SHM = 16384;
constexpr int V_OFF = 0, K_OFF = 2 * SHM;
constexpr int SG_OFF = 65536, SL_OFF = SG_OFF + 16384, SELW_OFF = SL_OFF + 16384, TL_OFF = SELW_OFF + 512;
constexpr int ALF_OFF = TL_OFF + 1024;
constexpr float THR2 = 11.5f;
#define KSWZ(row, colB) ((row) * 256 + ((colB) ^ (((row) & 7) << 4)))
#define SBAR() __builtin_amdgcn_sched_barrier(0)
__device__ __forceinline__ int v_st(int k, int c) { const int kk = (k & ~0xC) | ((k & 4) << 1) | ((k & 8) >> 1); return ((kk >> 3) * 4 + (c >> 5)) * 512 + ((kk & 7) * 32 + (c & 31)) * 2; }
__device__ __forceinline__ int v_rd_base(int lane) { return ((lane & 3) << 3) | (((lane >> 2) & 3) << 6) | (((lane >> 4) & 1) << 5) | (((lane >> 5) & 1) << 8); }
constexpr int v_rd_off(int d0, int ks, int half) { return d0 * 512 + ks * 4096 + half * 2048; }
__device__ __forceinline__ int crow(int r, int hi) { return (r & 3) + 8 * (r >> 2) + 4 * hi; }

__device__ __forceinline__ void qkt(f32x16& p0, f32x16& p1, const LAS unsigned char* lds  , int r32, int hi, const bf16x8 (&qr)[8]) {
#pragma unroll
    for (int r = 0; r < 16; ++r) { p0[r] = 0.f; p1[r] = 0.f; }
    const LAS unsigned char* kb[4];
#pragma unroll
    for (int dd = 0; dd < 4; ++dd) kb[dd] = lds + KSWZ(r32, (dd * 16 + hi * 8) * 2);
#pragma unroll
    for (int d0 = 0; d0 < 8; ++d0) { const LAS unsigned char* a = kb[d0 & 3] + (d0 >> 2) * 128;
        const bf16x8 b0 = *(const LAS bf16x8*)a;
        const bf16x8 b1 = *(const LAS bf16x8*)(a + 32 * 256);
        p0 = __builtin_amdgcn_mfma_f32_32x32x16_bf16(b0, qr[d0], p0, 0, 0, 0);
        p1 = __builtin_amdgcn_mfma_f32_32x32x16_bf16(b1, qr[d0], p1, 0, 0, 0); }
}
__device__ __forceinline__ void pv_tile(f32x16 (&o)[4], int vb0  , bf16x8 pa0, bf16x8 pa1, bf16x8 pa2, bf16x8 pa3) {
#define TRRD(dst, off) asm volatile("ds_read_b64_tr_b16 %0, %1 offset:%2" : "=&v"(dst) : "v"(vb0), "i"(off) : "memory")
#define PV_D0(d0) do { s16x4 l0, l1, l2, l3, h0, h1, h2, h3; constexpr int b_ = v_rd_off(d0, 0, 0); \
        TRRD(l0, b_); TRRD(h0, b_ + 2048); TRRD(l1, b_ + 4096); TRRD(h1, b_ + 6144); TRRD(l2, b_ + 8192); TRRD(h2, b_ + 10240); TRRD(l3, b_ + 12288); TRRD(h3, b_ + 14336); \
        asm volatile("s_waitcnt lgkmcnt(0)" ::: "memory"); SBAR(); \
        o[d0] = __builtin_amdgcn_mfma_f32_32x32x16_bf16(pa0, (bf16x8){l0[0], l0[1], l0[2], l0[3], h0[0], h0[1], h0[2], h0[3]}, o[d0], 0, 0, 0); \
        o[d0] = __builtin_amdgcn_mfma_f32_32x32x16_bf16(pa1, (bf16x8){l1[0], l1[1], l1[2], l1[3], h1[0], h1[1], h1[2], h1[3]}, o[d0], 0, 0, 0); \
        o[d0] = __builtin_amdgcn_mfma_f32_32x32x16_bf16(pa2, (bf16x8){l2[0], l2[1], l2[2], l2[3], h2[0], h2[1], h2[2], h2[3]}, o[d0], 0, 0, 0); \
        o[d0] = __builtin_amdgcn_mfma_f32_32x32x16_bf16(pa3, (bf16x8){l3[0], l3[1], l3[2], l3[3], h3[0], h3[1], h3[2], h3[3]}, o[d0], 0, 0, 0); } while (0)
    PV_D0(0); PV_D0(1); PV_D0(2); PV_D0(3);
#undef PV_D0
#undef TRRD
}
__device__ __forceinline__ float red8(float v) {
    v += __int_as_float(__builtin_amdgcn_update_dpp(0, __float_as_int(v), 0xB1, 0xF, 0xF, true));
    v += __int_as_float(__builtin_amdgcn_update_dpp(0, __float_as_int(v), 0x4E, 0xF, 0xF, true));
    v += __int_as_float(__builtin_amdgcn_update_dpp(0, __float_as_int(v), 0x141, 0xF, 0xF, true));
    return v;
}
template <int MODE>
__device__ __forceinline__ void score_mod(f32x16& e0, f32x16& e1, int kidx, int t_row, float sl2, int hi, bool rowok) {
    if (MODE == 0) {
#pragma unroll
        for (int r = 0; r < 16; ++r) { e0[r] *= QK_C2; e1[r] *= QK_C2; }
        return;
    }
    constexpr int CS = (MODE == 1) ? 16 : 1;
    constexpr unsigned W = (MODE == 3) ? 512u : 0x7fffffffu;
    const int dqa = (MODE == 1) ? (t_row - 31 - 1024 * kidx - 64 * hi) : (t_row - kidx - 4 * hi);
    const int dqb = dqa - 32 * CS;
    const float slc = sl2 * (float)CS, ba = -sl2 * (float)dqa, bb = -sl2 * (float)dqb;
    const float NEG = -__builtin_inff();
#pragma unroll
    for (int r = 0; r < 16; ++r) { const int c = (r & 3) + 8 * (r >> 2);
        const float xa = fmaf(e0[r], QK_C2, fmaf(slc, (float)c, ba)), xb = fmaf(e1[r], QK_C2, fmaf(slc, (float)c, bb));
        e0[r] = (rowok && (unsigned)(dqa - CS * c) < W) ? xa : NEG;
        e1[r] = (rowok && (unsigned)(dqb - CS * c) < W) ? xb : NEG; }
}
template <int MODE, int PASS>
__device__ __forceinline__ void attn_pass(LAS unsigned char* lds, const bf16_t* Kp, const bf16_t* Vp, int pitch, int NT, int kb0,
                                          const bf16x8 (&qr)[8], float& m, float& l, float gate, float invl, f32x16 (&o)[4], int t_row, float sl2, int tokl) {
    const int tid = otid(), lane = tid & 63, r32 = lane & 31, hi = lane >> 5;
    const int sr = tid >> 4, sc = (tid & 15) * 8, vst0 = v_st(sr, sc), vst1 = v_st(32 + sr, sc), kws = KSWZ(sr, sc * 2);
    const int vb0 = (int)(uintptr_t)lds + V_OFF + v_rd_base(lane);
    const LAS int* TL = (const LAS int*)(lds + TL_OFF);
    const LAS unsigned* SELW = (const LAS unsigned*)(lds + SELW_OFF);
    LAS float* SG = (LAS float*)(lds + SG_OFF); LAS float* SL = (LAS float*)(lds + SL_OFF);
    bf16x8 st_k0, st_k1, st_v0, st_v1;
#define KEY0(i) ((MODE == 2) ? 64 * TL[(i)] : kb0 + 64 * (i))
#define A_LOAD(k0_) do { st_k0 = *(const bf16x8*)(Kp + (size_t)((k0_) + sr) * pitch + sc); st_k1 = *(const bf16x8*)(Kp + (size_t)((k0_) + 32 + sr) * pitch + sc); \
        if (PASS == 2) { st_v0 = *(const bf16x8*)(Vp + (size_t)((k0_) + sr) * pitch + sc); st_v1 = *(const bf16x8*)(Vp + (size_t)((k0_) + 32 + sr) * pitch + sc); } } while (0)
#define A_WRITE(bf) do { *(LAS bf16x8*)(lds + K_OFF + (bf) * SHM + kws) = st_k0; *(LAS bf16x8*)(lds + K_OFF + (bf) * SHM + kws + 32 * 256) = st_k1; \
        if (PASS == 2) { *(LAS bf16x8*)(lds + V_OFF + (bf) * SHM + vst0) = st_v0; *(LAS bf16x8*)(lds + V_OFF + (bf) * SHM + vst1) = st_v1; } } while (0)
#define A_STEP(i, BUF) do { \
        const bool more_ = (i) + 1 < NT; const int kcur_ = KEY0(i); \
        if (more_) { const int kn_ = KEY0((i) + 1); A_LOAD(kn_); } \
        bool rowok_ = true; bool act_ = true; \
        if (MODE == 2) { const int n_ = kcur_ >> 6; rowok_ = ((SELW[tokl * 4 + (n_ >> 5)] >> (n_ & 31)) & 1u) != 0u; act_ = __any(rowok_); } \
        if (act_) { \
            f32x16 e0, e1; qkt(e0, e1, lds + K_OFF + (BUF) * SHM, r32, hi, qr); SBAR(); \
            score_mod<MODE>(e0, e1, (MODE == 1) ? (i) : kcur_, t_row, sl2, hi, rowok_); \
            if (PASS == 1) { \
                float tmax = e0[0]; _Pragma("unroll") for (int r = 1; r < 16; ++r) tmax = fmaxf(tmax, e0[r]); _Pragma("unroll") for (int r = 0; r < 16; ++r) tmax = fmaxf(tmax, e1[r]); \
                { auto rr = __builtin_amdgcn_permlane32_swap(__float_as_uint(tmax), __float_as_uint(tmax), false, false); tmax = fmaxf(__uint_as_float(rr[0]), __uint_as_float(rr[1])); } \
                const float mn = fmaxf(m, tmax); float ps = 0.f; \
                _Pragma("unroll") for (int r = 0; r < 16; ++r) ps += __builtin_amdgcn_exp2f(e0[r] - mn); _Pragma("unroll") for (int r = 0; r < 16; ++r) ps += __builtin_amdgcn_exp2f(e1[r] - mn); \
                { auto rr = __builtin_amdgcn_permlane32_swap(__float_as_uint(ps), __float_as_uint(ps), false, false); ps = __uint_as_float(rr[0]) + __uint_as_float(rr[1]); } \
                l = l * __builtin_amdgcn_exp2f(m - mn) + ps; m = mn; \
            } else { \
                const float f1_ = (MODE == 1) ? invl : gate * invl; \
                _Pragma("unroll") for (int r = 0; r < 16; ++r) { e0[r] = __builtin_amdgcn_exp2f(e0[r] - m) * f1_; e1[r] = __builtin_amdgcn_exp2f(e1[r] - m) * f1_; } \
                if (MODE == 1) { \
                    _Pragma("unroll") for (int rq = 0; rq < 4; ++rq) { \
                        float ga = (e0[4 * rq] + e0[4 * rq + 1]) + (e0[4 * rq + 2] + e0[4 * rq + 3]), la = e0[4 * rq + 3]; \
                        float gb = (e1[4 * rq] + e1[4 * rq + 1]) + (e1[4 * rq + 2] + e1[4 * rq + 3]), lb = e1[4 * rq + 3]; \
                        ga = red8(ga); la = red8(la); gb = red8(gb); lb = red8(lb); \
                        if ((r32 & 7) == 0) { const int na = 16 * (i) + 2 * rq + hi; SG[tokl * 128 + na] = ga; SL[tokl * 128 + na] = la; SG[tokl * 128 + na + 8] = gb; SL[tokl * 128 + na + 8] = lb; } } \
                    _Pragma("unroll") for (int r = 0; r < 16; ++r) { e0[r] *= gate; e1[r] *= gate; } \
                } \
                bf16x8 pa0, pa1, pa2, pa3; \
                PK4(e0, 0, pa0); PK4(e0, 8, pa1); PK4(e1, 0, pa2); PK4(e1, 8, pa3); \
                SBAR(); pv_tile(o, vb0 + (BUF) * SHM, pa0, pa1, pa2, pa3); \
            } \
        } \
        if (more_) { VM_WAIT(); A_WRITE((BUF) ^ 1); } \
        __syncthreads(); } while (0)
#define PK4(P, B_, OUT) do { unsigned a0 = cvtpk(P[B_ + 0], P[B_ + 1]), a1 = cvtpk(P[B_ + 2], P[B_ + 3]); \
        unsigned b0 = cvtpk(P[B_ + 4], P[B_ + 5]), b1 = cvtpk(P[B_ + 6], P[B_ + 7]); \
        auto r0 = __builtin_amdgcn_permlane32_swap(a0, b0, false, false); auto r1 = __builtin_amdgcn_permlane32_swap(a1, b1, false, false); \
        u32x4 w = {r0[0], r1[0], r0[1], r1[1]}; OUT = *reinterpret_cast<bf16x8*>(&w); } while (0)
    if (NT <= 0) return;
    { const int k0 = KEY0(0); A_LOAD(k0); VM_WAIT(); A_WRITE(0); }
    __syncthreads();
#pragma unroll 1
    for (int i = 0; i < NT; ++i) { const int buf = i & 1; A_STEP(i, buf); }
#undef PK4
#undef A_STEP
#undef A_WRITE
#undef A_LOAD
#undef KEY0
}

template <int MODE>
__device__ __forceinline__ void attn_online(LAS unsigned char* lds, const bf16_t* Kp, const bf16_t* Vp, int NT, int kb0,
                                            const bf16x8 (&qr)[8], float& m, float& l, f32x16 (&o)[4], int t_row, int tw0, float sl2, int tokl) {
    const int tid = otid(), lane = tid & 63, r32 = lane & 31, hi = lane >> 5, wave = __builtin_amdgcn_readfirstlane(tid >> 6);
    const int sr = tid >> 4, sc = (tid & 15) * 8, vst0 = v_st(sr, sc), vst1 = v_st(32 + sr, sc), kws = KSWZ(sr, sc * 2);
    const int vb0 = (int)(uintptr_t)lds + V_OFF + v_rd_base(lane);
    const LAS int* TL = (const LAS int*)(lds + TL_OFF);
    const LAS unsigned* SELW = (const LAS unsigned*)(lds + SELW_OFF);
    LAS float* alf = (LAS float*)(lds + ALF_OFF) + wave * 64;
    constexpr int pitch = HD;
    bf16x8 st_k0, st_k1, st_v0, st_v1;
    bf16x8 kx0, kx1, qx;
    { const float kr = (float)r32, bh = sl2 * (1.0f / QK_C2); const unsigned bhb = cvtpk(bh, 0.f) & 0xffffu; const float bl = bh - __uint_as_float(bhb << 16);
      u32x4 a = {hi == 0 ? cvtpk(kr, kr) : 0u, 0u, 0u, 0u}, b = {hi == 0 ? cvtpk(kr + 32.f, kr + 32.f) : 0u, 0u, 0u, 0u}, c = {hi == 0 ? cvtpk(bh, bl) : 0u, 0u, 0u, 0u};
      kx0 = *reinterpret_cast<bf16x8*>(&a); kx1 = *reinterpret_cast<bf16x8*>(&b); qx = *reinterpret_cast<bf16x8*>(&c); }
#define KEY0(i) ((MODE == 2) ? 64 * TL[(i)] : kb0 + 64 * (i))
#define A_LOAD(k0_) do { st_k0 = *(const bf16x8*)(Kp + (size_t)((k0_) + sr) * pitch + sc); st_k1 = *(const bf16x8*)(Kp + (size_t)((k0_) + 32 + sr) * pitch + sc); \
        st_v0 = *(const bf16x8*)(Vp + (size_t)((k0_) + sr) * pitch + sc); st_v1 = *(const bf16x8*)(Vp + (size_t)((k0_) + 32 + sr) * pitch + sc); } while (0)
#define A_WRITE(bf) do { *(LAS bf16x8*)(lds + K_OFF + (bf) * SHM + kws) = st_k0; *(LAS bf16x8*)(lds + K_OFF + (bf) * SHM + kws + 32 * 256) = st_k1; \
        *(LAS bf16x8*)(lds + V_OFF + (bf) * SHM + vst0) = st_v0; *(LAS bf16x8*)(lds + V_OFF + (bf) * SHM + vst1) = st_v1; } while (0)
#define PK4(P, B_, OUT) do { unsigned a0 = cvtpk(P[B_ + 0], P[B_ + 1]), a1 = cvtpk(P[B_ + 2], P[B_ + 3]); \
        unsigned b0 = cvtpk(P[B_ + 4], P[B_ + 5]), b1 = cvtpk(P[B_ + 6], P[B_ + 7]); \
        auto r0 = __builtin_amdgcn_permlane32_swap(a0, b0, false, false); auto r1 = __builtin_amdgcn_permlane32_swap(a1, b1, false, false); \
        u32x4 w = {r0[0], r1[0], r0[1], r1[1]}; OUT = *reinterpret_cast<bf16x8*>(&w); } while (0)
    if (NT <= 0) return;
    { const int k0 = KEY0(0); A_LOAD(k0); VM_WAIT(); A_WRITE(0); }
    __syncthreads();
#pragma unroll 1
    for (int i = 0; i < NT; ++i) {
        const int buf = i & 1; const bool more = i + 1 < NT; const int kcur = KEY0(i);
        if (more) { const int kn = KEY0(i + 1); A_LOAD(kn); }
        bool rowok = true, act = true;
        if (MODE == 2) { const int n_ = kcur >> 6; rowok = ((SELW[tokl * 4 + (n_ >> 5)] >> (n_ & 31)) & 1u) != 0u; act = __any(rowok); }
        if (act) {
            f32x16 e0, e1; qkt(e0, e1, lds + K_OFF + buf * SHM, r32, hi, qr);
            e0 = __builtin_amdgcn_mfma_f32_32x32x16_bf16(kx0, qx, e0, 0, 0, 0);
            e1 = __builtin_amdgcn_mfma_f32_32x32x16_bf16(kx1, qx, e1, 0, 0, 0);
            SBAR();
            const float NEG = -__builtin_inff();
            const float tb = rowok ? -sl2 * (float)(t_row - kcur) : NEG;
#pragma unroll
            for (int r = 0; r < 16; ++r) { e0[r] = fmaf(e0[r], QK_C2, tb); e1[r] = fmaf(e1[r], QK_C2, tb); }
            const bool interior = (MODE == 3) ? (kcur + 63 <= tw0 && kcur >= tw0 + 3 - 511) : (kcur + 63 <= tw0);
            if (!interior) {
                constexpr unsigned W = (MODE == 3) ? 512u : 0x7fffffffu;
                const int dqa = t_row - kcur - 4 * hi, dqb = dqa - 32;
#pragma unroll
                for (int r = 0; r < 16; ++r) { const int c = (r & 3) + 8 * (r >> 2);
                    if ((unsigned)(dqa - c) >= W) e0[r] = NEG;
                    if ((unsigned)(dqb - c) >= W) e1[r] = NEG; }
            }
            float pmax = e0[0];
#pragma unroll
            for (int r = 1; r < 16; ++r) pmax = fmaxf(pmax, e0[r]);
#pragma unroll
            for (int r = 0; r < 16; ++r) pmax = fmaxf(pmax, e1[r]);
            { auto rr = __builtin_amdgcn_permlane32_swap(__float_as_uint(pmax), __float_as_uint(pmax), false, false); pmax = fmaxf(__uint_as_float(rr[0]), __uint_as_float(rr[1])); }
            float mn, alpha;
            if (__all((pmax - m) <= THR2)) { mn = m; alpha = 1.f; }
            else { mn = fmaxf(m, pmax); alpha = __builtin_amdgcn_exp2f(m - mn); m = mn; }
            float ps = 0.f;
#pragma unroll
            for (int r = 0; r < 16; ++r) { e0[r] = __builtin_amdgcn_exp2f(e0[r] - mn); e1[r] = __builtin_amdgcn_exp2f(e1[r] - mn); ps += e0[r] + e1[r]; }
            { auto rr = __builtin_amdgcn_permlane32_swap(__float_as_uint(ps), __float_as_uint(ps), false, false); ps = __uint_as_float(rr[0]) + __uint_as_float(rr[1]); }
            l = l * alpha + ps;
            if (__any(alpha < 1.f)) { if (hi == 0) alf[r32] = alpha; asm volatile("s_waitcnt lgkmcnt(0)" ::: "memory");
#pragma unroll
                for (int r = 0; r < 16; ++r) { const float a_ = alf[crow(r, hi)];
#pragma unroll
                    for (int d0 = 0; d0 < 4; ++d0) o[d0][r] *= a_; }
                asm volatile("s_waitcnt lgkmcnt(0)" ::: "memory"); }
            bf16x8 pa0, pa1, pa2, pa3;
            PK4(e0, 0, pa0); PK4(e0, 8, pa1); PK4(e1, 0, pa2); PK4(e1, 8, pa3);
            SBAR(); pv_tile(o, vb0 + buf * SHM, pa0, pa1, pa2, pa3);
        }
        if (more) { VM_WAIT(); A_WRITE(buf ^ 1); }
        __syncthreads();
    }
#undef PK4
#undef A_WRITE
#undef A_LOAD
#undef KEY0
}
__device__ __forceinline__ void scale_rows(LAS unsigned char* lds, f32x16 (&o)[4], float fac, int wave, int r32, int hi) {
    LAS float* alf = (LAS float*)(lds + ALF_OFF) + wave * 64;
    if (hi == 0) alf[r32] = fac;
    asm volatile("s_waitcnt lgkmcnt(0)" ::: "memory");
#pragma unroll
    for (int r = 0; r < 16; ++r) { const float a_ = alf[crow(r, hi)];
#pragma unroll
        for (int d0 = 0; d0 < 4; ++d0) o[d0][r] *= a_; }
    asm volatile("s_waitcnt lgkmcnt(0)" ::: "memory");
}
#define ATT_STORE_O(ROWPTR_EXPR) do { \
    _Pragma("unroll") for (int r = 0; r < 16; ++r) { const int orow = att::crow(r, hi); bf16_t* op_ = (ROWPTR_EXPR); \
        _Pragma("unroll") for (int d0 = 0; d0 < 4; ++d0) { const float v = o[d0][r]; const float vn = __shfl_xor(v, 1); \
            if ((r32 & 1) == 0) *(unsigned*)(op_ + d0 * 32 + r32) = cvtpk(v, vn); } } } while (0)
}

__device__ __forceinline__ void phase_xattn(Frame& F, int L) {
    const bf16_t* QX = (const bf16_t*)(F.ws + WS_QX); const bf16_t* KVM = (const bf16_t*)(F.ws + WS_KVMEM) + (size_t)L * MMEM * 2 * XAW; bf16_t* OX = (bf16_t*)(F.ws + WS_OX);
    for (int u = F.bid; u < BATCH * 4 * (SEQ / 256); u += F.G) {
        const int tid = otid(), lane = tid & 63, r32 = lane & 31, hi = lane >> 5, wave = __builtin_amdgcn_readfirstlane(tid >> 6);
        const int qb = u % (SEQ / 256), hd = (u / (SEQ / 256)) & 3, b = u / (4 * (SEQ / 256));
        const int t = qb * 256 + wave * 32 + r32; const size_t row = (size_t)b * SEQ + t;
        bf16x8 qr[8];
#pragma unroll
        for (int d0 = 0; d0 < 8; ++d0) qr[d0] = *(const bf16x8*)(QX + row * XAW + hd * HD + d0 * 16 + hi * 8);
        const bf16_t* Kp = KVM + (size_t)b * MEMLEN * 2 * XAW + hd * HD; const bf16_t* Vp = Kp + XAW;
        f32x16 o[4];
#pragma unroll
        for (int d0 = 0; d0 < 4; ++d0)
#pragma unroll
            for (int r = 0; r < 16; ++r) o[d0][r] = 0.f;
        float m = -1e30f, l = 0.f;
        att::attn_pass<0, 1>(F.lds, Kp, Vp, 2 * XAW, MEMLEN / 64, 0, qr, m, l, 1.f, 1.f, o, 0, 0.f, 0);
        const float invl = l > 0.f ? 1.0f / l : 0.f;
        att::attn_pass<0, 2>(F.lds, Kp, Vp, 2 * XAW, MEMLEN / 64, 0, qr, m, l, 1.f, invl, o, 0, 0.f, 0);
        ATT_STORE_O(OX + ((size_t)b * SEQ + qb * 256 + wave * 32 + orow) * XAW + hd * HD);
    }
}

__device__ __forceinline__ void phase_nsa(Frame& F) {
    const bf16_t* NQ = (const bf16_t*)(F.ws + WS_NQ); const bf16_t* NKV = (const bf16_t*)(F.ws + WS_NKV); const bf16_t* KVC = (const bf16_t*)(F.ws + WS_KVC);
    const float* GT = (const float*)(F.ws + WS_GATES); bf16_t* NO = (bf16_t*)(F.ws + WS_NO);
    LAS unsigned char* lds = F.lds;
    LAS float* SG = (LAS float*)(lds + att::SG_OFF); LAS float* SL = (LAS float*)(lds + att::SL_OFF);
    LAS unsigned* SELW = (LAS unsigned*)(lds + att::SELW_OFF); LAS int* TL = (LAS int*)(lds + att::TL_OFF);
    constexpr int NQB = SEQ / 32, NUNITS = BATCH * NSA_G * NQB;
    for (int u = F.bid; u < NUNITS; u += F.G) {
        const int tid = otid(), lane = tid & 63, r32 = lane & 31, hi = lane >> 5, wave = __builtin_amdgcn_readfirstlane(tid >> 6);
        const int qb = NQB - 1 - u / (BATCH * NSA_G), bg = u % (BATCH * NSA_G), b = bg >> 2, g = bg & 3;
        const int t0 = qb * 32, tokl = 4 * wave + (r32 >> 3), j = r32 & 7, t = t0 + tokl, head = g * 8 + j;
        const size_t row = (size_t)b * SEQ + t;
        const float sl2 = __builtin_amdgcn_exp2f(-0.25f * (float)(head + 1)) * LOG2E;
        bf16x8 qr[8];
#pragma unroll
        for (int d0 = 0; d0 < 8; ++d0) qr[d0] = *(const bf16x8*)(NQ + row * QW + head * HD + d0 * 16 + hi * 8);
        const float g_c = GT[row * GW_ + head], g_s = GT[row * GW_ + 32 + head], g_w = GT[row * GW_ + 64 + head];
        for (int i = tid; i < 8192; i += NTHR) SG[i] = 0.f;
        __syncthreads();
        f32x16 o[4];
#pragma unroll
        for (int d0 = 0; d0 < 4; ++d0)
#pragma unroll
            for (int r = 0; r < 16; ++r) o[d0][r] = 0.f;
        const int tw0 = t0 + 4 * wave;
        { const int jlo = (t0 - 511 > 0 ? t0 - 511 : 0) >> 6, jhi = (t0 + 31) >> 6, NTw = jhi - jlo + 1;
          const bf16_t* Kw = NKV + ((size_t)((((2 * 2 + 0) * 2 + b) * 4 + g)) * SEQ) * HD; const bf16_t* Vw = NKV + ((size_t)((((2 * 2 + 1) * 2 + b) * 4 + g)) * SEQ) * HD;
          float m = -1e30f, l = 0.f;
          att::attn_online<3>(lds, Kw, Vw, NTw, jlo * 64, qr, m, l, o, t, tw0, sl2, tokl);
          att::scale_rows(lds, o, l > 0.f ? g_w / l : 0.f, wave, r32, hi); }
        { const bf16_t* Kc = KVC + (size_t)(bg * 512) * HD; const bf16_t* Vc = KVC + (size_t)(4096 + bg * 512) * HD;
          const int NTc = t0 / 1024 + 1; float m = -1e30f, l = 0.f;
          att::attn_pass<1, 1>(lds, Kc, Vc, HD, NTc, 0, qr, m, l, g_c, 0.f, o, t, sl2, tokl);
          const float invl = l > 0.f ? 1.0f / l : 0.f;
          att::attn_pass<1, 2>(lds, Kc, Vc, HD, NTc, 0, qr, m, l, g_c, invl, o, t, sl2, tokl); }
        for (int i4 = 0; i4 < 4; ++i4) {
            const int tk = 4 * wave + i4, cur = (t0 + tk) >> 6, n0 = lane, n1 = lane + 64;
            const float s0 = SG[tk * 128 + n0] + (n0 > 0 ? SL[tk * 128 + n0 - 1] : 0.f), s1 = SG[tk * 128 + n1] + SL[tk * 128 + n1 - 1];
            float v0 = n0 > cur ? -2.f : ((n0 == 0 || n0 == cur || n0 == cur - 1) ? 1e6f : s0);
            float v1 = n1 > cur ? -2.f : ((n1 == cur || n1 == cur - 1) ? 1e6f : s1);
            unsigned w0 = 0u, w1 = 0u, w2 = 0u, w3 = 0u;
            for (int k = 0; k < 16; ++k) {
                const float mx = wave_max(fmaxf(v0, v1));
                if (!(mx > -1.f)) break;
                const unsigned long long b0 = __ballot(v0 == mx); int n;
                if (b0) n = __builtin_ctzll(b0); else { const unsigned long long b1 = __ballot(v1 == mx); if (!b1) break; n = 64 + __builtin_ctzll(b1); }
                const unsigned bit = 1u << (n & 31);
                if (n < 32) w0 |= bit; else if (n < 64) w1 |= bit; else if (n < 96) w2 |= bit; else w3 |= bit;
                if (n < 64) { if (lane == n) v0 = -2.f; } else { if (lane == n - 64) v1 = -2.f; }
            }
            if (lane == 0) { SELW[tk * 4 + 0] = w0; SELW[tk * 4 + 1] = w1; SELW[tk * 4 + 2] = w2; SELW[tk * 4 + 3] = w3; }
        }
        __syncthreads();
        if (wave == 0) {
            unsigned u0 = 0u, u1 = 0u;
            for (int tk = 0; tk < 32; ++tk) { u0 |= (SELW[tk * 4 + (lane >> 5)] >> (lane & 31)) & 1u; u1 |= (SELW[tk * 4 + 2 + (lane >> 5)] >> (lane & 31)) & 1u; }
            const unsigned long long b0 = __ballot(u0 != 0u), b1 = __ballot(u1 != 0u), lt = (1ull << lane) - 1ull; const int c0 = __builtin_popcountll(b0);
            if (u0) TL[__builtin_popcountll(b0 & lt)] = lane;
            if (u1) TL[c0 + __builtin_popcountll(b1 & lt)] = 64 + lane;
            if (lane == 0) TL[128] = c0 + __builtin_popcountll(b1);
        }
        float* stash = (float*)(F.ws + WS_STASH) + ((size_t)(F.bid * NWAVES + wave) * 64) * 64 + lane;
#pragma unroll
        for (int d0 = 0; d0 < 4; ++d0)
#pragma unroll
            for (int r = 0; r < 16; ++r) { stash[(d0 * 16 + r) * 64] = o[d0][r]; o[d0][r] = 0.f; }
        __syncthreads();
        { const int NTs = TL[128]; const bf16_t* Ks = NKV + ((size_t)((((1 * 2 + 0) * 2 + b) * 4 + g)) * SEQ) * HD; const bf16_t* Vs = NKV + ((size_t)((((1 * 2 + 1) * 2 + b) * 4 + g)) * SEQ) * HD;
          float m = -1e30f, l = 0.f;
          att::attn_online<2>(lds, Ks, Vs, NTs, 0, qr, m, l, o, t, tw0, sl2, tokl);
          att::scale_rows(lds, o, l > 0.f ? g_s / l : 0.f, wave, r32, hi); }
#pragma unroll
        for (int d0 = 0; d0 < 4; ++d0)
#pragma unroll
            for (int r = 0; r < 16; ++r) o[d0][r] += stash[(d0 * 16 + r) * 64];
        ATT_STORE_O(NO + ((size_t)b * SEQ + t0 + 4 * wave + (orow >> 3)) * QW + (g * 8 + (orow & 7)) * HD);
    }
}

constexpr int NPH = 30;
__global__ void __launch_bounds__(NTHR, 2) mk_fwd(Args args) {
    extern __shared__ __attribute__((aligned(16))) unsigned char lds_raw[];
    Frame F;
    F.lds = (LAS unsigned char*)lds_raw;
    F.MISC = (volatile LAS unsigned*)(F.lds + MISC_OFF);
    F.G = gridDim.x; F.bid = blockIdx.x; F.ws = args.ws; F.out = args.out;
    F.ctl = (unsigned*)(args.ws + WS_CTL);
    for (int u = threadIdx.x; u < (LDS_BYTES - LDSCTL_OFF) / 4; u += NTHR) ((LAS unsigned*)(F.lds + LDSCTL_OFF))[u] = 0u;
    __syncthreads();
    const int lo = args.ph_lo, hi = args.ph_hi;
    XcdBarrier bar; bar.bar = F.ctl + CW_BAR; bar.x = 0; bar.st = nullptr;
    if (hi - lo > 1) bar = xcd_barrier_post(F.ctl + CW_BAR, F.MISC + 8);
#ifndef PH_MASK
#define PH_MASK 0xffffffffu
#endif
#define EN(i) ((PH_MASK >> (i)) & 1u)
#ifndef REP_MASK
#define REP_MASK 0u
#endif
#define REPS(i) (1 + (int)((REP_MASK >> (i)) & 1u))
#define IN(k) (lo <= (k) && (k) < hi)
#define SEAM(k) do { if ((k) + 1 < hi) xcd_barrier(bar); } while (0)
    unsigned char* ws = args.ws;
    bf16_t* HN = (bf16_t*)(ws + WS_HN); bf16_t* Yb = (bf16_t*)(ws + WS_Y); float* SSP = (float*)(ws + WS_SSP);

    if (EN(0) && IN(0)) { for (int rep_ = 0; rep_ < REPS(0); ++rep_) { phase_p0(F, args); } SEAM(0); }
    if (EN(1) && IN(1)) {
        _Pragma("unroll 1") for (int rep_ = 0; rep_ < REPS(1); ++rep_) {
        {
            pg8::Gemm g{(const bf16_t*)(ws + WS_MEMN), (const bf16_t*)(ws + WS_XAKV), DM, DM, 0, 0}; pg8::StaticOrder S; S.init(MMEM, 2 * 2 * XAW, F.G, F.bid);
            pg8::EpiPlain E{(bf16_t*)(ws + WS_KVMEM), 2 * XAW, 2 * XAW, (size_t)MMEM * 2 * XAW, nullptr};
            pg8::gemm_phase<pg8::EpiPlain>(F.lds, g, S, E);
        }
        phase_poolprep(F, args);
        {
            const int idx = F.bid * NTHR + otid();
            if (idx < 2 * CMP_HID) { const float* part = (const float*)(ws + WS_CMPB + 65536); float s = args.in[IN_CMP_B1][idx];
                for (int ks = 0; ks < 16; ++ks) s += part[((idx >> 9) * 16 + ks) * CMP_HID + (idx & 511)];
                ((float*)(ws + WS_CMPB))[idx] = s; }
        }
        }
        SEAM(1);
    }
#pragma unroll 1
    for (int L = 0; L < 2; ++L) {
        const int pb = 2 + 14 * L;
        const float* ln_mix = args.in[IN_LN_MIX] + (size_t)L * 2 * DM; const float* ln_xa = args.in[IN_LN_XA] + (size_t)L * 2 * DM; const float* ln_ffn = args.in[IN_LN_FFN] + (size_t)L * 2 * DM;
        if (L == 0) {
            if (EN(2) && IN(pb)) {
                _Pragma("unroll 1") for (int rep_ = 0; rep_ < REPS(2); ++rep_) {
                pg8::Gemm g{HN, (const bf16_t*)(ws + WS_POOLW), DM, PGC, 4, (size_t)PGC}; pg8::StaticOrder S; S.init(MTOK, DM, F.G, F.bid);
                pg8::EpiY E{Yb, DM, args.in[IN_POOL_SCALE], SSP, 64};
                pg8::gemm_phase<pg8::EpiY>(F.lds, g, S, E);
                }
                SEAM(pb);
            }
        } else {
            if (EN(3) && IN(pb)) {
                _Pragma("unroll 1") for (int rep_ = 0; rep_ < REPS(3); ++rep_) {
                pg8::Gemm g{HN, (const bf16_t*)(ws + WS_NSAIN), DM, DM, 0, 0}; pg8::StaticOrder S; S.init(MTOK, NSA_INP, F.G, F.bid);
                pg8::EpiNsaIn E{(bf16_t*)(ws + WS_NQ), (bf16_t*)(ws + WS_NKV), (float*)(ws + WS_GATES), (const float*)(ws + WS_RS)};
                pg8::gemm_phase<pg8::EpiNsaIn>(F.lds, g, S, E);
                }
                SEAM(pb);
            }
            if (EN(4) && IN(pb + 1)) {
                _Pragma("unroll 1") for (int rep_ = 0; rep_ < REPS(4); ++rep_) {
                pg8::Gemm g{(const bf16_t*)(ws + WS_NKV), (const bf16_t*)(ws + WS_CMPW1), 2048, 4096, 2, (size_t)8 * SEQ * HD}; pg8::StaticOrder S; S.init(4096, 2 * CMP_HID, F.G, F.bid);
                pg8::EpiGelu E{(bf16_t*)(ws + WS_HID), CMP_HID, (const float*)(ws + WS_CMPB), CMP_HID, (size_t)4096 * CMP_HID};
                pg8::gemm_phase<pg8::EpiGelu>(F.lds, g, S, E);
                }
                SEAM(pb + 1);
            }
            if (EN(5) && IN(pb + 2)) { for (int rep_ = 0; rep_ < REPS(5); ++rep_) { phase_cmp2(F); } SEAM(pb + 2); }
            if (EN(6) && IN(pb + 3)) { for (int rep_ = 0; rep_ < REPS(6); ++rep_) { phase_nsa(F); } SEAM(pb + 3); }
            if (EN(7) && IN(pb + 4)) {
                _Pragma("unroll 1") for (int rep_ = 0; rep_ < REPS(7); ++rep_) {
                pg8::Gemm g{(const bf16_t*)(ws + WS_NO), (const bf16_t*)(ws + WS_NSAOUT), QW, QW, 0, 0}; pg8::StaticOrder S; S.init(MTOK, DM, F.G, F.bid);
                pg8::EpiY E{Yb, DM, nullptr, SSP, 64};
                pg8::gemm_phase<pg8::EpiY>(F.lds, g, S, E);
                }
                SEAM(pb + 4);
            }
        }
        if (EN(8) && IN(pb + 5)) { for (int rep_ = 0; rep_ < REPS(8); ++rep_) { if (L == 0) phase_resid<true, false>(F, args.in[IN_X], ln_mix + DM); else phase_resid<false, false>(F, nullptr, ln_mix + DM); } SEAM(pb + 5); }
        if (EN(9) && IN(pb + 6)) {
            _Pragma("unroll 1") for (int rep_ = 0; rep_ < REPS(9); ++rep_) {
            pg8::Gemm g{HN, (const bf16_t*)(ws + WS_XAQ) + (size_t)L * XAW * DM, DM, DM, 0, 0}; pg8::StaticOrder S; S.init(MTOK, XAW, F.G, F.bid);
            pg8::EpiPlain E{(bf16_t*)(ws + WS_QX), XAW, 0, 0, (const float*)(ws + WS_RS)};
            pg8::gemm_phase<pg8::EpiPlain>(F.lds, g, S, E);
            }
            SEAM(pb + 6);
        }
        if (EN(10) && IN(pb + 7)) { for (int rep_ = 0; rep_ < REPS(10); ++rep_) { phase_xattn(F, L); } SEAM(pb + 7); }
        if (EN(11) && IN(pb + 8)) {
            _Pragma("unroll 1") for (int rep_ = 0; rep_ < REPS(11); ++rep_) {
            pg8::Gemm g{(const bf16_t*)(ws + WS_OX), (const bf16_t*)(ws + WS_XAO) + (size_t)L * DM * XAW, XAW, XAW, 0, 0}; pg8::StaticOrder S; S.init(MTOK, DM, F.G, F.bid);
            pg8::EpiY E{Yb, DM, nullptr, SSP, 64};
            pg8::gemm_phase<pg8::EpiY>(F.lds, g, S, E);
            }
            SEAM(pb + 8);
        }
        if (EN(12) && IN(pb + 9)) { for (int rep_ = 0; rep_ < REPS(12); ++rep_) { phase_resid<false, false>(F, nullptr, ln_xa + DM); } SEAM(pb + 9); }
        if (EN(13) && IN(pb + 10)) {
            _Pragma("unroll 1") for (int rep_ = 0; rep_ < REPS(13); ++rep_) {
            pg8::Gemm g{HN, (const bf16_t*)(ws + WS_WGU) + (size_t)L * DFF2 * DM, DM, DM, 0, 0}; pg8::StaticOrder S; S.init(MTOK, DFF2, F.G, F.bid);
            pg8::EpiGateUp E{(bf16_t*)(ws + WS_ACT), args.in[IN_FFN_CONVW] + (size_t)L * 3 * DFF, args.in[IN_FFN_CONVB] + (size_t)L * DFF, (float*)(ws + WS_HALO), (float*)(ws + WS_EDGE), F.lds, (const float*)(ws + WS_RS)};
            pg8::gemm_phase<pg8::EpiGateUp>(F.lds, g, S, E);
            }
            SEAM(pb + 10);
        }
        if (EN(14) && IN(pb + 11)) { for (int rep_ = 0; rep_ < REPS(14); ++rep_) { phase_actfix(F, args.in[IN_FFN_CONVW] + (size_t)L * 3 * DFF, args.in[IN_FFN_CONVB] + (size_t)L * DFF); } SEAM(pb + 11); }
        if (EN(15) && IN(pb + 12)) {
            _Pragma("unroll 1") for (int rep_ = 0; rep_ < REPS(15); ++rep_) {
            pg8::Gemm g{(const bf16_t*)(ws + WS_ACT), (const bf16_t*)(ws + WS_WDN) + (size_t)L * DM * DFF, DFF, DFF, 0, 0}; pg8::StaticOrder S; S.init(MTOK, DM, F.G, F.bid);
            pg8::EpiY E{Yb, DM, nullptr, SSP, 64};
            pg8::gemm_phase<pg8::EpiY>(F.lds, g, S, E);
            }
            SEAM(pb + 12);
        }
        if (EN(16) && IN(pb + 13)) { for (int rep_ = 0; rep_ < REPS(16); ++rep_) { if (L == 0) phase_resid<false, false>(F, nullptr, ln_ffn + DM); else phase_resid<false, true>(F, nullptr, ln_ffn + DM); } SEAM(pb + 13); }
    }
#undef IN
#undef EN
#undef SEAM
}

extern "C" void kernel_launch(void* const* d_in, const int* in_sizes, int n_in, void* d_out, int out_size, void* d_ws, size_t ws_size, hipStream_t stream) {
    static int grid = 0;
    if (grid == 0) {
        if (n_in != 21 || in_sizes[0] != MTOK * DM || out_size != MTOK * DM || ws_size < WS_END) {
            fprintf(stderr, "kernel_launch: unexpected shapes (n_in %d, in0 %d, out %d, ws %zu; need ws >= %zu); nothing launched\n", n_in, n_in > 0 ? in_sizes[0] : -1, out_size, ws_size, (size_t)WS_END); grid = -1; return; }
        int dev = 0, cus = 0, per_cu = 0;
        if (hipGetDevice(&dev) != hipSuccess || hipDeviceGetAttribute(&cus, hipDeviceAttributeMultiprocessorCount, dev) != hipSuccess) { fprintf(stderr, "kernel_launch: device query failed\n"); grid = -1; return; }
        if (hipFuncSetAttribute((const void*)mk_fwd, hipFuncAttributeMaxDynamicSharedMemorySize, LDS_BYTES) != hipSuccess) { fprintf(stderr, "kernel_launch: hipFuncSetAttribute failed\n"); grid = -1; return; }
        if (hipOccupancyMaxActiveBlocksPerMultiprocessor(&per_cu, (const void*)mk_fwd, NTHR, LDS_BYTES) != hipSuccess || per_cu < 1)
            fprintf(stderr, "kernel_launch: note: occupancy query reports %d workgroups per CU\n", per_cu);
        (void)hipGetLastError();
        grid = cus;
    }
    if (grid < 0) return;
    if (hipMemsetAsync((char*)d_ws + WS_CTL, 0, CTL_ZERO_BYTES, stream) != hipSuccess) { fprintf(stderr, "kernel_launch: memset failed\n"); return; }
    Args a{};
    for (int i = 0; i < 21; ++i) a.in[i] = (const float*)d_in[i];
    a.out = (float*)d_out; a.ws = (unsigned char*)d_ws;
#if MK_N_LAUNCHES == 1
    a.ph_lo = 0; a.ph_hi = NPH;
    hipLaunchKernelGGL(mk_fwd, dim3(grid), dim3(NTHR), LDS_BYTES, stream, a);
#else
    for (int ph = 0; ph < NPH; ++ph) {
        if (ph >= 3 && ph <= 6) continue;
        a.ph_lo = ph; a.ph_hi = ph + 1;
        hipLaunchKernelGGL(mk_fwd, dim3(grid), dim3(NTHR), LDS_BYTES, stream, a);
    }
#endif
    const hipError_t le = hipPeekAtLastError();
    if (le != hipSuccess) fprintf(stderr, "kernel_launch: launch failed: %s\n", hipGetErrorName(le));
}
```

```cpp
#include <hip/hip_runtime.h>
#include <cstdio>
#include <cstdint>

#ifndef MK_N_LAUNCHES
#define MK_N_LAUNCHES 1
#endif

#define GAS __attribute__((address_space(1)))
#define LAS __attribute__((address_space(3)))
typedef unsigned short bf16_t;
typedef short bf16x8 __attribute__((ext_vector_type(8)));
typedef short s16x4 __attribute__((ext_vector_type(4)));
typedef float f32x4 __attribute__((ext_vector_type(4)));
typedef float f32x2 __attribute__((ext_vector_type(2)));
typedef float f32x16 __attribute__((ext_vector_type(16)));
typedef unsigned u32x4 __attribute__((ext_vector_type(4)));
typedef unsigned u32x2 __attribute__((ext_vector_type(2)));

constexpr int NWAVES = 8, NTHR = 512;
constexpr int BATCH = 2, SEQ = 8192, DM = 4096, MTOK = BATCH * SEQ;
constexpr int MEMLEN = 256, MMEM = BATCH * MEMLEN;
constexpr int PGC = 1024;
constexpr int HD = 128, NSA_G = 4, NSA_J = 8;
constexpr int QW = 4096, KVW = 3072, GW_ = 96, NSA_INW = QW + KVW + GW_;
constexpr int NSA_INP = 7424;
constexpr int CMP_HID = 512, NCMP = 511, NSEL = 128;
constexpr int XAW = 512;
constexpr int DFF = 11008, DFF2 = 22016;
constexpr float RMS_EPS = 1e-6f;
constexpr float LOG2E = 1.4426950408889634f;
constexpr float QK_C2 = 1.4426950408889634f * 0.08838834764831845f;

constexpr size_t MiB = 1u << 20;
constexpr size_t WS_CTL = 0, CTL_ZERO_BYTES = 1 * MiB;
constexpr size_t WS_POOLW = 1 * MiB;
constexpr size_t WS_NSAIN = 9 * MiB;
constexpr size_t WS_NSAOUT = 67 * MiB;
constexpr size_t WS_CMPW1 = 99 * MiB;
constexpr size_t WS_CMPW2 = 107 * MiB;
constexpr size_t WS_XAQ = 108 * MiB;
constexpr size_t WS_XAKV = 116 * MiB;
constexpr size_t WS_XAO = 132 * MiB;
constexpr size_t WS_WGU = 140 * MiB;
constexpr size_t WS_WDN = 484 * MiB;
constexpr size_t WS_HN = 656 * MiB;
constexpr size_t WS_Y = 784 * MiB;
constexpr size_t WS_SSP = 912 * MiB;
constexpr size_t WS_XR = 916 * MiB;
constexpr size_t WS_RS = 916 * MiB + 256 * 1024;
constexpr size_t WS_CMPB = 916 * MiB + 512 * 1024;
constexpr size_t WS_MEMN = 917 * MiB;
constexpr size_t WS_KVMEM = 921 * MiB;
constexpr size_t WS_QX = 923 * MiB;
constexpr size_t WS_OX = 939 * MiB;
constexpr size_t WS_GU = 955 * MiB;
constexpr size_t WS_ACT = 1643 * MiB;
constexpr size_t WS_NQ = 1987 * MiB;
constexpr size_t WS_NKV = 2115 * MiB;
constexpr size_t WS_GATES = 2212 * MiB;
constexpr size_t WS_HID = 2218 * MiB;
constexpr size_t WS_KVC = 2226 * MiB;
constexpr size_t WS_NO = 2228 * MiB;
constexpr size_t WS_STASH = 2356 * MiB;
constexpr size_t WS_HALO = 2420 * MiB;
constexpr size_t WS_EDGE = 2426 * MiB;
constexpr size_t WS_END = 2438 * MiB;
constexpr int CW_BAR = 4096;

constexpr int RING_BYTES = 131072;
constexpr int LDSCTL_OFF = RING_BYTES, MISC_OFF = LDSCTL_OFF + 320;
constexpr int XCH_OFF = LDSCTL_OFF + 1024;
constexpr int LDS_BYTES = 147456;

#define LDS_WAIT() asm volatile("s_waitcnt lgkmcnt(0)" ::: "memory")
#define VM_WAIT() asm volatile("s_waitcnt vmcnt(0)" ::: "memory")
__device__ __forceinline__ unsigned cvtpk(float lo, float hi) { unsigned r; asm volatile("v_cvt_pk_bf16_f32 %0, %1, %2" : "=v"(r) : "v"(lo), "v"(hi)); return r; }
__device__ __forceinline__ float bflo(unsigned w) { return __uint_as_float(w << 16); }
__device__ __forceinline__ float bfhi(unsigned w) { return __uint_as_float(w & 0xffff0000u); }
__device__ __forceinline__ int otid_w(int wave_s) { int z; asm volatile("v_mov_b32 %0, 0" : "=v"(z)); const int l = __builtin_amdgcn_mbcnt_hi(~0u, __builtin_amdgcn_mbcnt_lo(~0u, z)); return wave_s * 64 + l; }
#define otid() otid_w(F.wv)
template <class T> __device__ __forceinline__ T* optr(T* p) { asm volatile("" : "+s"(p)); return p; }
#define DPPF0(v, ctrl) __int_as_float(__builtin_amdgcn_update_dpp(0, __float_as_int(v), (ctrl), 0xF, 0xF, true))
__device__ __forceinline__ float wave_sum(float v) {
    v += DPPF0(v, 0xB1); v += DPPF0(v, 0x4E); v += DPPF0(v, 0x141); v += DPPF0(v, 0x140);
    v += __int_as_float(__builtin_amdgcn_ds_swizzle(__float_as_int(v), 0x401F));
    { auto rr = __builtin_amdgcn_permlane32_swap(__float_as_uint(v), __float_as_uint(v), false, false); v = __uint_as_float(rr[0]) + __uint_as_float(rr[1]); }
    return v;
}
#define DPPF(v, ctrl) __int_as_float(__builtin_amdgcn_update_dpp(__float_as_int(v), __float_as_int(v), (ctrl), 0xF, 0xF, false))
__device__ __forceinline__ float wave_max(float v) {
    v = fmaxf(v, DPPF(v, 0xB1)); v = fmaxf(v, DPPF(v, 0x4E)); v = fmaxf(v, DPPF(v, 0x141)); v = fmaxf(v, DPPF(v, 0x140));
    v = fmaxf(v, DPPF(v, 0x142)); v = fmaxf(v, DPPF(v, 0x143));
    return __int_as_float(__builtin_amdgcn_readlane(__float_as_int(v), 63));
}
__device__ __forceinline__ float sigmoidf_(float x) { return __builtin_amdgcn_rcpf(1.0f + __builtin_amdgcn_exp2f(-x * LOG2E)); }
__device__ __forceinline__ float gelu_tanh(float x) { const float u = 0.7978845608028654f * (x + 0.044715f * x * x * x); return x * __builtin_amdgcn_rcpf(1.0f + __builtin_amdgcn_exp2f(-2.0f * LOG2E * u)); }

#define XB_TMO      128
#define XB_XCNT(j)  (256  + 64 * (j))
#define XB_XSUB(j)  (1280 + 64 * (j))
#define XB_XGEN(j)  (2304 + 64 * (j))
#define XB_TOP      3328
#define XB_TOPGEN   3392
#define XCD_BAR_WORDS 3456
#define XB_SPIN_CAP (1u << 18)
__device__ __forceinline__ unsigned xb_ld(unsigned* p)              { return __hip_atomic_load(p, __ATOMIC_RELAXED, __HIP_MEMORY_SCOPE_AGENT); }
__device__ __forceinline__ unsigned xb_add(unsigned* p, unsigned v) { return __hip_atomic_fetch_add(p, v, __ATOMIC_RELAXED, __HIP_MEMORY_SCOPE_AGENT); }
__device__ __forceinline__ unsigned xb_xcc_id() { return (unsigned)__builtin_amdgcn_s_getreg((3 << 11) | 20) & 0xFu; }
#define XB_SPIN(cond, bar) do { unsigned _sp = 0; while (cond) { __builtin_amdgcn_s_sleep(1); \
    if ((++_sp & 255u) == 0u) { if (xb_ld(&(bar)[XB_TMO])) break; if (_sp > XB_SPIN_CAP) { atomicAdd(&(bar)[XB_TMO], 1u); break; } } } } while (0)
struct XcdBarrier { unsigned* bar; unsigned x; volatile LAS unsigned* st; };
__device__ __forceinline__ XcdBarrier xcd_barrier_post(unsigned* bar, volatile LAS unsigned* st) {
    XcdBarrier b; b.bar = bar; b.x = xb_xcc_id(); b.st = st;
    if (threadIdx.x == 0) (void)xb_add(&bar[XB_XCNT(b.x)], 1u);
    return b;
}
__device__ __forceinline__ void xcd_barrier_complete(unsigned* bar, unsigned x, unsigned& nloc, unsigned& nx) {
    const unsigned G = gridDim.x * gridDim.y * gridDim.z;
    unsigned sum, cnt, mine, sp = 0u;
    for (;;) {
        sum = 0u; cnt = 0u; mine = 0u;
#pragma unroll 1
        for (unsigned j = 0; j < 16; ++j) { const unsigned c = xb_ld(&bar[XB_XCNT(j)]); sum += c; cnt += (c > 0u) ? 1u : 0u; mine = (j == x) ? c : mine; }
        if (sum == G) break;
        __builtin_amdgcn_s_sleep(1);
        if ((++sp & 255u) == 0u) { if (xb_ld(&bar[XB_TMO])) break; if (sp > XB_SPIN_CAP) { atomicAdd(&bar[XB_TMO], 1u); break; } }
    }
    nloc = mine > 0u ? mine : 1u; nx = cnt > 0u ? cnt : 1u;
}
__device__ __forceinline__ void xcd_barrier(const XcdBarrier& b) {
    asm volatile("s_waitcnt vmcnt(0)" ::: "memory");
    __syncthreads();
    if (threadIdx.x == 0) {
        unsigned* bar = b.bar;
        __builtin_amdgcn_s_waitcnt(0);
        unsigned nloc = b.st[0], nx = b.st[1];
        if (nloc == 0u) { xcd_barrier_complete(bar, b.x, nloc, nx); b.st[0] = nloc; b.st[1] = nx; }
        const unsigned old = xb_add(&bar[XB_XSUB(b.x)], 1u);
        const unsigned gen = old / nloc;
        if (old + 1u == (gen + 1u) * nloc) {
            __builtin_amdgcn_fence(__ATOMIC_RELEASE, "agent");
            asm volatile("s_waitcnt vmcnt(0)" ::: "memory");
            const unsigned og = xb_add(&bar[XB_TOP], 1u);
            const unsigned tg = og / nx;
            if (og + 1u == (tg + 1u) * nx) xb_add(&bar[XB_TOPGEN], 1u);
            else XB_SPIN(xb_ld(&bar[XB_TOPGEN]) == tg, bar);
            __builtin_amdgcn_fence(__ATOMIC_ACQUIRE, "agent");
            xb_add(&bar[XB_XGEN(b.x)], 1u);
            asm volatile("s_waitcnt vmcnt(0)" ::: "memory");
        } else {
            XB_SPIN(xb_ld(&bar[XB_XGEN(b.x)]) == gen, bar);
            __builtin_amdgcn_fence(__ATOMIC_ACQUIRE, "agent");
            asm volatile("s_waitcnt vmcnt(0)" ::: "memory");
        }
    }
    __syncthreads();
}

namespace pg8 {
constexpr int BM = 256, BK = 64, HALF = 128, HTB = HALF * BK * 2, STAGE_BYTES = 8 * HTB, NXCD = 8, WGM = 8;
__host__ __device__ __forceinline__ int lds_byte(int r, int c) { const int st = (r >> 4) * 2 + (c >> 5), rr = r & 15, cc = c & 31, ob = rr * 64 + cc * 2; return st * 1024 + (ob ^ (((ob >> 9) & 1) << 5)); }
__host__ __device__ __forceinline__ void stage_rc(int b, int& R, int& C) { const int st = b / 1024, sb = b % 1024, swz = sb ^ (((sb >> 9) & 1) << 5); R = (st >> 1) * 16 + swz / 64; C = (st & 1) * 32 + (swz % 64) / 2; }
__host__ __device__ __forceinline__ int perm32(int rho) { const int n = rho >> 4, i = rho & 15; return 8 * (i >> 2) + 4 * n + (i & 3); }

struct Unit { int pm, pn, hm; };
struct Gemm { const bf16_t* A; const bf16_t* Bt; int lda, K, npg; size_t a_gs; };

struct StaticOrder {
    int nM, nN, nwg, G, c;
    __device__ void init(int M, int N, int G_, int c_) { nM = M / BM; nN = N / BM; nwg = nM * nN; G = G_; c = c_; }
    __device__ bool next(int i, Unit& u) const {
        const long L = (long)i * G + c; if (L >= nwg) return false;
        int wgid = (int)L; { const int q = nwg / NXCD, r = nwg % NXCD, xcd = wgid % NXCD, off = wgid / NXCD; wgid = (xcd < r ? xcd * (q + 1) : r * (q + 1) + (xcd - r) * q) + off; }
        const int nig = WGM * nN, gid = wgid / nig, fm = gid * WGM, gsz = (nM - fm) < WGM ? (nM - fm) : WGM;
        u.pm = fm + ((wgid % nig) % gsz); u.pn = (wgid % nig) / gsz; u.hm = 0; return true;
    }
};

struct PanelOrder {
    int G, c;
    __device__ void init(int G_, int c_) { G = G_; c = c_; }
    __device__ bool next(int i, Unit& u) const {
        const long j = (long)i * G + c; if (j >= 1024) return false;
        const int r = (int)j >> 8, p = (int)j & 255, x = p & 7, k = p >> 3; u.pm = 16 * r + 4 * (x >> 1) + (k >> 3); u.pn = 8 * (x & 1) + (k & 7); u.hm = 0; return true;
    }
};
struct HalfOrder {
    int nM, nN, c;
    __device__ void init(int M, int N, int c_) { nM = M / BM; nN = N / BM; c = c_; }
    __device__ bool next(int i, Unit& u) const { if (i != 0 || c < 0 || c >= 2 * nM * nN) return false;
        const int x = c & 7, sl = c >> 3, t = sl >> 1; u.hm = sl & 1; u.pn = t % nN; u.pm = x * (nM >> 3) + t / nN; return true; }
};
template <class Epi, class Sched = StaticOrder, bool ALIGN_EPI = true, bool SP2 = true, bool HM = false>
__device__ __forceinline__ void gemm_phase(LAS unsigned char* lds, const Gemm g, const Sched& S, const Epi& E, int wave_s) {
    const int tid = otid_w(wave_s), wid = __builtin_amdgcn_readfirstlane(tid >> 6), lane = tid & 63, wr = wid >> 2, wc = wid & 3, fr = lane & 15, fq = lane >> 4;
    const int K = g.K, nt = K / BK, lda = g.lda;
    unsigned voffA[2], voffB[2];
#pragma unroll
    for (int i = 0; i < 2; ++i) { int R, C; stage_rc(tid * 16 + i * 8192, R, C); const int Rb = (R & ~31) + perm32(R & 31);
        voffA[i] = (unsigned)(R * lda + C) * 2u; voffB[i] = (unsigned)(Rb * K + C) * 2u; }
    const size_t kstep = (size_t)(BK * 2);
    const size_t hstepA = HM ? (size_t)0 : (size_t)HALF * lda * 2, hstepB = (size_t)HALF * K * 2;
    const unsigned ldsw = (unsigned)wid * 1024u;
    const int aoff = lds_byte(wr * 64 + fr, fq * 8), boff = lds_byte(wc * 32 + fr, fq * 8);
#define PG8_SA(b, h) (((b) * 2 + (h)) * HTB)
#define PG8_SB(b, h) ((4 + (b) * 2 + (h)) * HTB)
#define PG8_STAGE(bufoff, gbase, voff) do { _Pragma("unroll") for (int _i = 0; _i < 2; ++_i) \
        __builtin_amdgcn_global_load_lds((const unsigned*)((const char*)(gbase) + (voff)[_i]), (LAS unsigned*)(lds + (bufoff) + ldsw + _i * 8192), 16, 0, 0); } while (0)
#define PG8_LDA(dst, b, h) do { _Pragma("unroll") for (int m = 0; m < 4; ++m) _Pragma("unroll") for (int k = 0; k < 2; ++k) dst[m][k] = *(const LAS bf16x8*)(lds + PG8_SA(b, h) + aoff + m * 2048 + k * 1024); } while (0)
#define PG8_LDB(dst, b, h) do { _Pragma("unroll") for (int n = 0; n < 2; ++n) _Pragma("unroll") for (int k = 0; k < 2; ++k) dst[n][k] = *(const LAS bf16x8*)(lds + PG8_SB(b, h) + boff + n * 2048 + k * 1024); } while (0)
#define PG8_MMA(ai, bj, At, Bt) do { __builtin_amdgcn_s_setprio(1); _Pragma("unroll") for (int m = 0; m < 4; ++m) _Pragma("unroll") for (int n = 0; n < 2; ++n) _Pragma("unroll") for (int k = 0; k < 2; ++k) \
        acc[ai][bj][m][n] = __builtin_amdgcn_mfma_f32_16x16x32_bf16(Bt[n][k], At[m][k], acc[ai][bj][m][n], 0, 0, 0); __builtin_amdgcn_s_setprio(0); } while (0)
#define PG8_WAIT_V(n) asm volatile("s_waitcnt vmcnt(" #n ")" ::: "memory")
#define PG8_WAIT_L(n) asm volatile("s_waitcnt lgkmcnt(" #n ")" ::: "memory")
#define PG8_BAR __builtin_amdgcn_s_barrier()
#define PG8_SCHED __builtin_amdgcn_sched_barrier(0)
#define PG8_APTR(u) ((const char*)g.A + (((size_t)(u).pm * BM + (HM ? (size_t)(u).hm * HALF : (size_t)0)) * lda + (g.npg ? (size_t)((u).pn / g.npg) * g.a_gs : (size_t)0)) * 2)
#define PG8_BPTR(u) ((const char*)g.Bt + (size_t)(u).pn * BM * K * 2)
    Unit cur, nxt; int ui = 0;
    if (!S.next(0, cur)) return;
    f32x4 acc[2][2][4][2];
#pragma unroll
    for (int a = 0; a < 2; ++a)
#pragma unroll
        for (int b = 0; b < 2; ++b)
#pragma unroll
            for (int m = 0; m < 4; ++m)
#pragma unroll
                for (int n = 0; n < 2; ++n) acc[a][b][m][n] = (f32x4){0.f, 0.f, 0.f, 0.f};
    bf16x8 At[4][2], B0[2][2], B1[2][2];
    const char* cA = PG8_APTR(cur); const char* cB = PG8_BPTR(cur);
    if constexpr (SP2) {
        PG8_STAGE(PG8_SB(0, 0), cB, voffB); PG8_STAGE(PG8_SB(0, 1), cB + hstepB, voffB); PG8_STAGE(PG8_SA(0, 0), cA, voffA); PG8_STAGE(PG8_SA(0, 1), cA + hstepA, voffA);
        if (wr == 1) PG8_BAR;
        PG8_WAIT_V(2); PG8_BAR;
        PG8_STAGE(PG8_SB(1, 0), cB + kstep, voffB); PG8_STAGE(PG8_SA(1, 0), cA + kstep, voffA); PG8_STAGE(PG8_SB(1, 1), cB + hstepB + kstep, voffB);
        PG8_WAIT_V(6); PG8_BAR;
    } else {
        PG8_STAGE(PG8_SB(0, 0), cB, voffB); PG8_STAGE(PG8_SA(0, 0), cA, voffA); PG8_STAGE(PG8_SB(0, 1), cB + hstepB, voffB); PG8_STAGE(PG8_SA(0, 1), cA + hstepA, voffA);
        if (wr == 1) PG8_BAR;
        PG8_WAIT_V(4); PG8_BAR;
        PG8_STAGE(PG8_SB(1, 0), cB + kstep, voffB); PG8_STAGE(PG8_SA(1, 0), cA + kstep, voffA); PG8_STAGE(PG8_SB(1, 1), cB + hstepB + kstep, voffB);
        PG8_WAIT_V(6); PG8_BAR;
    }
    for (;;) {
        const bool has_next = S.next(ui + 1, nxt);
        const char* nA = has_next ? PG8_APTR(nxt) : cA; const char* nB = has_next ? PG8_BPTR(nxt) : cB;
        for (int t = 0; t < nt; t += 2) {
            const bool last = (t == nt - 2);
            const char* a1 = cA + (size_t)(t + 1) * kstep;
            const char* a2 = last ? nA : cA + (size_t)(t + 2) * kstep; const char* b2 = last ? nB : cB + (size_t)(t + 2) * kstep;
            const char* a3 = a2 + kstep; const char* b3 = b2 + kstep;
            if constexpr (SP2) {
            PG8_LDB(B0, 0, 0); PG8_LDB(B1, 0, 1); PG8_SCHED; PG8_LDA(At, 0, 0); PG8_STAGE(PG8_SA(1, 1), a1 + hstepA, voffA);
            PG8_WAIT_V(8); PG8_WAIT_L(0); PG8_BAR; PG8_MMA(0, 0, At, B0); PG8_MMA(0, 1, At, B1); PG8_BAR; PG8_SCHED;
            if constexpr (!HM) PG8_LDA(At, 0, 1); PG8_STAGE(PG8_SB(0, 0), b2, voffB); PG8_STAGE(PG8_SB(0, 1), b2 + hstepB, voffB); PG8_STAGE(PG8_SA(0, 0), a2, voffA);
            PG8_WAIT_V(8); PG8_WAIT_L(0); PG8_BAR; if constexpr (!HM) { PG8_MMA(1, 0, At, B0); PG8_MMA(1, 1, At, B1); } PG8_BAR; PG8_SCHED;
            PG8_LDB(B0, 1, 0); PG8_LDB(B1, 1, 1); PG8_SCHED; PG8_LDA(At, 1, 0); PG8_STAGE(PG8_SA(0, 1), a2 + hstepA, voffA);
            PG8_WAIT_V(8); PG8_WAIT_L(0); PG8_BAR; PG8_MMA(0, 0, At, B0); PG8_MMA(0, 1, At, B1); PG8_BAR; PG8_SCHED;
            if constexpr (!HM) PG8_LDA(At, 1, 1); PG8_STAGE(PG8_SB(1, 0), b3, voffB); PG8_STAGE(PG8_SB(1, 1), b3 + hstepB, voffB); PG8_STAGE(PG8_SA(1, 0), a3, voffA);
            PG8_WAIT_V(8); PG8_WAIT_L(0); PG8_BAR; if constexpr (!HM) { PG8_MMA(1, 0, At, B0); PG8_MMA(1, 1, At, B1); } PG8_BAR; PG8_SCHED;
            } else {
            PG8_LDB(B0, 0, 0); PG8_SCHED; PG8_LDA(At, 0, 0); PG8_STAGE(PG8_SA(1, 1), a1 + hstepA, voffA);
            PG8_WAIT_L(8); PG8_BAR; PG8_WAIT_L(0); PG8_MMA(0, 0, At, B0); PG8_BAR; PG8_SCHED;
            PG8_LDB(B1, 0, 1); PG8_STAGE(PG8_SB(0, 0), b2, voffB);
            PG8_BAR; PG8_WAIT_L(0); PG8_MMA(0, 1, At, B1); PG8_BAR;
            PG8_LDA(At, 0, 1); PG8_STAGE(PG8_SA(0, 0), a2, voffA);
            PG8_BAR; PG8_WAIT_L(0); PG8_MMA(1, 0, At, B0); PG8_BAR; PG8_SCHED;
            PG8_STAGE(PG8_SB(0, 1), b2 + hstepB, voffB);
            PG8_WAIT_V(6); PG8_BAR; PG8_MMA(1, 1, At, B1); PG8_BAR;
            PG8_LDB(B0, 1, 0); PG8_SCHED; PG8_LDA(At, 1, 0); PG8_STAGE(PG8_SA(0, 1), a2 + hstepA, voffA);
            PG8_WAIT_L(8); PG8_BAR; PG8_WAIT_L(0); PG8_MMA(0, 0, At, B0); PG8_BAR; PG8_SCHED;
            PG8_LDB(B1, 1, 1); PG8_STAGE(PG8_SB(1, 0), b3, voffB);
            PG8_BAR; PG8_WAIT_L(0); PG8_MMA(0, 1, At, B1); PG8_BAR;
            PG8_LDA(At, 1, 1); PG8_STAGE(PG8_SA(1, 0), a3, voffA);
            PG8_BAR; PG8_WAIT_L(0); PG8_MMA(1, 0, At, B0); PG8_BAR; PG8_SCHED;
            PG8_STAGE(PG8_SB(1, 1), b3 + hstepB, voffB);
            PG8_WAIT_V(6); PG8_BAR; PG8_MMA(1, 1, At, B1); PG8_BAR;
            }
        }
        if constexpr (ALIGN_EPI) { if (wr == 0) PG8_BAR; }
        E(acc, cur, wr, wc, fr, fq);
        if (!has_next) break;
#pragma unroll
        for (int a = 0; a < 2; ++a)
#pragma unroll
            for (int b = 0; b < 2; ++b)
#pragma unroll
                for (int m = 0; m < 4; ++m)
#pragma unroll
                    for (int n = 0; n < 2; ++n) acc[a][b][m][n] = (f32x4){0.f, 0.f, 0.f, 0.f};
        cur = nxt; cA = nA; cB = nB; ++ui;
        if constexpr (ALIGN_EPI) { if (wr == 1) PG8_BAR; }
    }
    PG8_WAIT_V(0);
    if constexpr (!ALIGN_EPI) { if (wr == 0) PG8_BAR; }
    PG8_BAR;
#undef PG8_SA
#undef PG8_SB
#undef PG8_STAGE
#undef PG8_LDA
#undef PG8_LDB
#undef PG8_MMA
#undef PG8_WAIT_V
#undef PG8_WAIT_L
#undef PG8_BAR
#undef PG8_SCHED
#undef PG8_APTR
#undef PG8_BPTR
}

__device__ __forceinline__ u32x4 pack8(const f32x4 a, const f32x4 b) { u32x4 w; w.x = cvtpk(a[0], a[1]); w.y = cvtpk(a[2], a[3]); w.z = cvtpk(b[0], b[1]); w.w = cvtpk(b[2], b[3]); return w; }

template <bool HM>
struct EpiPlainT {
    bf16_t* O; int ldc; int split_cols; size_t split_stride; const float* rowscale;
    __device__ __forceinline__ void operator()(const f32x4 (&acc)[2][2][4][2], const Unit& u, int wr, int wc, int fr, int fq) const {
        const int row0 = u.pm * BM + (HM ? u.hm * HALF : 0) + wr * 64 + fr, col0 = u.pn * BM + wc * 32 + 8 * fq;
        bf16_t* Ob = O; if (split_cols) { const int tsp = (u.pn * BM) / split_cols; Ob = O + (size_t)tsp * split_stride - (size_t)tsp * split_cols; }
#pragma unroll
        for (int ai = 0; ai < (HM ? 1 : 2); ++ai)
#pragma unroll
            for (int m = 0; m < 4; ++m) { const int row = row0 + ai * HALF + m * 16; bf16_t* rowp = Ob + (size_t)row * ldc + col0; const float rs = rowscale ? ((const GAS float*)rowscale)[row] : 1.0f;
#pragma unroll
                for (int bj = 0; bj < 2; ++bj) *(GAS u32x4*)(rowp + bj * HALF) = pack8(acc[ai][bj][m][0] * rs, acc[ai][bj][m][1] * rs); }
    }
};
using EpiPlain = EpiPlainT<false>;
template <bool HM>
struct EpiGeluT {
    bf16_t* O; int ldc; const float* bias; int split_cols; size_t split_stride;
    __device__ __forceinline__ void operator()(const f32x4 (&acc)[2][2][4][2], const Unit& u, int wr, int wc, int fr, int fq) const {
        const int row0 = u.pm * BM + (HM ? u.hm * HALF : 0) + wr * 64 + fr, col0 = u.pn * BM + wc * 32 + 8 * fq;
        const int tsp = (u.pn * BM) / split_cols; bf16_t* Ob = O + (size_t)tsp * split_stride - (size_t)tsp * split_cols;
        f32x4 bv[2][2];
#pragma unroll
        for (int bj = 0; bj < 2; ++bj)
#pragma unroll
            for (int n = 0; n < 2; ++n) bv[bj][n] = *(const GAS f32x4*)(bias + col0 + bj * HALF + 4 * n);
#pragma unroll
        for (int ai = 0; ai < (HM ? 1 : 2); ++ai)
#pragma unroll
            for (int m = 0; m < 4; ++m) { bf16_t* rowp = Ob + (size_t)(row0 + ai * HALF + m * 16) * ldc + col0;
#pragma unroll
                for (int bj = 0; bj < 2; ++bj) { f32x4 v0 = acc[ai][bj][m][0] + bv[bj][0], v1 = acc[ai][bj][m][1] + bv[bj][1];
#pragma unroll
                    for (int j = 0; j < 4; ++j) { v0[j] = gelu_tanh(v0[j]); v1[j] = gelu_tanh(v1[j]); }
                    *(GAS u32x4*)(rowp + bj * HALF) = pack8(v0, v1); } }
    }
};
using EpiGelu = EpiGeluT<false>;
struct EpiY {
    bf16_t* O; int ldc; const float* colscale; float* ssp; int nsp;
    __device__ __forceinline__ void operator()(const f32x4 (&acc)[2][2][4][2], const Unit& u, int wr, int wc, int fr, int fq) const {
        const int row0 = u.pm * BM + wr * 64 + fr, col0 = u.pn * BM + wc * 32 + 8 * fq;
        f32x4 sv[2][2];
#pragma unroll
        for (int bj = 0; bj < 2; ++bj)
#pragma unroll
            for (int n = 0; n < 2; ++n) sv[bj][n] = colscale ? *(const GAS f32x4*)(colscale + col0 + bj * HALF + 4 * n) : (f32x4){1.f, 1.f, 1.f, 1.f};
#pragma unroll
        for (int ai = 0; ai < 2; ++ai)
#pragma unroll
            for (int m = 0; m < 4; ++m) { const int row = row0 + ai * HALF + m * 16; bf16_t* rowp = O + (size_t)row * ldc + col0; float ss = 0.f;
#pragma unroll
                for (int bj = 0; bj < 2; ++bj) { const f32x4 v0 = acc[ai][bj][m][0] * sv[bj][0], v1 = acc[ai][bj][m][1] * sv[bj][1];
                    ss += (v0[0] * v0[0] + v0[1] * v0[1]) + (v0[2] * v0[2] + v0[3] * v0[3]) + (v1[0] * v1[0] + v1[1] * v1[1]) + (v1[2] * v1[2] + v1[3] * v1[3]);
                    *(GAS u32x4*)(rowp + bj * HALF) = pack8(v0, v1); }
                ss += __int_as_float(__builtin_amdgcn_ds_swizzle(__float_as_int(ss), 0x401F));
                { auto rr = __builtin_amdgcn_permlane32_swap(__float_as_uint(ss), __float_as_uint(ss), false, false); ss = __uint_as_float(rr[0]) + __uint_as_float(rr[1]); }
                if (fq == 0) ((GAS float*)ssp)[(size_t)row * nsp + u.pn * 4 + wc] = ss; }
    }
};
struct EpiNsaIn {
    bf16_t* Q; bf16_t* KV; const float* rowscale;
    __device__ __forceinline__ void operator()(const f32x4 (&acc)[2][2][4][2], const Unit& u, int wr, int wc, int fr, int fq) const {
        const int row0 = u.pm * BM + wr * 64 + fr, col0 = u.pn * BM + wc * 32 + 8 * fq;
#pragma unroll
        for (int ai = 0; ai < 2; ++ai)
#pragma unroll
            for (int m = 0; m < 4; ++m) { const int row = row0 + ai * HALF + m * 16; const float rs = ((const GAS float*)rowscale)[row];
#pragma unroll
                for (int bj = 0; bj < 2; ++bj) { const int col = col0 + bj * HALF; const f32x4 v0 = acc[ai][bj][m][0] * rs, v1 = acc[ai][bj][m][1] * rs;
                    if (u.pn < 16) { *(GAS u32x4*)(Q + (size_t)row * QW + col) = pack8(v0, v1); }
                    else { const int idx = col - QW, br = idx >> 10, rem = idx & 1023, kvs = rem >> 9, gg = (rem >> 7) & 3, dh = rem & 127, b = row >> 13, s = row & (SEQ - 1);
                        *(GAS u32x4*)(KV + ((size_t)((((br * 2 + kvs) * 2 + b) * 4 + gg)) * SEQ + s) * HD + dh) = pack8(v0, v1); }
                } }
    }
};
template <bool HM>
struct EpiGatesT {
    float* GT; const float* rowscale;
    __device__ __forceinline__ void operator()(const f32x4 (&acc)[2][2][4][2], const Unit& u, int wr, int wc, int fr, int fq) const {
        const int row0 = u.pm * BM + (HM ? u.hm * HALF : 0) + wr * 64 + fr, col0 = wc * 32 + 8 * fq;
        if (col0 >= GW_) return;
#pragma unroll
        for (int ai = 0; ai < (HM ? 1 : 2); ++ai)
#pragma unroll
            for (int m = 0; m < 4; ++m) { const int row = row0 + ai * HALF + m * 16; const float rs = ((const GAS float*)rowscale)[row];
                const f32x4 v0 = acc[ai][0][m][0] * rs, v1 = acc[ai][0][m][1] * rs; float* gp = GT + (size_t)row * GW_ + col0; f32x4 a, c;
#pragma unroll
                for (int j = 0; j < 4; ++j) { a[j] = sigmoidf_(v0[j]); c[j] = sigmoidf_(v1[j]); }
                *(f32x4*)gp = a; *(GAS f32x4*)(gp + 4) = c; }
    }
};
using EpiGates = EpiGatesT<false>;

#define DPP4(dst, oldv, srcv, ctrl) do { _Pragma("unroll") for (int j_ = 0; j_ < 4; ++j_) dst[j_] = __int_as_float(__builtin_amdgcn_update_dpp(__float_as_int(oldv[j_]), __float_as_int(srcv[j_]), (ctrl), 0xF, 0xF, false)); } while (0)
struct EpiGateUp {
    bf16_t* ACT; const float* cw; const float* cb; float* HALO; float* EDGE; LAS unsigned char* lds; const float* rowscale;
    __device__ __forceinline__ void operator()(const f32x4 (&acc_in)[2][2][4][2], const Unit& u, int wr, int wc, int fr, int fq) const {
        const int chl = wc * 32 + 8 * fq, ch = u.pn * 128 + chl;
        f32x4 acc[2][2][4][2];
#pragma unroll
        for (int ai = 0; ai < 2; ++ai)
#pragma unroll
            for (int m = 0; m < 4; ++m) { const float rs = ((const GAS float*)rowscale)[u.pm * BM + ai * HALF + wr * 64 + m * 16 + fr];
#pragma unroll
                for (int bj = 0; bj < 2; ++bj) { acc[ai][bj][m][0] = acc_in[ai][bj][m][0] * rs; acc[ai][bj][m][1] = acc_in[ai][bj][m][1] * rs; } }
        LAS float* XCH = (LAS float*)(lds + XCH_OFF);
        if (fr >= 14) {
#pragma unroll
            for (int ai = 0; ai < 2; ++ai) { const int q = 2 * ai + wr; LAS float* x = XCH + ((q * 2 + (fr - 14)) * 128 + chl);
                *(LAS f32x4*)x = acc[ai][0][3][0]; *(LAS f32x4*)(x + 4) = acc[ai][0][3][1];
                if (q == 3) { float* hp = HALO + ((size_t)(u.pm * 2 + (fr - 14))) * DFF + ch; *(f32x4*)hp = acc[ai][0][3][0]; *(GAS f32x4*)(hp + 4) = acc[ai][0][3][1]; } }
        }
        asm volatile("s_waitcnt lgkmcnt(0)" ::: "memory"); __builtin_amdgcn_s_barrier(); asm volatile("" ::: "memory");
        const f32x4 w0a = *(const GAS f32x4*)(cw + ch), w0b = *(const GAS f32x4*)(cw + ch + 4), w1a = *(const GAS f32x4*)(cw + DFF + ch), w1b = *(const GAS f32x4*)(cw + DFF + ch + 4);
        const f32x4 w2a = *(const GAS f32x4*)(cw + 2 * DFF + ch), w2b = *(const GAS f32x4*)(cw + 2 * DFF + ch + 4), bba = *(const GAS f32x4*)(cb + ch), bbb = *(const GAS f32x4*)(cb + ch + 4);
        const bool seqstart = (u.pm & 31) == 0;
        const f32x4 zero4 = (f32x4){0.f, 0.f, 0.f, 0.f};
#define TAPS_CUR(z, c) asm("s_nop 1\n\tv_fmac_f32_dpp %0, %4, %8 row_shr:1 row_mask:0xf bank_mask:0xf bound_ctrl:1\n\tv_fmac_f32_dpp %1, %5, %9 row_shr:1 row_mask:0xf bank_mask:0xf bound_ctrl:1\n\t" \
            "v_fmac_f32_dpp %2, %6, %10 row_shr:1 row_mask:0xf bank_mask:0xf bound_ctrl:1\n\tv_fmac_f32_dpp %3, %7, %11 row_shr:1 row_mask:0xf bank_mask:0xf bound_ctrl:1\n\t" \
            "v_fmac_f32_dpp %0, %4, %12 row_shr:2 row_mask:0xf bank_mask:0xf bound_ctrl:1\n\tv_fmac_f32_dpp %1, %5, %13 row_shr:2 row_mask:0xf bank_mask:0xf bound_ctrl:1\n\t" \
            "v_fmac_f32_dpp %2, %6, %14 row_shr:2 row_mask:0xf bank_mask:0xf bound_ctrl:1\n\tv_fmac_f32_dpp %3, %7, %15 row_shr:2 row_mask:0xf bank_mask:0xf bound_ctrl:1" \
            : "+v"(z##0), "+v"(z##1), "+v"(z##2), "+v"(z##3) : "v"(c[0]), "v"(c[1]), "v"(c[2]), "v"(c[3]), "v"(W1[0]), "v"(W1[1]), "v"(W1[2]), "v"(W1[3]), "v"(W0[0]), "v"(W0[1]), "v"(W0[2]), "v"(W0[3]))
#define TAPS_PREV(z, c, d) asm("s_nop 1\n\tv_fmac_f32_dpp %0, %4, %8 row_shl:15 row_mask:0xf bank_mask:0xf bound_ctrl:1\n\tv_fmac_f32_dpp %1, %5, %9 row_shl:15 row_mask:0xf bank_mask:0xf bound_ctrl:1\n\t" \
            "v_fmac_f32_dpp %2, %6, %10 row_shl:15 row_mask:0xf bank_mask:0xf bound_ctrl:1\n\tv_fmac_f32_dpp %3, %7, %11 row_shl:15 row_mask:0xf bank_mask:0xf bound_ctrl:1\n\t" \
            "v_fmac_f32_dpp %0, %16, %12 row_shl:14 row_mask:0xf bank_mask:0xf bound_ctrl:1\n\tv_fmac_f32_dpp %1, %17, %13 row_shl:14 row_mask:0xf bank_mask:0xf bound_ctrl:1\n\t" \
            "v_fmac_f32_dpp %2, %18, %14 row_shl:14 row_mask:0xf bank_mask:0xf bound_ctrl:1\n\tv_fmac_f32_dpp %3, %19, %15 row_shl:14 row_mask:0xf bank_mask:0xf bound_ctrl:1" \
            : "+v"(z##0), "+v"(z##1), "+v"(z##2), "+v"(z##3) : "v"(c[0]), "v"(c[1]), "v"(c[2]), "v"(c[3]), "v"(W1[0]), "v"(W1[1]), "v"(W1[2]), "v"(W1[3]), "v"(W0[0]), "v"(W0[1]), "v"(W0[2]), "v"(W0[3]), "v"(d[0]), "v"(d[1]), "v"(d[2]), "v"(d[3]))
#pragma unroll
        for (int ai = 0; ai < 2; ++ai) { const int q = 2 * ai + wr;
            f32x4 r63a = zero4, r63b = zero4, r62a = zero4, r62b = zero4;
            if (q > 0) { const LAS float* x = XCH + (((q - 1) * 2) * 128 + chl); r62a = *(const LAS f32x4*)x; r62b = *(const LAS f32x4*)(x + 4); r63a = *(const LAS f32x4*)(x + 128); r63b = *(const LAS f32x4*)(x + 132); }
            const f32x4 s2a = fr == 15 ? r63a : r62a, s2b = fr == 15 ? r63b : r62b;
#pragma unroll
            for (int m = 0; m < 4; ++m) {
                const f32x4 ca = acc[ai][0][m][0], cb_ = acc[ai][0][m][1], ua = acc[ai][1][m][0], ub = acc[ai][1][m][1];
                const int lrow = ai * HALF + wr * 64 + m * 16 + fr;
                f32x4 za = w2a * ca + bba, zb = w2b * cb_ + bbb;
                { float za0 = za[0], za1 = za[1], za2 = za[2], za3 = za[3], zb0 = zb[0], zb1 = zb[1], zb2 = zb[2], zb3 = zb[3];
                  const f32x4 p1a = m == 0 ? r63a : acc[ai][0][m > 0 ? m - 1 : 0][0], p1b = m == 0 ? r63b : acc[ai][0][m > 0 ? m - 1 : 0][1];
                  const f32x4 p2a = m == 0 ? s2a : p1a, p2b = m == 0 ? s2b : p1b;
                  { const f32x4 W1 = w1a, W0 = w0a; TAPS_CUR(za, ca); TAPS_PREV(za, p1a, p2a); }
                  { const f32x4 W1 = w1b, W0 = w0b; TAPS_CUR(zb, cb_); TAPS_PREV(zb, p1b, p2b); }
                  za = (f32x4){za0, za1, za2, za3}; zb = (f32x4){zb0, zb1, zb2, zb3}; }
                if (q == 0 && m == 0 && fr < 2 && !seqstart) {
                    float* ep = EDGE + ((size_t)((u.pm * 2 + fr) * 2)) * DFF + ch;
                    *(f32x4*)ep = ca; *(GAS f32x4*)(ep + 4) = cb_; *(GAS f32x4*)(ep + DFF) = ua; *(GAS f32x4*)(ep + DFF + 4) = ub;
                } else {
                    f32x4 ta = za * (-LOG2E), tb = zb * (-LOG2E);
#pragma unroll
                    for (int j = 0; j < 4; ++j) { ta[j] = __builtin_amdgcn_exp2f(ta[j]); tb[j] = __builtin_amdgcn_exp2f(tb[j]); }
                    ta = ta + 1.0f; tb = tb + 1.0f;
#pragma unroll
                    for (int j = 0; j < 4; ++j) { ta[j] = __builtin_amdgcn_rcpf(ta[j]); tb[j] = __builtin_amdgcn_rcpf(tb[j]); }
                    za = za * ta * ua; zb = zb * tb * ub;
                    *(GAS u32x4*)(ACT + (size_t)(u.pm * BM + lrow) * DFF + ch) = pack8(za, zb);
                }
            }
        }
#undef TAPS_CUR
#undef TAPS_PREV
    }
};
struct EpiKvc {
    bf16_t* KVC;
    __device__ __forceinline__ void operator()(const f32x4 (&acc)[2][2][4][2], const Unit& u, int wr, int wc, int fr, int fq) const {
        const int row0 = u.pm * BM + wr * 64 + fr, col0 = wc * 32 + 8 * fq;
#pragma unroll
        for (int ai = 0; ai < 2; ++ai)
#pragma unroll
            for (int m = 0; m < 4; ++m) { const int row = row0 + ai * HALF + m * 16; const bool dead = (row & 511) == 511;
                const f32x4 z4 = (f32x4){0.f, 0.f, 0.f, 0.f}; const f32x4 v0 = dead ? z4 : acc[ai][0][m][0], v1 = dead ? z4 : acc[ai][0][m][1];
                *(GAS u32x4*)(KVC + ((size_t)u.pn * 4096 + row) * 128 + col0) = pack8(v0, v1); }
    }
};
}

struct Args { const float* in[21]; float* out; unsigned char* ws; int ph_lo, ph_hi; };
struct Frame {
    LAS unsigned char* lds; volatile LAS unsigned* MISC; unsigned* ctl;
    int G, bid, wv;
    unsigned char* ws; float* out;
};
enum { IN_X = 0, IN_MEM, IN_LN_MIX, IN_LN_XA, IN_LN_FFN, IN_MEM_NORM, IN_POOL_W, IN_POOL_SCALE, IN_NSA_W_IN, IN_NSA_W_OUT, IN_CMP_POS, IN_CMP_W1, IN_CMP_B1, IN_CMP_W2,
       IN_XA_WQ, IN_XA_WKV, IN_XA_WO, IN_FFN_WGU, IN_FFN_CONVW, IN_FFN_CONVB, IN_FFN_WDN };

template <int MODE>
__device__ __forceinline__ void p0_transpose_item(const float* W, int K, int N, bf16_t* WT, const float* gk  , LAS unsigned* scr, int item, int lane) {
    const int nblk = (N + 63) / 64, kb = item / nblk, nb = item - kb * nblk, k0 = 64 * kb, n0 = 64 * nb;
    const int rr = lane >> 4, cq = lane & 15, n = n0 + 4 * cq; const bool nok = n < N;
    f32x4 v[16];
#pragma unroll
    for (int i = 0; i < 8; ++i)
#pragma unroll
        for (int e = 0; e < 2; ++e) { const int k = k0 + 8 * i + 2 * rr + e; v[2 * i + e] = nok ? *(const GAS f32x4*)(W + (size_t)k * N + n) : (f32x4){0.f, 0.f, 0.f, 0.f}; }
#pragma unroll
    for (int i = 0; i < 8; ++i) { f32x4 a = v[2 * i], b = v[2 * i + 1];
        if (gk) { const int k = k0 + 8 * i + 2 * rr; a = a * gk[k]; b = b * gk[k + 1]; }
        LAS unsigned* d = scr + (4 * i + rr) * 65 + 4 * cq;
        d[0] = cvtpk(a[0], b[0]); d[1] = cvtpk(a[1], b[1]); d[2] = cvtpk(a[2], b[2]); d[3] = cvtpk(a[3], b[3]); }
    LDS_WAIT(); asm volatile("" ::: "memory");
    int r0 = n0;
    if (MODE == 1) { const int up = n0 >= DFF ? 1 : 0, ch = n0 - up * DFF; r0 = (ch >> 7) * 256 + up * 128 + (ch & 127); }
    const int c = lane & 7;
#pragma unroll
    for (int j = 0; j < 8; ++j) { const int nn = (lane >> 3) + 8 * j; const LAS unsigned* sp = scr + (4 * c) * 65 + nn;
        u32x4 o; o.x = sp[0]; o.y = sp[65]; o.z = sp[130]; o.w = sp[195];
        if (n0 + nn < N) *(GAS u32x4*)(WT + (size_t)(r0 + nn) * K + k0 + 8 * c) = o; }
    LDS_WAIT(); asm volatile("" ::: "memory");
}
__device__ __forceinline__ float row_sumsq(const float* row, int lane) {
    const f32x4* xr = (const f32x4*)row + lane; float s = 0.f;
#pragma unroll
    for (int j = 0; j < 16; ++j) { const f32x4 v = xr[64 * j]; s += (v[0] * v[0] + v[1] * v[1]) + (v[2] * v[2] + v[3] * v[3]); }
    return wave_sum(s);
}
#ifndef C2FILL
#define C2FILL 1
#endif
#ifndef XQFILL
#define XQFILL 1
#endif
constexpr int XQF_N = 112 * NWAVES * 11;
#ifndef TAILFILL
#define TAILFILL 1
#endif
#ifndef DEFER_CONV
#define DEFER_CONV 1
#endif
__device__ __forceinline__ void phase_p0(Frame& F, const Args& A) {
    unsigned char* const wsl = optr(F.ws);
    const int tid = otid(), lane = tid & 63, wave = __builtin_amdgcn_readfirstlane(tid >> 6);
    LAS unsigned* scr = (LAS unsigned*)(F.lds + wave * 8448);
    const int gw = F.bid * NWAVES + wave, NGW = F.G * NWAVES;
    unsigned char* ws = wsl;
    int it = gw;
#define P0_MAT(MODE, src, K_, N_, dst, gk_) do { const int n_ = ((K_) / 64) * (((N_) + 63) / 64); for (; it < n_; it += NGW) p0_transpose_item<MODE>((src), (K_), (N_), (bf16_t*)(dst), (gk_), scr, it, lane); it -= n_; } while (0)
    { const int off_ = (XQFILL && F.G == 256) ? XQF_N : 0; const int n_ = (DM / 64) * (DFF2 / 64) - off_;
      for (; it < n_; it += NGW) p0_transpose_item<1>(A.in[IN_FFN_WGU], DM, DFF2, (bf16_t*)(ws + WS_WGU), A.in[IN_LN_FFN], scr, it + off_, lane); it -= n_; }
    for (int l = 1; l < 2 - DEFER_CONV; ++l) P0_MAT(1, A.in[IN_FFN_WGU] + (size_t)l * DM * DFF2, DM, DFF2, ws + WS_WGU + (size_t)l * DFF2 * DM * 2, A.in[IN_LN_FFN] + (size_t)l * 2 * DM);
    for (int l = 0; l < (TAILFILL ? 0 : 2 - DEFER_CONV); ++l) P0_MAT(0, A.in[IN_FFN_WDN] + (size_t)l * DFF * DM, DFF, DM, ws + WS_WDN + (size_t)l * DM * DFF * 2, nullptr);
    P0_MAT(0, A.in[IN_NSA_W_IN], DM, NSA_INW, ws + WS_NSAIN, A.in[IN_LN_MIX] + (size_t)2 * DM);
    if (!DEFER_CONV) P0_MAT(0, A.in[IN_NSA_W_OUT], QW, DM, ws + WS_NSAOUT, nullptr);
    for (int g = 0; g < 4; ++g) P0_MAT(0, A.in[IN_POOL_W] + (size_t)g * PGC * PGC, PGC, PGC, ws + WS_POOLW + (size_t)g * PGC * PGC * 2, nullptr);
    for (int l = 0; l < 2; ++l) P0_MAT(0, A.in[IN_CMP_W1] + (size_t)l * 4096 * CMP_HID, 4096, CMP_HID, ws + WS_CMPW1 + (size_t)l * CMP_HID * 4096 * 2, nullptr);
    for (int l = 0; l < 2; ++l) P0_MAT(0, A.in[IN_CMP_W2] + (size_t)l * CMP_HID * HD, CMP_HID, HD, ws + WS_CMPW2 + (size_t)l * 256 * CMP_HID * 2, nullptr);
    for (int l = 0; l < 2 - DEFER_CONV; ++l) P0_MAT(0, A.in[IN_XA_WQ] + (size_t)l * DM * XAW, DM, XAW, ws + WS_XAQ + (size_t)l * XAW * DM * 2, A.in[IN_LN_XA] + (size_t)l * 2 * DM);
    for (int l = 0; l < 2; ++l) P0_MAT(0, A.in[IN_XA_WKV] + (size_t)l * DM * 2 * XAW, DM, 2 * XAW, ws + WS_XAKV + (size_t)l * 2 * XAW * DM * 2, nullptr);
    for (int l = 0; l < 2 - DEFER_CONV; ++l) P0_MAT(0, A.in[IN_XA_WO] + (size_t)l * XAW * DM, XAW, DM, ws + WS_XAO + (size_t)l * DM * XAW * 2, nullptr);
#undef P0_MAT
    for (int l = 0; l < 2; ++l) { u32x4* z = (u32x4*)(ws + WS_CMPW2 + ((size_t)l * 256 + HD) * CMP_HID * 2); const int n16 = (256 - HD) * CMP_HID * 2 / 16;
      for (int i = gw * 64 + lane; i < n16; i += NGW * 64) *(GAS u32x4*)(z + i) = (u32x4){0u, 0u, 0u, 0u}; }
    { u32x4* z = (u32x4*)(ws + WS_NSAIN + (size_t)NSA_INW * DM * 2); const int n16 = (NSA_INP - NSA_INW) * DM * 2 / 16;
      for (int i = gw * 64 + lane; i < n16; i += NGW * 64) z[i] = (u32x4){0u, 0u, 0u, 0u}; }
    for (int r = gw; r < MMEM; r += NGW) {
        const float* row = A.in[IN_MEM] + (size_t)r * DM; const float rs = 1.0f / sqrtf(row_sumsq(row, lane) * (1.0f / DM) + RMS_EPS);
        bf16_t* o = (bf16_t*)(ws + WS_MEMN) + (size_t)r * DM;
#pragma unroll
        for (int j = 0; j < 8; ++j) { const int c8 = (j * 64 + lane) * 8; const f32x4 a = *(const GAS f32x4*)(row + c8), b = *(const GAS f32x4*)(row + c8 + 4);
            const f32x4 ga = *(const GAS f32x4*)(A.in[IN_MEM_NORM] + c8), gb = *(const GAS f32x4*)(A.in[IN_MEM_NORM] + c8 + 4);
            *(GAS u32x4*)(o + c8) = pg8::pack8(a * rs * ga, b * rs * gb); }
    }
    { float* part = (float*)(ws + WS_CMPB + 65536);
      for (int tk = gw; tk < 256; tk += NGW) { const int kv = tk >> 7, ng = (tk >> 4) & 7, ks = tk & 15, n = ng * 64 + lane;
          const float* pos = A.in[IN_CMP_POS] + (size_t)kv * 4096 + ks * 256; const float* w1 = A.in[IN_CMP_W1] + ((size_t)kv * 4096 + ks * 256) * CMP_HID + n; float s = 0.f;
#pragma unroll 8
          for (int k = 0; k < 256; ++k) s += pos[k] * w1[(size_t)k * CMP_HID];
          part[(kv * 16 + ks) * CMP_HID + n] = s; } }
    { float* xr = (float*)(ws + WS_XR);
      for (int r = gw; r < MTOK; r += NGW) { const float ss = row_sumsq(A.in[IN_X] + (size_t)r * DM, lane); if (lane == 0) xr[r] = 1.0f / sqrtf(ss * (1.0f / DM) + RMS_EPS); } }
}

template <int WIN>
__device__ __forceinline__ void pool_item(const float* X, const float* xr, const f32x4 gv, bf16_t* D0, int t0, int tin0, int c) {
    f32x4 prev[WIN]; f32x4 s = (f32x4){0.f, 0.f, 0.f, 0.f};
#pragma unroll
    for (int i = 0; i < WIN; ++i) { prev[i] = (tin0 - WIN + i >= 0) ? *(const GAS f32x4*)(X + (size_t)(t0 - WIN + i) * DM + c) * ((const GAS float*)xr)[tin0 - WIN + i >= 0 ? t0 - WIN + i : t0] * gv : (f32x4){0.f, 0.f, 0.f, 0.f}; s += prev[i]; }
#pragma unroll 1
    for (int r0 = 0; r0 < 64; r0 += 16) {
        f32x4 cur[16];
#pragma unroll
        for (int r = 0; r < 16; ++r) { const int t = t0 + r0 + r; cur[r] = *(const GAS f32x4*)(X + (size_t)t * DM + c) * ((const GAS float*)xr)[t] * gv; }
#pragma unroll
        for (int r = 0; r < 16; ++r) { const int t = t0 + r0 + r, tin = tin0 + r0 + r;
            const f32x4 old = (r >= WIN) ? cur[r >= WIN ? r - WIN : 0] : prev[r < WIN ? r : 0];
            s += cur[r]; s -= old;
            const float ic = 1.0f / (float)(tin + 1 < WIN ? tin + 1 : WIN);
            const f32x4 d = s * ic - cur[r]; u32x2 w; w.x = cvtpk(d[0], d[1]); w.y = cvtpk(d[2], d[3]);
            *(GAS u32x2*)(D0 + (size_t)t * DM + c) = w; }
#pragma unroll
        for (int i = 0; i < WIN; ++i) prev[i] = cur[16 - WIN + i];
    }
}
__device__ __forceinline__ void phase_poolprep(Frame& F, const Args& A) {
    unsigned char* const wsl = optr(F.ws);
    const float* X = A.in[IN_X]; const float* g0 = A.in[IN_LN_MIX]; const float* xr = (const float*)(wsl + WS_XR); bf16_t* D0 = (bf16_t*)(wsl + WS_HN);
    const int tid = otid();
    constexpr int NQ = DM / 4, TOTAL = (MTOK / 64) * NQ;
    for (int it = F.bid * NTHR + tid; it < TOTAL; it += F.G * NTHR) {
        const int chn = it / NQ, qq = it - chn * NQ, c = 4 * qq, t0 = chn * 64, tin0 = t0 & (SEQ - 1);
        const f32x4 gv = *(const GAS f32x4*)(g0 + c);
        switch (__builtin_amdgcn_readfirstlane(c >> 10)) {
            case 0: pool_item<2>(X, xr, gv, D0, t0, tin0, c); break;
            case 1: pool_item<4>(X, xr, gv, D0, t0, tin0, c); break;
            case 2: pool_item<8>(X, xr, gv, D0, t0, tin0, c); break;
            default: pool_item<16>(X, xr, gv, D0, t0, tin0, c); break;
        }
    }
}

template <bool FIRST, bool LAST>
__device__ __forceinline__ void phase_resid(Frame& F, const float* x, const float* g1) {
    unsigned char* const wsl = optr(F.ws);
    const int tid = otid(), lane = tid & 63, wave = __builtin_amdgcn_readfirstlane(tid >> 6);
    const int gw = F.bid * NWAVES + wave, NGW = F.G * NWAVES;
    const bf16_t* Y = (const bf16_t*)(wsl + WS_Y); const float* ssp = (const float*)(wsl + WS_SSP); bf16_t* H = (bf16_t*)(wsl + WS_HN); float* RS = (float*)(wsl + WS_RS);
    for (int row = gw; row < MTOK; row += NGW) {
        const float ss = wave_sum(((const GAS float*)ssp)[(size_t)row * 64 + lane]); const float rs = 1.0f / sqrtf(ss * (1.0f / DM) + RMS_EPS);
        float s2 = 0.f;
#pragma unroll
        for (int j = 0; j < 8; ++j) { const int c8 = (j * 64 + lane) * 8; const size_t off = (size_t)row * DM + c8;
            const u32x4 yw = *(const GAS u32x4*)(Y + off); f32x4 h0, h1;
            if (FIRST) { h0 = *(const GAS f32x4*)(x + off); h1 = *(const GAS f32x4*)(x + off + 4); }
            else { const u32x4 hw = *(const GAS u32x4*)(H + off); h0 = (f32x4){bflo(hw.x), bfhi(hw.x), bflo(hw.y), bfhi(hw.y)}; h1 = (f32x4){bflo(hw.z), bfhi(hw.z), bflo(hw.w), bfhi(hw.w)}; }
            const f32x4 ga = *(const GAS f32x4*)(g1 + c8), gb = *(const GAS f32x4*)(g1 + c8 + 4);
            const f32x4 y0 = (f32x4){bflo(yw.x), bfhi(yw.x), bflo(yw.y), bfhi(yw.y)}, y1 = (f32x4){bflo(yw.z), bfhi(yw.z), bflo(yw.w), bfhi(yw.w)};
            const f32x4 a = h0 + y0 * rs * ga, b = h1 + y1 * rs * gb;
            if (LAST) { *(GAS f32x4*)(F.out + off) = a; *(GAS f32x4*)(F.out + off + 4) = b; }
            else { *(GAS u32x4*)(H + off) = pg8::pack8(a, b);
                s2 += (a[0] * a[0] + a[1] * a[1]) + (a[2] * a[2] + a[3] * a[3]) + (b[0] * b[0] + b[1] * b[1]) + (b[2] * b[2] + b[3] * b[3]); } }
        if (!LAST) { const float t2 = wave_sum(s2); if (lane == 0) ((GAS float*)RS)[row] = 1.0f / sqrtf(t2 * (1.0f / DM) + RMS_EPS); }
    }
}

__device__ __forceinline__ void unpack8(const u32x4 w, float (&f)[8]) { f[0] = bflo(w.x); f[1] = bfhi(w.x); f[2] = bflo(w.y); f[3] = bfhi(w.y); f[4] = bflo(w.z); f[5] = bfhi(w.z); f[6] = bflo(w.w); f[7] = bfhi(w.w); }
__device__ __forceinline__ void phase_act(Frame& F, const float* cw, const float* cb) {
    unsigned char* const wsl = optr(F.ws);
    const bf16_t* GU = (const bf16_t*)(wsl + WS_GU); bf16_t* ACT = (bf16_t*)(wsl + WS_ACT);
    constexpr int NCG = DFF / 8, RCH = 32, TOTAL = (MTOK / RCH) * NCG;
    const int tid = otid();
    for (int it = F.bid * NTHR + tid; it < TOTAL; it += F.G * NTHR) {
        const int chunk = it / NCG, cg = it - chunk * NCG, ch = cg * 8, colg = (ch >> 7) * 256 + (ch & 127), colu = colg + 128;
        const int t0 = chunk * RCH, tin0 = t0 & (SEQ - 1);
        float w0[8], w1[8], w2[8], bb[8], g2[8], g1[8];
#pragma unroll
        for (int j = 0; j < 8; ++j) { w0[j] = cw[ch + j]; w1[j] = cw[DFF + ch + j]; w2[j] = cw[2 * DFF + ch + j]; bb[j] = cb[ch + j]; g2[j] = 0.f; g1[j] = 0.f; }
        if (tin0 >= 2) { unpack8(*(const GAS u32x4*)(GU + (size_t)(t0 - 2) * DFF2 + colg), g2); unpack8(*(const GAS u32x4*)(GU + (size_t)(t0 - 1) * DFF2 + colg), g1); }
#pragma unroll 2
        for (int r = 0; r < RCH; ++r) { const size_t ro = (size_t)(t0 + r) * DFF2; float gc[8], up[8], o[8];
            unpack8(*(const GAS u32x4*)(GU + ro + colg), gc); unpack8(*(const GAS u32x4*)(GU + ro + colu), up);
#pragma unroll
            for (int j = 0; j < 8; ++j) { const float z = w0[j] * g2[j] + w1[j] * g1[j] + w2[j] * gc[j] + bb[j]; o[j] = z * sigmoidf_(z) * up[j]; g2[j] = g1[j]; g1[j] = gc[j]; }
            u32x4 w; w.x = cvtpk(o[0], o[1]); w.y = cvtpk(o[2], o[3]); w.z = cvtpk(o[4], o[5]); w.w = cvtpk(o[6], o[7]);
            *(GAS u32x4*)(ACT + (size_t)(t0 + r) * DFF + ch) = w; }
    }
}

__device__ __forceinline__ void phase_actfix(Frame& F, const float* cw, const float* cb) {
    unsigned char* const wsl = optr(F.ws);
    const float* HALO = (const float*)(wsl + WS_HALO); const float* EDGE = (const float*)(wsl + WS_EDGE); bf16_t* ACT = (bf16_t*)(wsl + WS_ACT);
    constexpr int NC4 = DFF / 4, TOTAL = 64 * 2 * NC4;
    const int tid = otid();
    for (int it = F.bid * NTHR + tid; it < TOTAL; it += F.G * NTHR) {
        const int c4 = it % NC4, pr = it / NC4, r = pr & 1, pm = pr >> 1, ch = 4 * c4;
        if ((pm & 31) == 0) continue;
        const float* e = EDGE + ((size_t)((pm * 2 + r) * 2)) * DFF + ch; const float* hprev = HALO + ((size_t)((pm - 1) * 2)) * DFF + ch;
        const f32x4 cur = *(const f32x4*)e, up = *(const GAS f32x4*)(e + DFF);
        const f32x4 p1 = r == 0 ? *(const GAS f32x4*)(hprev + DFF) : *(const GAS f32x4*)(EDGE + ((size_t)((pm * 2) * 2)) * DFF + ch);
        const f32x4 p2 = r == 0 ? *(const f32x4*)hprev : *(const GAS f32x4*)(hprev + DFF);
        f32x4 z = *(const GAS f32x4*)(cw + ch) * p2 + *(const GAS f32x4*)(cw + DFF + ch) * p1 + *(const GAS f32x4*)(cw + 2 * DFF + ch) * cur + *(const GAS f32x4*)(cb + ch);
#pragma unroll
        for (int j = 0; j < 4; ++j) z[j] = z[j] * sigmoidf_(z[j]) * up[j];
        u32x2 w; w.x = cvtpk(z[0], z[1]); w.y = cvtpk(z[2], z[3]);
        *(GAS u32x2*)(ACT + (size_t)(pm * 256 + r) * DFF + ch) = w;
    }
}

__device__ __forceinline__ void phase_cmp2(Frame& F) {
    unsigned char* const wsl = optr(F.ws);
    const int tid = otid(), lane = tid & 63, wave = __builtin_amdgcn_readfirstlane(tid >> 6);
    const int gw = F.bid * NWAVES + wave, NGW = F.G * NWAVES;
    const bf16_t* HID = (const bf16_t*)(wsl + WS_HID); const bf16_t* W2 = (const bf16_t*)(wsl + WS_CMPW2); bf16_t* KVC = (bf16_t*)(wsl + WS_KVC);
    for (int r = gw; r < 2 * 4096; r += NGW) { const int kv = r >> 12;
        const bf16_t* h = HID + (size_t)r * CMP_HID; const bf16_t* wa = W2 + ((size_t)kv * HD + 2 * lane) * CMP_HID; const bf16_t* wb = wa + CMP_HID;
        float s0 = 0.f, s1 = 0.f;
#pragma unroll 4
        for (int k = 0; k < CMP_HID; k += 8) { float hf[8], a[8], b[8]; unpack8(*(const GAS u32x4*)(h + k), hf); unpack8(*(const GAS u32x4*)(wa + k), a); unpack8(*(const GAS u32x4*)(wb + k), b);
#pragma unroll
            for (int j = 0; j < 8; ++j) { s0 += hf[j] * a[j]; s1 += hf[j] * b[j]; } }
        if ((r & 511) == 511) { s0 = 0.f; s1 = 0.f; }
        *(GAS unsigned*)(KVC + (size_t)r * HD + 2 * lane) = cvtpk(s0, s1);
    }
}


namespace att {
constexpr int SHM = 16384;
constexpr int V_OFF = 0, K_OFF = 2 * SHM;
constexpr int SG_OFF = 65536, SL_OFF = SG_OFF + 16384, SELW_OFF = SL_OFF + 16384, TL_OFF = SELW_OFF + 512;
constexpr int WUN_OFF = TL_OFF + 640;
constexpr int ALF_OFF = TL_OFF + 1024;
constexpr float THR2 = 11.5f;
#define KSWZ(row, colB) ((row) * 256 + ((colB) ^ (((row) & 7) << 4)))
#define SBAR() __builtin_amdgcn_sched_barrier(0)
__device__ __forceinline__ int v_st(int k, int c) { const int kk = (k & ~0xC) | ((k & 4) << 1) | ((k & 8) >> 1); return ((kk >> 3) * 4 + (c >> 5)) * 512 + ((kk & 7) * 32 + (c & 31)) * 2; }
__device__ __forceinline__ int v_rd_base(int lane) { return ((lane & 3) << 3) | (((lane >> 2) & 3) << 6) | (((lane >> 4) & 1) << 5) | (((lane >> 5) & 1) << 8); }
constexpr int v_rd_off(int d0, int ks, int half) { return d0 * 512 + ks * 4096 + half * 2048; }
__device__ __forceinline__ int crow(int r, int hi) { return (r & 3) + 8 * (r >> 2) + 4 * hi; }

__device__ __forceinline__ void qkt(f32x16& p0, f32x16& p1, const LAS unsigned char* lds  , int r32, int hi, const bf16x8 (&qr)[8]) {
#pragma unroll
    for (int r = 0; r < 16; ++r) { p0[r] = 0.f; p1[r] = 0.f; }
    const LAS unsigned char* kb[4];
#pragma unroll
    for (int dd = 0; dd < 4; ++dd) kb[dd] = lds + KSWZ(r32, (dd * 16 + hi * 8) * 2);
#pragma unroll
    for (int d0 = 0; d0 < 8; ++d0) { const LAS unsigned char* a = kb[d0 & 3] + (d0 >> 2) * 128;
        const bf16x8 b0 = *(const LAS bf16x8*)a;
        const bf16x8 b1 = *(const LAS bf16x8*)(a + 32 * 256);
        p0 = __builtin_amdgcn_mfma_f32_32x32x16_bf16(b0, qr[d0], p0, 0, 0, 0);
        p1 = __builtin_amdgcn_mfma_f32_32x32x16_bf16(b1, qr[d0], p1, 0, 0, 0);
        if ((d0 & 3) == 3) SBAR(); }
}
__device__ __forceinline__ void pv_tile(f32x16 (&o)[4], int vb0  , bf16x8 pa0, bf16x8 pa1, bf16x8 pa2, bf16x8 pa3) {
#define TRRD(dst, off) asm volatile("ds_read_b64_tr_b16 %0, %1 offset:%2" : "=&v"(dst) : "v"(vb0), "i"(off) : "memory")
#define PV_D0(d0) do { s16x4 l0, l1, l2, l3, h0, h1, h2, h3; constexpr int b_ = v_rd_off(d0, 0, 0); \
        TRRD(l0, b_); TRRD(h0, b_ + 2048); TRRD(l1, b_ + 4096); TRRD(h1, b_ + 6144); TRRD(l2, b_ + 8192); TRRD(h2, b_ + 10240); TRRD(l3, b_ + 12288); TRRD(h3, b_ + 14336); \
        asm volatile("s_waitcnt lgkmcnt(0)" ::: "memory"); SBAR(); \
        o[d0] = __builtin_amdgcn_mfma_f32_32x32x16_bf16((bf16x8){l0[0], l0[1], l0[2], l0[3], h0[0], h0[1], h0[2], h0[3]}, pa0, o[d0], 0, 0, 0); \
        o[d0] = __builtin_amdgcn_mfma_f32_32x32x16_bf16((bf16x8){l1[0], l1[1], l1[2], l1[3], h1[0], h1[1], h1[2], h1[3]}, pa1, o[d0], 0, 0, 0); \
        o[d0] = __builtin_amdgcn_mfma_f32_32x32x16_bf16((bf16x8){l2[0], l2[1], l2[2], l2[3], h2[0], h2[1], h2[2], h2[3]}, pa2, o[d0], 0, 0, 0); \
        o[d0] = __builtin_amdgcn_mfma_f32_32x32x16_bf16((bf16x8){l3[0], l3[1], l3[2], l3[3], h3[0], h3[1], h3[2], h3[3]}, pa3, o[d0], 0, 0, 0); } while (0)
    PV_D0(0); PV_D0(1); PV_D0(2); PV_D0(3);
#undef PV_D0
#undef TRRD
}
__device__ __forceinline__ float red8(float v) {
    v += __int_as_float(__builtin_amdgcn_update_dpp(0, __float_as_int(v), 0xB1, 0xF, 0xF, true));
    v += __int_as_float(__builtin_amdgcn_update_dpp(0, __float_as_int(v), 0x4E, 0xF, 0xF, true));
    v += __int_as_float(__builtin_amdgcn_update_dpp(0, __float_as_int(v), 0x141, 0xF, 0xF, true));
    return v;
}
template <int MODE>
__device__ __forceinline__ void score_mod(f32x16& e0, f32x16& e1, int kidx, int t_row, float sl2, int hi, bool rowok) {
    if (MODE == 0) {
#pragma unroll
        for (int r = 0; r < 16; ++r) { e0[r] *= QK_C2; e1[r] *= QK_C2; }
        return;
    }
    constexpr int CS = (MODE == 1) ? 16 : 1;
    constexpr unsigned W = (MODE == 3) ? 512u : 0x7fffffffu;
    const int dqa = (MODE == 1) ? (t_row - 31 - 1024 * kidx - 64 * hi) : (t_row - kidx - 4 * hi);
    const int dqb = dqa - 32 * CS;
    const float slc = sl2 * (float)CS, ba = -sl2 * (float)dqa, bb = -sl2 * (float)dqb;
    const float NEG = -__builtin_inff();
#pragma unroll
    for (int r = 0; r < 16; ++r) { const int c = (r & 3) + 8 * (r >> 2);
        const float xa = fmaf(e0[r], QK_C2, fmaf(slc, (float)c, ba)), xb = fmaf(e1[r], QK_C2, fmaf(slc, (float)c, bb));
        e0[r] = (rowok && (unsigned)(dqa - CS * c) < W) ? xa : NEG;
        e1[r] = (rowok && (unsigned)(dqb - CS * c) < W) ? xb : NEG; }
}
__device__ __forceinline__ void prefetch_k(LAS unsigned char* lds, const bf16_t* Kp, int key0, int buf, int wave_s) {
    const int tid = otid_w(wave_s), wave = __builtin_amdgcn_readfirstlane(tid >> 6);
#pragma unroll
    for (int j = 0; j < 2; ++j) { const int q = 512 * j + tid, row = q >> 4, cc = (q & 15) ^ (row & 7);
        __builtin_amdgcn_global_load_lds((const unsigned*)(Kp + (size_t)key0 * HD + (unsigned)(row * HD + cc * 8)), (LAS unsigned*)(lds + K_OFF + buf * SHM + j * 8192 + wave * 1024), 16, 0, 0); }
}
__device__ __forceinline__ void prefetch_v(LAS unsigned char* lds, const bf16_t* Vp, int key0, int buf, int wave_s) {
    const int tid = otid_w(wave_s), wave = __builtin_amdgcn_readfirstlane(tid >> 6);
#pragma unroll
    for (int j = 0; j < 2; ++j) { const int q = 512 * j + tid, sb = q >> 5, kk = (sb >> 2) * 8 + ((q & 31) >> 2), c = (sb & 3) * 32 + (q & 3) * 8, k = (kk & ~0xC) | ((kk & 4) << 1) | ((kk & 8) >> 1);
        __builtin_amdgcn_global_load_lds((const unsigned*)(Vp + (size_t)key0 * HD + (unsigned)(k * HD + c)), (LAS unsigned*)(lds + V_OFF + buf * SHM + j * 8192 + wave * 1024), 16, 0, 0); }
}
__device__ __forceinline__ void prefetch_k0(LAS unsigned char* lds, const bf16_t* Kp, int key0, int wave_s) { prefetch_k(lds, Kp, key0, 0, wave_s); }
template <int MODE, int PASS, bool PRE = false, bool CHAIN = false>
__device__ __forceinline__ void attn_pass(LAS unsigned char* lds, const bf16_t* Kp, const bf16_t* Vp, int pitch, int NT, int kb0,
                                          const bf16x8 (&qr)[8], float& m, float& l, float gate, float invl, f32x16 (&o)[4], int t_row, float sl2, int tokl, int wave_s, int par0 = 0) {
    const int tid = otid_w(wave_s), lane = tid & 63, r32 = lane & 31, hi = lane >> 5;
    const int sr = tid >> 4, sc = (tid & 15) * 8, vst0 = v_st(sr, sc), vst1 = v_st(32 + sr, sc), kws = KSWZ(sr, sc * 2);
    const int vb0 = (int)(uintptr_t)lds + V_OFF + v_rd_base(lane);
    const LAS int* TL = (const LAS int*)(lds + TL_OFF);
    const LAS unsigned* SELW = (const LAS unsigned*)(lds + SELW_OFF);
    LAS float* SG = (LAS float*)(lds + SG_OFF); LAS float* SL = (LAS float*)(lds + SL_OFF);
    bf16x8 st_k0, st_k1, st_v0, st_v1;
#define KEY0(i) ((MODE == 2) ? 64 * TL[(i)] : kb0 + 64 * (i))
#define A_LOAD(k0_) do { st_k0 = *(const GAS bf16x8*)(Kp + (size_t)((k0_) + sr) * pitch + sc); st_k1 = *(const GAS bf16x8*)(Kp + (size_t)((k0_) + 32 + sr) * pitch + sc); \
        if (PASS == 2) { st_v0 = *(const GAS bf16x8*)(Vp + (size_t)((k0_) + sr) * pitch + sc); st_v1 = *(const GAS bf16x8*)(Vp + (size_t)((k0_) + 32 + sr) * pitch + sc); } } while (0)
#define A_WRITE(bf) do { *(LAS bf16x8*)(lds + K_OFF + (bf) * SHM + kws) = st_k0; *(LAS bf16x8*)(lds + K_OFF + (bf) * SHM + kws + 32 * 256) = st_k1; \
        if (PASS == 2) { *(LAS bf16x8*)(lds + V_OFF + (bf) * SHM + vst0) = st_v0; *(LAS bf16x8*)(lds + V_OFF + (bf) * SHM + vst1) = st_v1; } } while (0)
#define A_STEP(i, BUF) do { \
        const bool more_ = (i) + 1 < NT; const int kcur_ = KEY0(i); \
        if (more_) { const int kn_ = KEY0((i) + 1); A_LOAD(kn_); } else if (CHAIN) { prefetch_k(lds, Kp, kb0, (BUF) ^ 1, wave_s); } \
        bool rowok_ = true; bool act_ = true; \
        if (MODE == 2) { const int n_ = kcur_ >> 6; rowok_ = ((SELW[tokl * 4 + (n_ >> 5)] >> (n_ & 31)) & 1u) != 0u; act_ = __any(rowok_); } \
        if (act_) { \
            f32x16 e0, e1; qkt(e0, e1, lds + K_OFF + (BUF) * SHM, r32, hi, qr); SBAR(); \
              \
              \
            const int dq_ = (MODE == 1) ? (t_row - 31 - 1024 * (i) - 64 * hi) : 0; \
            const float slc_ = (MODE == 1) ? 16.0f * sl2 : 0.f; \
            const float b00_ = ((MODE == 1) ? -sl2 * (float)dq_ : 0.f) - sh_; \
            f32x2 bp_ = {b00_, b00_ + slc_}; const f32x2 s2_ = {2.0f * slc_, 2.0f * slc_}, s6_ = {6.0f * slc_, 6.0f * slc_}, dB_ = {32.0f * slc_, 32.0f * slc_}, c2v_ = {QK_C2, QK_C2}; \
            _Pragma("unroll") for (int r = 0; r < 16; r += 2) { \
                const f32x2 xa_ = __builtin_elementwise_fma((f32x2){e0[r], e0[r + 1]}, c2v_, bp_), xb_ = __builtin_elementwise_fma((f32x2){e1[r], e1[r + 1]}, c2v_, bp_ + dB_); \
                e0[r] = xa_[0]; e0[r + 1] = xa_[1]; e1[r] = xb_[0]; e1[r + 1] = xb_[1]; \
                if (MODE == 1) bp_ += ((r & 2) == 0) ? s2_ : s6_; } \
            if (MODE == 1 && __any(dq_ - 944 < 0)) { \
                const float NEG_ = -__builtin_inff(); \
                _Pragma("unroll") for (int r = 0; r < 16; ++r) { const int c = (r & 3) + 8 * (r >> 2); \
                    if (dq_ - 16 * c < 0) e0[r] = NEG_; \
                    if (dq_ - 512 - 16 * c < 0) e1[r] = NEG_; } } \
            if (PASS == 1) { \
                float tmax = e0[0]; _Pragma("unroll") for (int r = 1; r < 16; ++r) tmax = fmaxf(tmax, e0[r]); _Pragma("unroll") for (int r = 0; r < 16; ++r) tmax = fmaxf(tmax, e1[r]); \
                { auto rr = __builtin_amdgcn_permlane32_swap(__float_as_uint(tmax), __float_as_uint(tmax), false, false); tmax = fmaxf(__uint_as_float(rr[0]), __uint_as_float(rr[1])); } \
                const float mn = fmaxf(m, tmax); const f32x2 nm_ = {-mn, -mn}; f32x2 ps2_ = {0.f, 0.f}; \
                _Pragma("unroll") for (int r = 0; r < 16; r += 2) { const f32x2 ya_ = (f32x2){e0[r], e0[r + 1]} + nm_, yb_ = (f32x2){e1[r], e1[r + 1]} + nm_; \
                    ps2_ += (f32x2){__builtin_amdgcn_exp2f(ya_[0]), __builtin_amdgcn_exp2f(ya_[1])}; ps2_ += (f32x2){__builtin_amdgcn_exp2f(yb_[0]), __builtin_amdgcn_exp2f(yb_[1])}; } \
                float ps = ps2_[0] + ps2_[1]; \
                { auto rr = __builtin_amdgcn_permlane32_swap(__float_as_uint(ps), __float_as_uint(ps), false, false); ps = __uint_as_float(rr[0]) + __uint_as_float(rr[1]); } \
                l = l * __builtin_amdgcn_exp2f(m - mn) + ps; m = mn; \
            } else { \
                _Pragma("unroll") for (int r = 0; r < 16; ++r) { e0[r] = __builtin_amdgcn_exp2f(e0[r]); e1[r] = __builtin_amdgcn_exp2f(e1[r]); } \
                if (MODE == 1) {        \
                    f32x4 gav_, lav_, gbv_, lbv_; \
                    _Pragma("unroll") for (int rq = 0; rq < 4; ++rq) { \
                        float ga = (e0[4 * rq] + e0[4 * rq + 1]) + (e0[4 * rq + 2] + e0[4 * rq + 3]), la = e0[4 * rq + 3]; \
                        float gb = (e1[4 * rq] + e1[4 * rq + 1]) + (e1[4 * rq + 2] + e1[4 * rq + 3]), lb = e1[4 * rq + 3]; \
                        gav_[rq] = red8(ga); lav_[rq] = red8(la); gbv_[rq] = red8(gb); lbv_[rq] = red8(lb); } \
                      \
                    if ((r32 & 7) == 0) { const int sa_ = tokl * 128 + 16 * (i) + 4 * hi; \
                        *(LAS f32x4*)(SG + sa_) = gav_ * rg_; *(LAS f32x4*)(SL + sa_) = lav_ * rg_; *(LAS f32x4*)(SG + sa_ + 8) = gbv_ * rg_; *(LAS f32x4*)(SL + sa_ + 8) = lbv_ * rg_; } \
                } \
                bf16x8 pa0, pa1, pa2, pa3; \
                PK4(e0, 0, pa0); PK4(e0, 8, pa1); PK4(e1, 0, pa2); PK4(e1, 8, pa3); \
                SBAR(); pv_tile(o, vb0 + (BUF) * SHM, pa0, pa1, pa2, pa3); \
            } \
        } \
        if (more_) { VM_WAIT(); A_WRITE((BUF) ^ 1); } \
        __syncthreads(); } while (0)
#define PK4(P, B_, OUT) do { unsigned a0 = cvtpk(P[B_ + 0], P[B_ + 1]), a1 = cvtpk(P[B_ + 2], P[B_ + 3]); \
        unsigned b0 = cvtpk(P[B_ + 4], P[B_ + 5]), b1 = cvtpk(P[B_ + 6], P[B_ + 7]); \
        auto r0 = __builtin_amdgcn_permlane32_swap(a0, b0, false, false); auto r1 = __builtin_amdgcn_permlane32_swap(a1, b1, false, false); \
        u32x4 w = {r0[0], r1[0], r0[1], r1[1]}; OUT = *reinterpret_cast<bf16x8*>(&w); } while (0)
    if (NT <= 0) return;
    const float gc_ = fmaxf(gate, 1e-30f), sh_ = (PASS == 2) ? m - __builtin_amdgcn_logf(gc_ * invl) : 0.f, rg_ = __builtin_amdgcn_rcpf(gc_);
    if (!PRE) { const int k0 = KEY0(0); A_LOAD(k0); VM_WAIT(); A_WRITE(par0); } else { VM_WAIT(); }
    __syncthreads();
#pragma unroll 1
    for (int i = 0; i < NT; ++i) { const int buf = (i + par0) & 1; A_STEP(i, buf); }
#undef PK4
#undef A_STEP
#undef A_WRITE
#undef A_LOAD
#undef KEY0
}

template <int MODE, bool PRE = false, int PITCH = HD>
__device__ __forceinline__ void attn_online(LAS unsigned char* lds, const bf16_t* Kp, const bf16_t* Vp, int NT, int kb0,
                                            const bf16x8 (&qr)[8], float& m, float& l, f32x16 (&o)[4], int t_row, int tw0, float sl2, int tokl, int wave_s) {
    const int tid = otid_w(wave_s), lane = tid & 63, r32 = lane & 31, hi = lane >> 5, wave = __builtin_amdgcn_readfirstlane(tid >> 6);
    const int vb0 = (int)(uintptr_t)lds + V_OFF + v_rd_base(lane);
    const LAS int* TL = (const LAS int*)(lds + TL_OFF);
    const LAS unsigned* SELW = (const LAS unsigned*)(lds + SELW_OFF);
    constexpr int pitch = PITCH;
    unsigned gko[2], gvo[2];
#pragma unroll
    for (int j = 0; j < 2; ++j) { const int q = 512 * j + tid;
        { const int row = q >> 4, cc = (q & 15) ^ (row & 7); gko[j] = (unsigned)(row * pitch + cc * 8); }
        { const int sb = q >> 5, kk = (sb >> 2) * 8 + ((q & 31) >> 2), c = (sb & 3) * 32 + (q & 3) * 8, k = (kk & ~0xC) | ((kk & 4) << 1) | ((kk & 8) >> 1); gvo[j] = (unsigned)(k * pitch + c); } }
    const unsigned ldsw = (unsigned)wave * 1024u;
    bf16x8 kx0, kx1, qx;
    { const float kr = (float)r32, bh = sl2 * (1.0f / QK_C2); const unsigned bhb = cvtpk(bh, 0.f) & 0xffffu; const float bl = bh - __uint_as_float(bhb << 16);
      u32x4 a = {hi == 0 ? cvtpk(kr, kr) : 0u, 0u, 0u, 0u}, b = {hi == 0 ? cvtpk(kr + 32.f, kr + 32.f) : 0u, 0u, 0u, 0u}, c = {hi == 0 ? cvtpk(bh, bl) : 0u, 0u, 0u, 0u};
      kx0 = *reinterpret_cast<bf16x8*>(&a); kx1 = *reinterpret_cast<bf16x8*>(&b); qx = *reinterpret_cast<bf16x8*>(&c); }
#define KEY0(i) ((MODE == 2) ? 64 * TL[(i)] : kb0 + 64 * (i))
#define DMA_K(k0_, bf) do { _Pragma("unroll") for (int j_ = 0; j_ < 2; ++j_) \
        __builtin_amdgcn_global_load_lds((const unsigned*)(Kp + (size_t)(k0_) * pitch + gko[j_]), (LAS unsigned*)(lds + K_OFF + (bf) * SHM + j_ * 8192 + ldsw), 16, 0, 0); } while (0)
#define DMA_V(k0_, bf) do { _Pragma("unroll") for (int j_ = 0; j_ < 2; ++j_) \
        __builtin_amdgcn_global_load_lds((const unsigned*)(Vp + (size_t)(k0_) * pitch + gvo[j_]), (LAS unsigned*)(lds + V_OFF + (bf) * SHM + j_ * 8192 + ldsw), 16, 0, 0); } while (0)
#define PK4(P, B_, OUT) do { unsigned a0 = cvtpk(P[B_ + 0], P[B_ + 1]), a1 = cvtpk(P[B_ + 2], P[B_ + 3]); \
        unsigned b0 = cvtpk(P[B_ + 4], P[B_ + 5]), b1 = cvtpk(P[B_ + 6], P[B_ + 7]); \
        auto r0 = __builtin_amdgcn_permlane32_swap(a0, b0, false, false); auto r1 = __builtin_amdgcn_permlane32_swap(a1, b1, false, false); \
        u32x4 w = {r0[0], r1[0], r0[1], r1[1]}; OUT = *reinterpret_cast<bf16x8*>(&w); } while (0)
#define QK_TILE(i_, E0, E1, ROK, ACT) do { const int kc_ = KEY0(i_); ROK = true; ACT = true; \
        if (MODE == 2) { const int n_ = kc_ >> 6; ROK = ((SELW[tokl * 4 + (n_ >> 5)] >> (n_ & 31)) & 1u) != 0u; ACT = __any(ROK); } \
        if (ACT) { qkt(E0, E1, lds + K_OFF + ((i_) & 1) * SHM, r32, hi, qr); \
            E0 = __builtin_amdgcn_mfma_f32_32x32x16_bf16(kx0, qx, E0, 0, 0, 0); \
            E1 = __builtin_amdgcn_mfma_f32_32x32x16_bf16(kx1, qx, E1, 0, 0, 0); } } while (0)
#define PART_SM(i_, E0, E1, ROK, AL_) do { const int kcur = KEY0(i_); \
        const float NEG = -__builtin_inff(); \
        const float tb = (ROK) ? -sl2 * (float)(t_row - kcur) : NEG; \
        const bool interior = (MODE == 3) ? (kcur + 63 <= tw0 && kcur >= tw0 + 3 - 511) : (kcur + 63 <= tw0); \
        if (!interior) { \
            constexpr unsigned W = (MODE == 3) ? 512u : 0x7fffffffu; \
            const int dqa = t_row - kcur - 4 * hi, dqb = dqa - 32; \
            _Pragma("unroll") for (int r = 0; r < 16; ++r) { const int c = (r & 3) + 8 * (r >> 2); \
                if ((unsigned)(dqa - c) >= W) E0[r] = NEG; \
                if ((unsigned)(dqb - c) >= W) E1[r] = NEG; } \
        } \
        float pmax = E0[0];        \
        _Pragma("unroll") for (int r = 1; r < 16; ++r) pmax = fmaxf(pmax, E0[r]); \
        _Pragma("unroll") for (int r = 0; r < 16; ++r) pmax = fmaxf(pmax, E1[r]); \
        { auto rr = __builtin_amdgcn_permlane32_swap(__float_as_uint(pmax), __float_as_uint(pmax), false, false); pmax = fmaxf(__uint_as_float(rr[0]), __uint_as_float(rr[1])); } \
        pmax = fmaf(pmax, QK_C2, tb); \
        float mn; \
        if (__all((pmax - m) <= THR2)) { mn = m; AL_ = 1.f; } \
        else { mn = fmaxf(m, pmax); AL_ = __builtin_amdgcn_exp2f(m - mn); m = mn; } \
        const float c0_ = tb - mn; \
        _Pragma("unroll") for (int r = 0; r < 16; r += 2) { \
            const f32x2 xa_ = __builtin_elementwise_fma((f32x2){E0[r], E0[r + 1]}, (f32x2){QK_C2, QK_C2}, (f32x2){c0_, c0_}), xb_ = __builtin_elementwise_fma((f32x2){E1[r], E1[r + 1]}, (f32x2){QK_C2, QK_C2}, (f32x2){c0_, c0_}); \
            E0[r] = __builtin_amdgcn_exp2f(xa_[0]); E0[r + 1] = __builtin_amdgcn_exp2f(xa_[1]); E1[r] = xb_[0]; E1[r + 1] = xb_[1]; } \
        if (__any(AL_ < 1.f)) {        \
            _Pragma("unroll") for (int d0 = 0; d0 < 4; ++d0) \
                _Pragma("unroll") for (int r = 0; r < 16; ++r) o[d0][r] *= AL_; } } while (0)
#define FIN_SM(E0, E1, AL_) do { \
        f32x2 ps2 = {0.f, 0.f}; \
        _Pragma("unroll") for (int r = 0; r < 16; r += 2) { E1[r] = __builtin_amdgcn_exp2f(E1[r]); E1[r + 1] = __builtin_amdgcn_exp2f(E1[r + 1]); \
            ps2 += (f32x2){E0[r], E0[r + 1]}; ps2 += (f32x2){E1[r], E1[r + 1]}; } \
        float ps = ps2[0] + ps2[1]; \
        { auto rr = __builtin_amdgcn_permlane32_swap(__float_as_uint(ps), __float_as_uint(ps), false, false); ps = __uint_as_float(rr[0]) + __uint_as_float(rr[1]); } \
        l = l * AL_ + ps; \
        PK4(E0, 0, pa0); PK4(E0, 8, pa1); PK4(E1, 0, pa2); PK4(E1, 8, pa3); } while (0)
#define PSTEP(t_, X0, X1, ROKX, ACTX, ALX, Y0, Y1, ACTY, ALY) do { \
        if ((t_) + 1 < NT) { const int k1_ = KEY0((t_) + 1); DMA_K(k1_, ((t_) + 1) & 1); } \
        if ((t_) < NT) { const int k0_ = KEY0(t_); DMA_V(k0_, (t_) & 1); QK_TILE(t_, X0, X1, ROKX, ACTX); } else { ACTX = false; } \
        if ((t_) > 0 && ACTY) { bf16x8 pa0, pa1, pa2, pa3; FIN_SM(Y0, Y1, ALY); pv_tile(o, vb0 + (((t_) + 1) & 1) * SHM, pa0, pa1, pa2, pa3); } \
        if (ACTX) PART_SM(t_, X0, X1, ROKX, ALX); \
        VM_WAIT(); \
        __syncthreads(); } while (0)
    if (NT <= 0) return;
    { if (!PRE) { const int k0 = KEY0(0); DMA_K(k0, 0); } VM_WAIT(); }
    __syncthreads();
    f32x16 eA0, eA1, eB0, eB1; bool rokA = true, actA = false, rokB = true, actB = false; float alA = 1.f, alB = 1.f;
#pragma unroll
    for (int r = 0; r < 16; ++r) { eA0[r] = 0.f; eA1[r] = 0.f; eB0[r] = 0.f; eB1[r] = 0.f; }
#pragma unroll 1
    for (int t = 0; t <= NT; t += 2) {
        PSTEP(t, eA0, eA1, rokA, actA, alA, eB0, eB1, actB, alB);
        if (t + 1 <= NT) PSTEP(t + 1, eB0, eB1, rokB, actB, alB, eA0, eA1, actA, alA);
    }
#undef PART_SM
#undef FIN_SM
#undef PSTEP
#undef QK_TILE
#undef PK4
#undef DMA_V
#undef DMA_K
#undef KEY0
}
__device__ __forceinline__ void scale_rows(f32x16 (&o)[4], float fac) {
#pragma unroll
    for (int d0 = 0; d0 < 4; ++d0)
#pragma unroll
        for (int r = 0; r < 16; ++r) o[d0][r] *= fac;
}
#define ATT_STORE_O(ROWPTR) do { bf16_t* op_ = (ROWPTR) + (hi ? 8 : 0); \
    _Pragma("unroll") for (int d0 = 0; d0 < 4; ++d0) { \
        _Pragma("unroll") for (int rg = 0; rg < 4; rg += 2) { \
            unsigned ax = cvtpk(o[d0][4 * rg + 0], o[d0][4 * rg + 1]), ay = cvtpk(o[d0][4 * rg + 2], o[d0][4 * rg + 3]); \
            unsigned bx = cvtpk(o[d0][4 * rg + 4], o[d0][4 * rg + 5]), by = cvtpk(o[d0][4 * rg + 6], o[d0][4 * rg + 7]); \
            { auto rr = __builtin_amdgcn_permlane32_swap(ax, bx, false, false); ax = rr[0]; bx = rr[1]; } \
            { auto rr = __builtin_amdgcn_permlane32_swap(ay, by, false, false); ay = rr[0]; by = rr[1]; } \
            u32x4 w_ = {ax, ay, bx, by}; *(GAS u32x4*)(op_ + d0 * 32 + rg * 8) = w_; } } } while (0)
}

__device__ __forceinline__ void phase_xattn(Frame& F, int L) {
    unsigned char* const wsl = optr(F.ws);
    const bf16_t* QX = (const bf16_t*)(wsl + WS_QX); const bf16_t* KVM = (const bf16_t*)(wsl + WS_KVMEM) + (size_t)L * MMEM * 2 * XAW; bf16_t* OX = (bf16_t*)(wsl + WS_OX);
    for (int u = F.bid; u < BATCH * 4 * (SEQ / 256); u += F.G) {
        const int tid = otid(), lane = tid & 63, r32 = lane & 31, hi = lane >> 5, wave = __builtin_amdgcn_readfirstlane(tid >> 6);
        const int qb = u % (SEQ / 256), hd = (u / (SEQ / 256)) & 3, b = u / (4 * (SEQ / 256));
        const int t = qb * 256 + wave * 32 + r32; const size_t row = (size_t)b * SEQ + t;
        bf16x8 qr[8];
#pragma unroll
        for (int d0 = 0; d0 < 8; ++d0) qr[d0] = *(const GAS bf16x8*)(QX + row * XAW + hd * HD + d0 * 16 + hi * 8);
        const bf16_t* Kp = KVM + (size_t)b * MEMLEN * 2 * XAW + hd * HD; const bf16_t* Vp = Kp + XAW;
        f32x16 o[4];
#pragma unroll
        for (int d0 = 0; d0 < 4; ++d0)
#pragma unroll
            for (int r = 0; r < 16; ++r) o[d0][r] = 0.f;
        float m = -1e30f, l = 0.f;
        att::attn_online<3, false, 2 * XAW>(F.lds, Kp, Vp, MEMLEN / 64, 0, qr, m, l, o, 0, 300, 0.f, 0, F.wv);
        att::scale_rows(o, l > 0.f ? 1.0f / l : 0.f);
        ATT_STORE_O(OX + ((size_t)b * SEQ + qb * 256 + wave * 32 + r32) * XAW + hd * HD);
    }
}

#ifndef TP_NSA_SEC
#define TP_NSA_SEC 0
#endif
__device__ __forceinline__ void phase_nsa(Frame& F, unsigned long long& tp_acc, const Args& A) {
    unsigned char* const wsl = optr(F.ws);
    unsigned long long tp_s = 0ull;
#define NSEC_B(k) do { if (TP_NSA_SEC == (k)) tp_s = __builtin_amdgcn_s_memrealtime(); } while (0)
#define NSEC_E(k) do { if (TP_NSA_SEC == (k)) tp_acc += __builtin_amdgcn_s_memrealtime() - tp_s; } while (0)
    const bf16_t* NQ = (const bf16_t*)(wsl + WS_NQ); const bf16_t* NKV = (const bf16_t*)(wsl + WS_NKV); const bf16_t* KVC = (const bf16_t*)(wsl + WS_KVC);
    const float* GT = (const float*)(wsl + WS_GATES); bf16_t* NO = (bf16_t*)(wsl + WS_NO);
    LAS unsigned char* lds = F.lds;
    LAS float* SG = (LAS float*)(lds + att::SG_OFF); LAS float* SL = (LAS float*)(lds + att::SL_OFF);
    LAS unsigned* SELW = (LAS unsigned*)(lds + att::SELW_OFF); LAS int* TL = (LAS int*)(lds + att::TL_OFF); LAS unsigned* WUN = (LAS unsigned*)(lds + att::WUN_OFF);
    constexpr int NQB = SEQ / 32, NUNITS = BATCH * NSA_G * NQB;
    bf16x8 qr[8];
#define NSA_SEAM(u_) do { const int tid_ = otid(), ln_ = tid_ & 63, wv_ = __builtin_amdgcn_readfirstlane(tid_ >> 6); \
        const int qb_ = NQB - 1 - (u_) / (BATCH * NSA_G), bg_ = (u_) % (BATCH * NSA_G), b_ = bg_ >> 2, g_ = bg_ & 3, t0_ = qb_ * 32; \
        const size_t row_ = (size_t)b_ * SEQ + t0_ + 4 * wv_ + ((ln_ & 31) >> 3); const int head_ = g_ * 8 + (ln_ & 7); \
        _Pragma("unroll") for (int d0 = 0; d0 < 8; ++d0) qr[d0] = *(const GAS bf16x8*)(NQ + row_ * QW + head_ * HD + d0 * 16 + (ln_ >> 5) * 8); \
        att::prefetch_k0(lds, NKV + ((size_t)((((2 * 2 + 0) * 2 + b_) * 4 + g_)) * SEQ) * HD, ((t0_ - 511 > 0 ? t0_ - 511 : 0) >> 6) * 64, F.wv); } while (0)
    LAS int* NXT = (LAS int*)(lds + att::TL_OFF + 600);
    unsigned* qctr = F.ctl + 1024;
    if (F.bid < NUNITS) NSA_SEAM(F.bid);
    constexpr int CV_NGU = (DM / 64) * (DFF2 / 64), CV_NDN = TAILFILL ? 0 : (DFF / 64) * (DM / 64), CV_NNO = C2FILL ? 0 : (QW / 64) * (DM / 64), CV_NXQ = (DM / 64) * (XAW / 64), CV_NXO = (XAW / 64) * (DM / 64);
    constexpr int CV_E1 = CV_NGU + CV_NDN, CV_E2 = CV_E1 + CV_NNO, CV_E3 = CV_E2 + CV_NXQ, CV_ALL = CV_E3 + CV_NXO;
    int cv_it = DEFER_CONV ? F.bid * NWAVES + F.wv : CV_ALL;
#define NSA_CONV(maxn_) do { LAS unsigned* scr_ = (LAS unsigned*)(lds + F.wv * 8448); const int ln_c = otid() & 63; \
        _Pragma("unroll 1") for (int c_ = 0; c_ < (maxn_) && cv_it < CV_ALL; ++c_, cv_it += F.G * NWAVES) { \
            if (cv_it < CV_NGU) p0_transpose_item<1>(A.in[IN_FFN_WGU] + (size_t)DM * DFF2, DM, DFF2, (bf16_t*)(wsl + WS_WGU + (size_t)DFF2 * DM * 2), A.in[IN_LN_FFN] + (size_t)2 * DM, scr_, cv_it, ln_c); \
            else if (cv_it < CV_E1) p0_transpose_item<0>(A.in[IN_FFN_WDN] + (size_t)DFF * DM, DFF, DM, (bf16_t*)(wsl + WS_WDN + (size_t)DM * DFF * 2), nullptr, scr_, cv_it - CV_NGU, ln_c); \
            else if (cv_it < CV_E2) p0_transpose_item<0>(A.in[IN_NSA_W_OUT], QW, DM, (bf16_t*)(wsl + WS_NSAOUT), nullptr, scr_, cv_it - CV_E1, ln_c); \
            else if (cv_it < CV_E3) p0_transpose_item<0>(A.in[IN_XA_WQ] + (size_t)DM * XAW, DM, XAW, (bf16_t*)(wsl + WS_XAQ + (size_t)XAW * DM * 2), A.in[IN_LN_XA] + (size_t)2 * DM, scr_, cv_it - CV_E2, ln_c); \
            else p0_transpose_item<0>(A.in[IN_XA_WO] + (size_t)XAW * DM, XAW, DM, (bf16_t*)(wsl + WS_XAO + (size_t)DM * XAW * 2), nullptr, scr_, cv_it - CV_E3, ln_c); } } while (0)
    int it_ = 0;
    for (int u = F.bid; u < NUNITS; ) {
        const int tid = otid(), lane = tid & 63, r32 = lane & 31, hi = lane >> 5, wave = __builtin_amdgcn_readfirstlane(tid >> 6);
        if (tid == 0) NXT[it_ & 1] = F.G + (int)__hip_atomic_fetch_add(qctr, 1u, __ATOMIC_RELAXED, __HIP_MEMORY_SCOPE_AGENT);
        const int qb = NQB - 1 - u / (BATCH * NSA_G), bg = u % (BATCH * NSA_G), b = bg >> 2, g = bg & 3;
        const int t0 = qb * 32, tokl = 4 * wave + (r32 >> 3), j = r32 & 7, t = t0 + tokl, head = g * 8 + j;
        const float sl2 = __builtin_amdgcn_exp2f(-0.25f * (float)(head + 1)) * LOG2E;
        f32x16 o[4];
#pragma unroll
        for (int d0 = 0; d0 < 4; ++d0)
#pragma unroll
            for (int r = 0; r < 16; ++r) o[d0][r] = 0.f;
        const int tw0 = t0 + 4 * wave;
        NSEC_B(1);
        { const int jlo = (t0 - 511 > 0 ? t0 - 511 : 0) >> 6, jhi = (t0 + 31) >> 6, NTw = jhi - jlo + 1;
          const bf16_t* Kw = NKV + ((size_t)((((2 * 2 + 0) * 2 + b) * 4 + g)) * SEQ) * HD; const bf16_t* Vw = NKV + ((size_t)((((2 * 2 + 1) * 2 + b) * 4 + g)) * SEQ) * HD;
          float m = -1e30f, l = 0.f;
          att::attn_online<3, true>(lds, Kw, Vw, NTw, jlo * 64, qr, m, l, o, t, tw0, sl2, tokl, F.wv);
          att::prefetch_k(lds, KVC + (size_t)(bg * 512) * HD, 0, 0, F.wv);
          int tg_g_w = t; asm volatile("" : "+v"(tg_g_w)); const float g_w = *(const GAS float*)(GT + ((size_t)b * SEQ + tg_g_w) * GW_ + 64 + head); att::scale_rows(o, l > 0.f ? g_w / l : 0.f); }
        NSEC_E(1); NSEC_B(2);
        { const bf16_t* Kc = KVC + (size_t)(bg * 512) * HD; const bf16_t* Vc = KVC + (size_t)(4096 + bg * 512) * HD;
          const int NTc = t0 / 1024 + 1; float m = -1e30f, l = 0.f; int tg_g_c = t; asm volatile("" : "+v"(tg_g_c)); const float g_c = *(const GAS float*)(GT + ((size_t)b * SEQ + tg_g_c) * GW_ + head);
          const int p2 = NTc & 1;
          att::prefetch_v(lds, Vc, 0, p2, F.wv);
          att::attn_pass<1, 1, true, true>(lds, Kc, Vc, HD, NTc, 0, qr, m, l, g_c, 0.f, o, t, sl2, tokl, F.wv, 0);
          const float invl = l > 0.f ? 1.0f / l : 0.f;
          att::attn_pass<1, 2, true>(lds, Kc, Vc, HD, NTc, 0, qr, m, l, g_c, invl, o, t, sl2, tokl, F.wv, p2); }
        att::prefetch_k0(lds, NKV + ((size_t)((((1 * 2 + 0) * 2 + b) * 4 + g)) * SEQ) * HD, 0, F.wv);
        NSEC_E(2); NSEC_B(3);
        {
            unsigned wsel[4][4];
#pragma unroll
            for (int i4 = 0; i4 < 4; ++i4) {
                const int tk = 4 * wave + i4, cur = (t0 + tk) >> 6, n0 = lane, n1 = lane + 64;
                const int nlim = 16 * (t0 / 1024 + 1);
#define SGSLOT(n_) (((n_) & ~15) | (((((n_) >> 3) & 1) * 2 + ((n_) & 1)) << 2) | (((n_) >> 1) & 3))
                const float s0 = (n0 < nlim ? SG[tk * 128 + SGSLOT(n0)] : 0.f) + ((n0 > 0 && n0 <= nlim) ? SL[tk * 128 + SGSLOT(n0 - 1)] : 0.f), s1 = (n1 < nlim ? SG[tk * 128 + SGSLOT(n1)] : 0.f) + (n1 <= nlim ? SL[tk * 128 + SGSLOT(n1 - 1)] : 0.f);
#undef SGSLOT
                const float v0 = (n0 == 0 || n0 == cur || n0 == cur - 1) ? 1e6f : fmaxf(s0, 0.f), v1 = (n1 == cur || n1 == cur - 1) ? 1e6f : fmaxf(s1, 0.f);
                const unsigned k0 = n0 > cur ? 0u : __float_as_uint(v0) + 1u, k1 = n1 > cur ? 0u : __float_as_uint(v1) + 1u;
                unsigned T = 0u;
#pragma unroll
                for (int bit = 30; bit >= 0; --bit) { const unsigned cand = T | (1u << bit);
                    const int cnt = __builtin_popcountll(__ballot(k0 >= cand)) + __builtin_popcountll(__ballot(k1 >= cand));
                    T = cnt >= 16 ? cand : T; }
                unsigned long long g0 = __ballot(k0 > T), g1 = __ballot(k1 > T);
                unsigned long long q0 = T ? __ballot(k0 == T) : 0ull, q1 = T ? __ballot(k1 == T) : 0ull;
                int need = 16 - __builtin_popcountll(g0) - __builtin_popcountll(g1);
                while (need > 0 && q0) { const unsigned long long lb = q0 & (0ull - q0); g0 |= lb; q0 ^= lb; --need; }
                while (need > 0 && q1) { const unsigned long long lb = q1 & (0ull - q1); g1 |= lb; q1 ^= lb; --need; }
                wsel[i4][0] = (unsigned)g0; wsel[i4][1] = (unsigned)(g0 >> 32); wsel[i4][2] = (unsigned)g1; wsel[i4][3] = (unsigned)(g1 >> 32);
            }
            if (lane == 0) {
#pragma unroll
                for (int i4 = 0; i4 < 4; ++i4) { const int tk = 4 * wave + i4; SELW[tk * 4 + 0] = wsel[i4][0]; SELW[tk * 4 + 1] = wsel[i4][1]; SELW[tk * 4 + 2] = wsel[i4][2]; SELW[tk * 4 + 3] = wsel[i4][3]; }
#pragma unroll
                for (int q = 0; q < 4; ++q) WUN[wave * 4 + q] = wsel[0][q] | wsel[1][q] | wsel[2][q] | wsel[3][q];
            }
        }
        asm volatile("s_waitcnt lgkmcnt(0)" ::: "memory"); __builtin_amdgcn_s_barrier(); asm volatile("" ::: "memory");
        if (wave == 0) {
            unsigned u0 = 0u, u1 = 0u;
#pragma unroll
            for (int wv = 0; wv < 8; ++wv) { u0 |= (WUN[wv * 4 + (lane >> 5)] >> (lane & 31)) & 1u; u1 |= (WUN[wv * 4 + 2 + (lane >> 5)] >> (lane & 31)) & 1u; }
            const unsigned long long b0 = __ballot(u0 != 0u), b1 = __ballot(u1 != 0u), lt = (1ull << lane) - 1ull; const int c0 = __builtin_popcountll(b0);
            if (u0) TL[__builtin_popcountll(b0 & lt)] = lane;
            if (u1) TL[c0 + __builtin_popcountll(b1 & lt)] = 64 + lane;
            if (lane == 0) TL[128] = c0 + __builtin_popcountll(b1);
        }
        { const int ln_ = otid() & 63; u32x4* stash = (u32x4*)((float*)(wsl + WS_STASH) + ((size_t)(F.bid * NWAVES + wave) * 64) * 64) + ln_;
#pragma unroll
        for (int d0 = 0; d0 < 4; ++d0)
#pragma unroll
            for (int rp = 0; rp < 2; ++rp) { u32x4 w_; w_.x = cvtpk(o[d0][8 * rp], o[d0][8 * rp + 1]); w_.y = cvtpk(o[d0][8 * rp + 2], o[d0][8 * rp + 3]); w_.z = cvtpk(o[d0][8 * rp + 4], o[d0][8 * rp + 5]); w_.w = cvtpk(o[d0][8 * rp + 6], o[d0][8 * rp + 7]);
                *(GAS u32x4*)(stash + (d0 * 2 + rp) * 64) = w_;
#pragma unroll
                for (int r = 0; r < 8; ++r) o[d0][8 * rp + r] = 0.f; } }
        asm volatile("s_waitcnt lgkmcnt(0)" ::: "memory"); __builtin_amdgcn_s_barrier(); asm volatile("" ::: "memory");
        NSEC_E(3); NSEC_B(4);
        { const int NTs = TL[128]; if (TP_NSA_SEC == 9) tp_acc += (unsigned long long)NTs * 100ull; if (TP_NSA_SEC == 10) { const LAS unsigned* SW_ = (const LAS unsigned*)(lds + att::SELW_OFF); int na_ = 0; for (int i_ = 0; i_ < NTs; ++i_) { const int n_ = ((const LAS int*)(lds + att::TL_OFF))[i_]; unsigned any_ = 0u; for (int k_ = 0; k_ < 4; ++k_) any_ |= (SW_[(4 * wave + k_) * 4 + (n_ >> 5)] >> (n_ & 31)) & 1u; na_ += (int)any_; } tp_acc += (unsigned long long)na_ * 100ull; } const bf16_t* Ks = NKV + ((size_t)((((1 * 2 + 0) * 2 + b) * 4 + g)) * SEQ) * HD; const bf16_t* Vs = NKV + ((size_t)((((1 * 2 + 1) * 2 + b) * 4 + g)) * SEQ) * HD;
          float m = -1e30f, l = 0.f;
          att::attn_online<2, true>(lds, Ks, Vs, NTs, 0, qr, m, l, o, t, tw0, sl2, tokl, F.wv);
          int tg_g_s = t; asm volatile("" : "+v"(tg_g_s)); const float g_s = *(const GAS float*)(GT + ((size_t)b * SEQ + tg_g_s) * GW_ + 32 + head); att::scale_rows(o, l > 0.f ? g_s / l : 0.f); }
        NSEC_E(4);
        if (DEFER_CONV) { NSA_CONV(3); __syncthreads(); }
        const int un = __builtin_amdgcn_readfirstlane(NXT[it_ & 1]);
        if (un < NUNITS) NSA_SEAM(un);
        { const int ln_ = otid() & 63, r32 = ln_ & 31, hi = ln_ >> 5; const u32x4* stash = (const u32x4*)((const float*)(wsl + WS_STASH) + ((size_t)(F.bid * NWAVES + wave) * 64) * 64) + ln_;
#pragma unroll
        for (int d0 = 0; d0 < 4; ++d0)
#pragma unroll
            for (int rp = 0; rp < 2; ++rp) { const u32x4 w_ = *(const GAS u32x4*)(stash + (d0 * 2 + rp) * 64);
                o[d0][8 * rp + 0] += __uint_as_float(w_.x << 16); o[d0][8 * rp + 1] += __uint_as_float(w_.x & 0xffff0000u); o[d0][8 * rp + 2] += __uint_as_float(w_.y << 16); o[d0][8 * rp + 3] += __uint_as_float(w_.y & 0xffff0000u);
                o[d0][8 * rp + 4] += __uint_as_float(w_.z << 16); o[d0][8 * rp + 5] += __uint_as_float(w_.z & 0xffff0000u); o[d0][8 * rp + 6] += __uint_as_float(w_.w << 16); o[d0][8 * rp + 7] += __uint_as_float(w_.w & 0xffff0000u); }
        ATT_STORE_O(NO + ((size_t)b * SEQ + t0 + 4 * wave + (r32 >> 3)) * QW + (g * 8 + (r32 & 7)) * HD); }
        u = un; ++it_;
    }
    if (DEFER_CONV) { __syncthreads(); NSA_CONV(1 << 30); }
#undef NSA_CONV
}

constexpr int NPH = 30;
#ifndef HALFM
#define HALFM 1
#endif
__global__ void __launch_bounds__(NTHR, 2) mk_fwd(Args args) {
    extern __shared__ __attribute__((aligned(16))) unsigned char lds_raw[];
    Frame F;
    F.lds = (LAS unsigned char*)lds_raw;
    F.MISC = (volatile LAS unsigned*)(F.lds + MISC_OFF);
    F.wv = __builtin_amdgcn_readfirstlane((int)threadIdx.x >> 6);
    F.G = gridDim.x; F.bid = blockIdx.x; F.ws = args.ws; F.out = args.out;
    F.ctl = (unsigned*)(args.ws + WS_CTL);
    for (int u = threadIdx.x; u < (LDS_BYTES - LDSCTL_OFF) / 4; u += NTHR) ((LAS unsigned*)(F.lds + LDSCTL_OFF))[u] = 0u;
    __syncthreads();
    const int lo = args.ph_lo, hi = args.ph_hi;
    XcdBarrier bar; bar.bar = F.ctl + CW_BAR; bar.x = 0; bar.st = nullptr;
    if (hi - lo > 1) bar = xcd_barrier_post(F.ctl + CW_BAR, F.MISC + 8);
#ifndef PH_MASK
#define PH_MASK 0xffffffffu
#endif
#define EN(i) ((PH_MASK >> (i)) & 1u)
#ifndef REP_MASK
#define REP_MASK 0u
#endif
#define REPS(i) (1 + (int)((REP_MASK >> (i)) & 1u))
#define IN(k) (lo <= (k) && (k) < hi)
#ifndef TP_MODE
#define TP_MODE 0
#endif
#ifndef TP_AMP
#define TP_AMP 3
#endif
    unsigned long long tp_acc = 0ull, tp_t0 = 0ull;
#ifndef TP_MASK
#define TP_MASK 0u
#endif
#define TPS(i) ((TP_MASK >> (i)) & 1u)
#define TP_BEGIN(mode) do { if (TP_MODE == (mode)) tp_t0 = __builtin_amdgcn_s_memrealtime(); } while (0)
#define TP_END(mode) do { if (TP_MODE == (mode)) tp_acc += __builtin_amdgcn_s_memrealtime() - tp_t0; } while (0)
#define HN ((bf16_t*)(ws + WS_HN))
#define Yb ((bf16_t*)(ws + WS_Y))
#define SSP ((float*)(ws + WS_SSP))
#define SEAM(k) do { if ((k) + 1 < hi) { TP_BEGIN(1); xcd_barrier(bar); TP_END(1); } } while (0)
    unsigned char* const ws_k = args.ws;

    if (EN(0) && IN(0)) { if (TPS(0)) tp_t0 = __builtin_amdgcn_s_memrealtime(); for (int rep_ = 0; rep_ < REPS(0); ++rep_) { phase_p0(F, args); } if (TPS(0)) tp_acc += __builtin_amdgcn_s_memrealtime() - tp_t0; SEAM(0); }
    if (EN(1) && IN(1)) { if (TPS(1)) tp_t0 = __builtin_amdgcn_s_memrealtime();
        _Pragma("unroll 1") for (int rep_ = 0; rep_ < REPS(1); ++rep_) { unsigned char* const ws = optr(ws_k);
        phase_poolprep(F, args);
        }
        if (TPS(1)) tp_acc += __builtin_amdgcn_s_memrealtime() - tp_t0;
        SEAM(1);
    }
#pragma unroll 1
    for (int L = 0; L < 2; ++L) {
        const int pb = 2 + 14 * L;
        const float* ln_mix = args.in[IN_LN_MIX] + (size_t)L * 2 * DM; const float* ln_xa = args.in[IN_LN_XA] + (size_t)L * 2 * DM; const float* ln_ffn = args.in[IN_LN_FFN] + (size_t)L * 2 * DM;
        if (L == 0) {
            if (EN(2) && IN(pb)) { if (TPS(2)) tp_t0 = __builtin_amdgcn_s_memrealtime();
                _Pragma("unroll 1") for (int rep_ = 0; rep_ < REPS(2); ++rep_) { unsigned char* const ws = optr(ws_k);
                pg8::Gemm g{HN, (const bf16_t*)(ws + WS_POOLW), DM, PGC, 4, (size_t)PGC}; pg8::PanelOrder S; S.init(F.G, F.bid);
                pg8::EpiY E{Yb, DM, args.in[IN_POOL_SCALE], SSP, 64};
                pg8::gemm_phase<pg8::EpiY, pg8::PanelOrder>(F.lds, g, S, E, F.wv);
                }
                if (TPS(2)) tp_acc += __builtin_amdgcn_s_memrealtime() - tp_t0;
                SEAM(pb);
            }
        } else {
            if (EN(3) && IN(pb)) { if (TPS(3)) tp_t0 = __builtin_amdgcn_s_memrealtime();
                _Pragma("unroll 1") for (int rep_ = 0; rep_ < REPS(3); ++rep_) { unsigned char* const ws = optr(ws_k);
                pg8::Gemm g{HN, (const bf16_t*)(ws + WS_NSAIN), DM, DM, 0, 0}; pg8::StaticOrder S; S.init(MTOK, QW + KVW, F.G, F.bid);
                pg8::EpiNsaIn E{(bf16_t*)(ws + WS_NQ), (bf16_t*)(ws + WS_NKV), (const float*)(ws + WS_RS)};
                pg8::gemm_phase<pg8::EpiNsaIn>(F.lds, g, S, E, F.wv);
                }
                if (TPS(3)) tp_acc += __builtin_amdgcn_s_memrealtime() - tp_t0;
                SEAM(pb);
            }
            if (EN(4) && IN(pb + 1)) { if (TPS(4)) tp_t0 = __builtin_amdgcn_s_memrealtime();
                _Pragma("unroll 1") for (int rep_ = 0; rep_ < REPS(4); ++rep_) { unsigned char* const ws = optr(ws_k);
#if HALFM
                if (F.G >= 256) {
                    pg8::Gemm g{(const bf16_t*)(ws + WS_NKV), (const bf16_t*)(ws + WS_CMPW1), 2048, 4096, 2, (size_t)8 * SEQ * HD}; pg8::HalfOrder S; S.init(4096, 2 * CMP_HID, F.bid);
                    pg8::EpiGeluT<true> E{(bf16_t*)(ws + WS_HID), CMP_HID, (const float*)(ws + WS_CMPB), CMP_HID, (size_t)4096 * CMP_HID};
                    pg8::gemm_phase<pg8::EpiGeluT<true>, pg8::HalfOrder, true, true, true>(F.lds, g, S, E, F.wv);
                    pg8::Gemm g2{HN, (const bf16_t*)(ws + WS_NSAIN) + (size_t)(QW + KVW) * DM, DM, DM, 0, 0}; pg8::HalfOrder S2; S2.init(MTOK, 256, F.bid - 128);
                    pg8::EpiGatesT<true> E2{(float*)(ws + WS_GATES), (const float*)(ws + WS_RS)};
                    pg8::gemm_phase<pg8::EpiGatesT<true>, pg8::HalfOrder, true, true, true>(F.lds, g2, S2, E2, F.wv);
                } else
#endif
                {
                pg8::Gemm g{(const bf16_t*)(ws + WS_NKV), (const bf16_t*)(ws + WS_CMPW1), 2048, 4096, 2, (size_t)8 * SEQ * HD}; pg8::StaticOrder S; S.init(4096, 2 * CMP_HID, F.G, F.bid);
                pg8::EpiGelu E{(bf16_t*)(ws + WS_HID), CMP_HID, (const float*)(ws + WS_CMPB), CMP_HID, (size_t)4096 * CMP_HID};
                pg8::gemm_phase<pg8::EpiGelu>(F.lds, g, S, E, F.wv);
                }
                if (F.bid >= 64 && (!HALFM || F.G < 256)) {
                    pg8::Gemm g2{HN, (const bf16_t*)(ws + WS_NSAIN) + (size_t)(QW + KVW) * DM, DM, DM, 0, 0}; pg8::StaticOrder S2; S2.init(MTOK, 256, F.G, F.bid - 64);
                    pg8::EpiGates E2{(float*)(ws + WS_GATES), (const float*)(ws + WS_RS)};
                    pg8::gemm_phase<pg8::EpiGates>(F.lds, g2, S2, E2, F.wv);
                }
                }
                if (TPS(4)) tp_acc += __builtin_amdgcn_s_memrealtime() - tp_t0;
                SEAM(pb + 1);
            }
            if (EN(5) && IN(pb + 2)) { if (TPS(5)) tp_t0 = __builtin_amdgcn_s_memrealtime(); _Pragma("unroll 1") for (int rep_ = 0; rep_ < REPS(5); ++rep_) { unsigned char* const ws = optr(ws_k);
                pg8::Gemm g{(const bf16_t*)(ws + WS_HID), (const bf16_t*)(ws + WS_CMPW2), CMP_HID, CMP_HID, 1, (size_t)4096 * CMP_HID}; pg8::StaticOrder S; S.init(4096, 512, F.G, F.bid);
                pg8::EpiKvc E{(bf16_t*)(ws + WS_KVC)};
                pg8::gemm_phase<pg8::EpiKvc>(F.lds, g, S, E, F.wv);
                if (C2FILL) {
                    const int nb0 = (F.G == 256) ? 32 : 0, nbk = F.G - nb0;
                    if ((int)F.bid >= nb0) { LAS unsigned* scr = (LAS unsigned*)(F.lds + F.wv * 8448); const int lane_ = otid() & 63;
                        _Pragma("unroll 1") for (int it = ((int)F.bid - nb0) * NWAVES + F.wv; it < (QW / 64) * (DM / 64); it += nbk * NWAVES)
                            p0_transpose_item<0>(args.in[IN_NSA_W_OUT], QW, DM, (bf16_t*)(ws + WS_NSAOUT), nullptr, scr, it, lane_); } } } if (TPS(5)) tp_acc += __builtin_amdgcn_s_memrealtime() - tp_t0; SEAM(pb + 2); }
            if (EN(6) && IN(pb + 3)) { if (TPS(6)) tp_t0 = __builtin_amdgcn_s_memrealtime(); for (int rep_ = 0; rep_ < REPS(6); ++rep_) { phase_nsa(F, tp_acc, args); } if (TPS(6)) tp_acc += __builtin_amdgcn_s_memrealtime() - tp_t0; SEAM(pb + 3); }
            if (EN(7) && IN(pb + 4)) { if (TPS(7)) tp_t0 = __builtin_amdgcn_s_memrealtime();
                _Pragma("unroll 1") for (int rep_ = 0; rep_ < REPS(7); ++rep_) { unsigned char* const ws = optr(ws_k);
                pg8::Gemm g{(const bf16_t*)(ws + WS_NO), (const bf16_t*)(ws + WS_NSAOUT), QW, QW, 0, 0}; pg8::PanelOrder S; S.init(F.G, F.bid);
                pg8::EpiY E{Yb, DM, nullptr, SSP, 64};
                pg8::gemm_phase<pg8::EpiY, pg8::PanelOrder>(F.lds, g, S, E, F.wv);
                }
                if (TPS(7)) tp_acc += __builtin_amdgcn_s_memrealtime() - tp_t0;
                SEAM(pb + 4);
            }
        }
        if (EN(8) && IN(pb + 5)) { if (TPS(8)) tp_t0 = __builtin_amdgcn_s_memrealtime(); for (int rep_ = 0; rep_ < REPS(8); ++rep_) { if (L == 0) phase_resid<true, false>(F, args.in[IN_X], ln_mix + DM); else phase_resid<false, false>(F, nullptr, ln_mix + DM); } if (TPS(8)) tp_acc += __builtin_amdgcn_s_memrealtime() - tp_t0; SEAM(pb + 5); }
        if (EN(9) && IN(pb + 6)) { if (TPS(9)) tp_t0 = __builtin_amdgcn_s_memrealtime();
            _Pragma("unroll 1") for (int rep_ = 0; rep_ < REPS(9); ++rep_) { unsigned char* const ws = optr(ws_k);
#if HALFM
            if (L == 1 && F.G >= 256) {
                pg8::Gemm g{HN, (const bf16_t*)(ws + WS_XAQ) + (size_t)L * XAW * DM, DM, DM, 0, 0}; pg8::HalfOrder S; S.init(MTOK, XAW, F.bid);
                pg8::EpiPlainT<true> E{(bf16_t*)(ws + WS_QX), XAW, 0, 0, (const float*)(ws + WS_RS)};
                pg8::gemm_phase<pg8::EpiPlainT<true>, pg8::HalfOrder, true, true, true>(F.lds, g, S, E, F.wv);
            } else
#endif
            {
            pg8::Gemm g{HN, (const bf16_t*)(ws + WS_XAQ) + (size_t)L * XAW * DM, DM, DM, 0, 0}; pg8::StaticOrder S; S.init(MTOK, XAW, F.G, F.bid);
            pg8::EpiPlain E{(bf16_t*)(ws + WS_QX), XAW, 0, 0, (const float*)(ws + WS_RS)};
            pg8::gemm_phase<pg8::EpiPlain>(F.lds, g, S, E, F.wv);
            }
            if (L == 0) {
                if (F.bid >= 128) {
                    pg8::Gemm g2{(const bf16_t*)(ws + WS_MEMN), (const bf16_t*)(ws + WS_XAKV), DM, DM, 0, 0}; pg8::StaticOrder S2; S2.init(MMEM, 2 * 2 * XAW, F.G, F.bid - 128);
                    pg8::EpiPlain E2{(bf16_t*)(ws + WS_KVMEM), 2 * XAW, 2 * XAW, (size_t)MMEM * 2 * XAW, nullptr};
                    pg8::gemm_phase<pg8::EpiPlain>(F.lds, g2, S2, E2, F.wv);
                }
                const int idx = (F.bid - 160) * NTHR + otid();
                if (idx >= 0 && idx < 2 * CMP_HID) { const float* part = (const float*)(ws + WS_CMPB + 65536); float sacc = args.in[IN_CMP_B1][idx];
                    for (int ks = 0; ks < 16; ++ks) sacc += part[((idx >> 9) * 16 + ks) * CMP_HID + (idx & 511)];
                    ((float*)(ws + WS_CMPB))[idx] = sacc; }
                if (XQFILL && F.G == 256 && F.bid >= 144) {
                    LAS unsigned* scr = (LAS unsigned*)(F.lds + F.wv * 8448); const int lane_ = otid() & 63;
                    _Pragma("unroll 1") for (int it = ((int)F.bid - 144) * NWAVES + F.wv; it < XQF_N; it += 112 * NWAVES)
                        p0_transpose_item<1>(args.in[IN_FFN_WGU], DM, DFF2, (bf16_t*)(ws + WS_WGU), args.in[IN_LN_FFN], scr, it, lane_); }
            }
            }
            if (TPS(9)) tp_acc += __builtin_amdgcn_s_memrealtime() - tp_t0;
            SEAM(pb + 6);
        }
        if (EN(10) && IN(pb + 7)) { if (TPS(10)) tp_t0 = __builtin_amdgcn_s_memrealtime(); for (int rep_ = 0; rep_ < REPS(10); ++rep_) { phase_xattn(F, L); } if (TPS(10)) tp_acc += __builtin_amdgcn_s_memrealtime() - tp_t0; SEAM(pb + 7); }
        if (EN(11) && IN(pb + 8)) { if (TPS(11)) tp_t0 = __builtin_amdgcn_s_memrealtime();
            _Pragma("unroll 1") for (int rep_ = 0; rep_ < REPS(11); ++rep_) { unsigned char* const ws = optr(ws_k);
            pg8::Gemm g{(const bf16_t*)(ws + WS_OX), (const bf16_t*)(ws + WS_XAO) + (size_t)L * DM * XAW, XAW, XAW, 0, 0}; pg8::PanelOrder S; S.init(F.G, F.bid);
            pg8::EpiY E{Yb, DM, nullptr, SSP, 64};
            pg8::gemm_phase<pg8::EpiY, pg8::PanelOrder>(F.lds, g, S, E, F.wv);
            }
            if (TPS(11)) tp_acc += __builtin_amdgcn_s_memrealtime() - tp_t0;
            SEAM(pb + 8);
        }
        if (EN(12) && IN(pb + 9)) { if (TPS(12)) tp_t0 = __builtin_amdgcn_s_memrealtime(); for (int rep_ = 0; rep_ < REPS(12); ++rep_) { phase_resid<false, false>(F, nullptr, ln_xa + DM); } if (TPS(12)) tp_acc += __builtin_amdgcn_s_memrealtime() - tp_t0; SEAM(pb + 9); }
        if (EN(13) && IN(pb + 10)) { if (TPS(13)) tp_t0 = __builtin_amdgcn_s_memrealtime();
            _Pragma("unroll 1") for (int rep_ = 0; rep_ < REPS(13); ++rep_) { unsigned char* const ws = optr(ws_k);
            pg8::Gemm g{HN, (const bf16_t*)(ws + WS_WGU) + (size_t)L * DFF2 * DM, DM, DM, 0, 0}; pg8::StaticOrder S; S.init(MTOK, DFF2, F.G, F.bid);
            pg8::EpiGateUp E{(bf16_t*)(ws + WS_ACT), args.in[IN_FFN_CONVW] + (size_t)L * 3 * DFF, args.in[IN_FFN_CONVB] + (size_t)L * DFF, (float*)(ws + WS_HALO), (float*)(ws + WS_EDGE), F.lds, (const float*)(ws + WS_RS)};
            pg8::gemm_phase<pg8::EpiGateUp>(F.lds, g, S, E, F.wv);
            if (TAILFILL) {
                const int nb0 = (F.G == 256) ? 128 : 0, nbk = F.G - nb0;
                if ((int)F.bid >= nb0) { LAS unsigned* scr = (LAS unsigned*)(F.lds + F.wv * 8448); const int lane_ = otid() & 63;
                    _Pragma("unroll 1") for (int it = ((int)F.bid - nb0) * NWAVES + F.wv; it < (DFF / 64) * (DM / 64); it += nbk * NWAVES)
                        p0_transpose_item<0>(args.in[IN_FFN_WDN] + (size_t)L * DFF * DM, DFF, DM, (bf16_t*)(ws + WS_WDN + (size_t)L * DM * DFF * 2), nullptr, scr, it, lane_); } }
            }
            if (TPS(13)) tp_acc += __builtin_amdgcn_s_memrealtime() - tp_t0;
            SEAM(pb + 10);
        }
        if (EN(14) && IN(pb + 11)) { if (TPS(14)) tp_t0 = __builtin_amdgcn_s_memrealtime(); for (int rep_ = 0; rep_ < REPS(14); ++rep_) { phase_actfix(F, args.in[IN_FFN_CONVW] + (size_t)L * 3 * DFF, args.in[IN_FFN_CONVB] + (size_t)L * DFF); } if (TPS(14)) tp_acc += __builtin_amdgcn_s_memrealtime() - tp_t0; SEAM(pb + 11); }
        if (EN(15) && IN(pb + 12)) { if (TPS(15)) tp_t0 = __builtin_amdgcn_s_memrealtime();
            _Pragma("unroll 1") for (int rep_ = 0; rep_ < REPS(15); ++rep_) { unsigned char* const ws = optr(ws_k);
            pg8::Gemm g{(const bf16_t*)(ws + WS_ACT), (const bf16_t*)(ws + WS_WDN) + (size_t)L * DM * DFF, DFF, DFF, 0, 0}; pg8::PanelOrder S; S.init(F.G, F.bid);
            pg8::EpiY E{Yb, DM, nullptr, SSP, 64};
            pg8::gemm_phase<pg8::EpiY, pg8::PanelOrder>(F.lds, g, S, E, F.wv);
            }
            if (TPS(15)) tp_acc += __builtin_amdgcn_s_memrealtime() - tp_t0;
            SEAM(pb + 12);
        }
        if (EN(16) && IN(pb + 13)) { if (TPS(16)) tp_t0 = __builtin_amdgcn_s_memrealtime(); for (int rep_ = 0; rep_ < REPS(16); ++rep_) { if (L == 0) phase_resid<false, false>(F, nullptr, ln_ffn + DM); else phase_resid<false, true>(F, nullptr, ln_ffn + DM); } if (TPS(16)) tp_acc += __builtin_amdgcn_s_memrealtime() - tp_t0; SEAM(pb + 13); }
    }
    if ((TP_MODE != 0 || TP_MASK != 0u || TP_NSA_SEC != 0) && blockIdx.x == 0) { const unsigned long long t1 = __builtin_amdgcn_s_memrealtime(); while (__builtin_amdgcn_s_memrealtime() - t1 < (unsigned long long)TP_AMP * tp_acc) __builtin_amdgcn_s_sleep(8); }
#undef HN
#undef Yb
#undef SSP
#undef IN
#undef EN
#undef SEAM
}

extern "C" void kernel_launch(void* const* d_in, const int* in_sizes, int n_in, void* d_out, int out_size, void* d_ws, size_t ws_size, hipStream_t stream) {
    static int grid = 0;
    if (grid == 0) {
        if (n_in != 21 || in_sizes[0] != MTOK * DM || out_size != MTOK * DM || ws_size < WS_END) {
            fprintf(stderr, "kernel_launch: unexpected shapes (n_in %d, in0 %d, out %d, ws %zu; need ws >= %zu); nothing launched\n", n_in, n_in > 0 ? in_sizes[0] : -1, out_size, ws_size, (size_t)WS_END); grid = -1; return; }
        int dev = 0, cus = 0, per_cu = 0;
        if (hipGetDevice(&dev) != hipSuccess || hipDeviceGetAttribute(&cus, hipDeviceAttributeMultiprocessorCount, dev) != hipSuccess) { fprintf(stderr, "kernel_launch: device query failed\n"); grid = -1; return; }
        if (hipFuncSetAttribute((const void*)mk_fwd, hipFuncAttributeMaxDynamicSharedMemorySize, LDS_BYTES) != hipSuccess) { fprintf(stderr, "kernel_launch: hipFuncSetAttribute failed\n"); grid = -1; return; }
        if (hipOccupancyMaxActiveBlocksPerMultiprocessor(&per_cu, (const void*)mk_fwd, NTHR, LDS_BYTES) != hipSuccess || per_cu < 1)
            fprintf(stderr, "kernel_launch: note: occupancy query reports %d workgroups per CU\n", per_cu);
        (void)hipGetLastError();
        grid = cus;
    }
    if (grid < 0) return;
    if (hipMemsetAsync((char*)d_ws + WS_CTL, 0, CTL_ZERO_BYTES, stream) != hipSuccess) { fprintf(stderr, "kernel_launch: memset failed\n"); return; }
    Args a{};
    for (int i = 0; i < 21; ++i) a.in[i] = (const float*)d_in[i];
    a.out = (float*)d_out; a.ws = (unsigned char*)d_ws;
#if MK_N_LAUNCHES == 1
    a.ph_lo = 0; a.ph_hi = NPH;
    hipLaunchKernelGGL(mk_fwd, dim3(grid), dim3(NTHR), LDS_BYTES, stream, a);
#else
    for (int ph = 0; ph < NPH; ++ph) {
        if (ph >= 3 && ph <= 6) continue;
        a.ph_lo = ph; a.ph_hi = ph + 1;
        hipLaunchKernelGGL(mk_fwd, dim3(grid), dim3(NTHR), LDS_BYTES, stream, a);
    }
#endif
    const hipError_t le = hipPeekAtLastError();
    if (le != hipSuccess) fprintf(stderr, "kernel_launch: launch failed: %s\n", hipGetErrorName(le));
}
```

```cpp
#include <hip/hip_runtime.h>
#include <cstdio>
#include <cstdint>

#ifndef MK_N_LAUNCHES
#define MK_N_LAUNCHES 1
#endif

#define GAS __attribute__((address_space(1)))
#define LAS __attribute__((address_space(3)))
typedef unsigned short bf16_t;
typedef short bf16x8 __attribute__((ext_vector_type(8)));
typedef short s16x4 __attribute__((ext_vector_type(4)));
typedef float f32x4 __attribute__((ext_vector_type(4)));
typedef float f32x2 __attribute__((ext_vector_type(2)));
typedef float f32x16 __attribute__((ext_vector_type(16)));
typedef unsigned u32x4 __attribute__((ext_vector_type(4)));
typedef unsigned u32x2 __attribute__((ext_vector_type(2)));

constexpr int NWAVES = 8, NTHR = 512;
constexpr int BATCH = 2, SEQ = 8192, DM = 4096, MTOK = BATCH * SEQ;
constexpr int MEMLEN = 256, MMEM = BATCH * MEMLEN;
constexpr int PGC = 1024;
constexpr int HD = 128, NSA_G = 4, NSA_J = 8;
constexpr int QW = 4096, KVW = 3072, GW_ = 96, NSA_INW = QW + KVW + GW_;
constexpr int NSA_INP = 7424;
constexpr int CMP_HID = 512, NCMP = 511, NSEL = 128;
constexpr int XAW = 512;
constexpr int DFF = 11008, DFF2 = 22016;
constexpr float RMS_EPS = 1e-6f;
constexpr float LOG2E = 1.4426950408889634f;
constexpr float QK_C2 = 1.4426950408889634f * 0.08838834764831845f;

constexpr size_t MiB = 1u << 20;
constexpr size_t WS_CTL = 0, CTL_ZERO_BYTES = 1 * MiB;
constexpr size_t WS_POOLW = 1 * MiB;
constexpr size_t WS_NSAIN = 9 * MiB;
constexpr size_t WS_NSAOUT = 67 * MiB;
constexpr size_t WS_CMPW1 = 99 * MiB;
constexpr size_t WS_CMPW2 = 107 * MiB;
constexpr size_t WS_XAQ = 108 * MiB;
constexpr size_t WS_XAKV = 116 * MiB;
constexpr size_t WS_XAO = 132 * MiB;
constexpr size_t WS_WGU = 140 * MiB;
constexpr size_t WS_WDN = 484 * MiB;
constexpr size_t WS_HN = 656 * MiB;
constexpr size_t WS_Y = 784 * MiB;
constexpr size_t WS_SSP = 912 * MiB;
constexpr size_t WS_XR = 916 * MiB;
constexpr size_t WS_RS = 916 * MiB + 256 * 1024;
constexpr size_t WS_CMPB = 916 * MiB + 512 * 1024;
constexpr size_t WS_MEMN = 917 * MiB;
constexpr size_t WS_KVMEM = 921 * MiB;
constexpr size_t WS_QX = 923 * MiB;
constexpr size_t WS_OX = 939 * MiB;
constexpr size_t WS_GU = 955 * MiB;
constexpr size_t WS_ACT = 1643 * MiB;
constexpr size_t WS_NQ = 1987 * MiB;
constexpr size_t WS_NKV = 2115 * MiB;
constexpr size_t WS_GATES = 2212 * MiB;
constexpr size_t WS_HID = 2218 * MiB;
constexpr size_t WS_KVC = 2226 * MiB;
constexpr size_t WS_NO = 2228 * MiB;
constexpr size_t WS_STASH = 2356 * MiB;
constexpr size_t WS_HALO = 2420 * MiB;
constexpr size_t WS_EDGE = 2426 * MiB;
constexpr size_t WS_END = 2438 * MiB;
constexpr int CW_BAR = 4096;

constexpr int RING_BYTES = 131072;
constexpr int LDSCTL_OFF = RING_BYTES, MISC_OFF = LDSCTL_OFF + 320;
constexpr int XCH_OFF = LDSCTL_OFF + 1024;
constexpr int LDS_BYTES = 147456;

#define LDS_WAIT() asm volatile("s_waitcnt lgkmcnt(0)" ::: "memory")
#define VM_WAIT() asm volatile("s_waitcnt vmcnt(0)" ::: "memory")
__device__ __forceinline__ unsigned cvtpk(float lo, float hi) { unsigned r; asm volatile("v_cvt_pk_bf16_f32 %0, %1, %2" : "=v"(r) : "v"(lo), "v"(hi)); return r; }
__device__ __forceinline__ float bflo(unsigned w) { return __uint_as_float(w << 16); }
__device__ __forceinline__ float bfhi(unsigned w) { return __uint_as_float(w & 0xffff0000u); }
__device__ __forceinline__ int otid_w(int wave_s) { int z; asm volatile("v_mov_b32 %0, 0" : "=v"(z)); const int l = __builtin_amdgcn_mbcnt_hi(~0u, __builtin_amdgcn_mbcnt_lo(~0u, z)); return wave_s * 64 + l; }
#define otid() otid_w(F.wv)
template <class T> __device__ __forceinline__ T* optr(T* p) { asm volatile("" : "+s"(p)); return p; }
#define DPPF0(v, ctrl) __int_as_float(__builtin_amdgcn_update_dpp(0, __float_as_int(v), (ctrl), 0xF, 0xF, true))
__device__ __forceinline__ float wave_sum(float v) {
    v += DPPF0(v, 0xB1); v += DPPF0(v, 0x4E); v += DPPF0(v, 0x141); v += DPPF0(v, 0x140);
    v += __int_as_float(__builtin_amdgcn_ds_swizzle(__float_as_int(v), 0x401F));
    { auto rr = __builtin_amdgcn_permlane32_swap(__float_as_uint(v), __float_as_uint(v), false, false); v = __uint_as_float(rr[0]) + __uint_as_float(rr[1]); }
    return v;
}
#define DPPF(v, ctrl) __int_as_float(__builtin_amdgcn_update_dpp(__float_as_int(v), __float_as_int(v), (ctrl), 0xF, 0xF, false))
__device__ __forceinline__ float wave_max(float v) {
    v = fmaxf(v, DPPF(v, 0xB1)); v = fmaxf(v, DPPF(v, 0x4E)); v = fmaxf(v, DPPF(v, 0x141)); v = fmaxf(v, DPPF(v, 0x140));
    v = fmaxf(v, DPPF(v, 0x142)); v = fmaxf(v, DPPF(v, 0x143));
    return __int_as_float(__builtin_amdgcn_readlane(__float_as_int(v), 63));
}
__device__ __forceinline__ float sigmoidf_(float x) { return __builtin_amdgcn_rcpf(1.0f + __builtin_amdgcn_exp2f(-x * LOG2E)); }
__device__ __forceinline__ float gelu_tanh(float x) { const float u = 0.7978845608028654f * (x + 0.044715f * x * x * x); return x * __builtin_amdgcn_rcpf(1.0f + __builtin_amdgcn_exp2f(-2.0f * LOG2E * u)); }

#define XB_TMO      128
#define XB_XCNT(j)  (256  + 64 * (j))
#define XB_XSUB(j)  (1280 + 64 * (j))
#define XB_XGEN(j)  (2304 + 64 * (j))
#define XB_TOP      3328
#define XB_TOPGEN   3392
#define XCD_BAR_WORDS 3456
#define XB_SPIN_CAP (1u << 18)
__device__ __forceinline__ unsigned xb_ld(unsigned* p)              { return __hip_atomic_load(p, __ATOMIC_RELAXED, __HIP_MEMORY_SCOPE_AGENT); }
__device__ __forceinline__ unsigned xb_add(unsigned* p, unsigned v) { return __hip_atomic_fetch_add(p, v, __ATOMIC_RELAXED, __HIP_MEMORY_SCOPE_AGENT); }
__device__ __forceinline__ unsigned xb_xcc_id() { return (unsigned)__builtin_amdgcn_s_getreg((3 << 11) | 20) & 0xFu; }
#define XB_SPIN(cond, bar) do { unsigned _sp = 0; while (cond) { __builtin_amdgcn_s_sleep(1); \
    if ((++_sp & 255u) == 0u) { if (xb_ld(&(bar)[XB_TMO])) break; if (_sp > XB_SPIN_CAP) { atomicAdd(&(bar)[XB_TMO], 1u); break; } } } } while (0)
struct XcdBarrier { unsigned* bar; unsigned x; volatile LAS unsigned* st; };
__device__ __forceinline__ XcdBarrier xcd_barrier_post(unsigned* bar, volatile LAS unsigned* st) {
    XcdBarrier b; b.bar = bar; b.x = xb_xcc_id(); b.st = st;
    if (threadIdx.x == 0) (void)xb_add(&bar[XB_XCNT(b.x)], 1u);
    return b;
}
__device__ __forceinline__ void xcd_barrier_complete(unsigned* bar, unsigned x, unsigned& nloc, unsigned& nx) {
    const unsigned G = gridDim.x * gridDim.y * gridDim.z;
    unsigned sum, cnt, mine, sp = 0u;
    for (;;) {
        sum = 0u; cnt = 0u; mine = 0u;
#pragma unroll 1
        for (unsigned j = 0; j < 16; ++j) { const unsigned c = xb_ld(&bar[XB_XCNT(j)]); sum += c; cnt += (c > 0u) ? 1u : 0u; mine = (j == x) ? c : mine; }
        if (sum == G) break;
        __builtin_amdgcn_s_sleep(1);
        if ((++sp & 255u) == 0u) { if (xb_ld(&bar[XB_TMO])) break; if (sp > XB_SPIN_CAP) { atomicAdd(&bar[XB_TMO], 1u); break; } }
    }
    nloc = mine > 0u ? mine : 1u; nx = cnt > 0u ? cnt : 1u;
}
__device__ __forceinline__ void xcd_barrier(const XcdBarrier& b) {
    asm volatile("s_waitcnt vmcnt(0)" ::: "memory");
    __syncthreads();
    if (threadIdx.x == 0) {
        unsigned* bar = b.bar;
        __builtin_amdgcn_s_waitcnt(0);
        unsigned nloc = b.st[0], nx = b.st[1];
        if (nloc == 0u) { xcd_barrier_complete(bar, b.x, nloc, nx); b.st[0] = nloc; b.st[1] = nx; }
        const unsigned old = xb_add(&bar[XB_XSUB(b.x)], 1u);
        const unsigned gen = old / nloc;
        if (old + 1u == (gen + 1u) * nloc) {
            __builtin_amdgcn_fence(__ATOMIC_RELEASE, "agent");
            asm volatile("s_waitcnt vmcnt(0)" ::: "memory");
            const unsigned og = xb_add(&bar[XB_TOP], 1u);
            const unsigned tg = og / nx;
            if (og + 1u == (tg + 1u) * nx) xb_add(&bar[XB_TOPGEN], 1u);
            else XB_SPIN(xb_ld(&bar[XB_TOPGEN]) == tg, bar);
            __builtin_amdgcn_fence(__ATOMIC_ACQUIRE, "agent");
            xb_add(&bar[XB_XGEN(b.x)], 1u);
            asm volatile("s_waitcnt vmcnt(0)" ::: "memory");
        } else {
            XB_SPIN(xb_ld(&bar[XB_XGEN(b.x)]) == gen, bar);
            __builtin_amdgcn_fence(__ATOMIC_ACQUIRE, "agent");
            asm volatile("s_waitcnt vmcnt(0)" ::: "memory");
        }
    }
    __syncthreads();
}

namespace pg8 {
constexpr int BM = 256, BK = 64, HALF = 128, HTB = HALF * BK * 2, STAGE_BYTES = 8 * HTB, NXCD = 8, WGM = 8;
__host__ __device__ __forceinline__ int lds_byte(int r, int c) { const int st = (r >> 4) * 2 + (c >> 5), rr = r & 15, cc = c & 31, ob = rr * 64 + cc * 2; return st * 1024 + (ob ^ (((ob >> 9) & 1) << 5)); }
__host__ __device__ __forceinline__ void stage_rc(int b, int& R, int& C) { const int st = b / 1024, sb = b % 1024, swz = sb ^ (((sb >> 9) & 1) << 5); R = (st >> 1) * 16 + swz / 64; C = (st & 1) * 32 + (swz % 64) / 2; }
__host__ __device__ __forceinline__ int perm32(int rho) { const int n = rho >> 4, i = rho & 15; return 8 * (i >> 2) + 4 * n + (i & 3); }

struct Unit { int pm, pn, hm; };
struct Gemm { const bf16_t* A; const bf16_t* Bt; int lda, K, npg; size_t a_gs; };

struct StaticOrder {
    int nM, nN, nwg, G, c;
    __device__ void init(int M, int N, int G_, int c_) { nM = M / BM; nN = N / BM; nwg = nM * nN; G = G_; c = c_; }
    __device__ bool next(int i, Unit& u) const {
        const long L = (long)i * G + c; if (L >= nwg) return false;
        int wgid = (int)L; { const int q = nwg / NXCD, r = nwg % NXCD, xcd = wgid % NXCD, off = wgid / NXCD; wgid = (xcd < r ? xcd * (q + 1) : r * (q + 1) + (xcd - r) * q) + off; }
        const int nig = WGM * nN, gid = wgid / nig, fm = gid * WGM, gsz = (nM - fm) < WGM ? (nM - fm) : WGM;
        u.pm = fm + ((wgid % nig) % gsz); u.pn = (wgid % nig) / gsz; u.hm = 0; return true;
    }
};

struct PanelOrder {
    int G, c;
    __device__ void init(int G_, int c_) { G = G_; c = c_; }
    __device__ bool next(int i, Unit& u) const {
        const long j = (long)i * G + c; if (j >= 1024) return false;
        const int r = (int)j >> 8, p = (int)j & 255, x = p & 7, k = p >> 3; u.pm = 16 * r + 4 * (x >> 1) + (k >> 3); u.pn = 8 * (x & 1) + (k & 7); u.hm = 0; return true;
    }
};
struct HalfOrder {
    int nM, nN, c;
    __device__ void init(int M, int N, int c_) { nM = M / BM; nN = N / BM; c = c_; }
    __device__ bool next(int i, Unit& u) const { if (i != 0 || c < 0 || c >= 2 * nM * nN) return false;
        const int x = c & 7, sl = c >> 3, t = sl >> 1; u.hm = sl & 1; u.pn = t % nN; u.pm = x * (nM >> 3) + t / nN; return true; }
};
template <class Epi, class Sched = StaticOrder, bool ALIGN_EPI = true, bool SP2 = true, bool HM = false>
__device__ __forceinline__ void gemm_phase(LAS unsigned char* lds, const Gemm g, const Sched& S, const Epi& E, int wave_s) {
    const int tid = otid_w(wave_s), wid = __builtin_amdgcn_readfirstlane(tid >> 6), lane = tid & 63, wr = wid >> 2, wc = wid & 3, fr = lane & 15, fq = lane >> 4;
    const int K = g.K, nt = K / BK, lda = g.lda;
    unsigned voffA[2], voffB[2];
#pragma unroll
    for (int i = 0; i < 2; ++i) { int R, C; stage_rc(tid * 16 + i * 8192, R, C); const int Rb = (R & ~31) + perm32(R & 31);
        voffA[i] = (unsigned)(R * lda + C) * 2u; voffB[i] = (unsigned)(Rb * K + C) * 2u; }
    const size_t kstep = (size_t)(BK * 2);
    const size_t hstepA = HM ? (size_t)0 : (size_t)HALF * lda * 2, hstepB = (size_t)HALF * K * 2;
    const unsigned ldsw = (unsigned)wid * 1024u;
    const int aoff = lds_byte(wr * 64 + fr, fq * 8), boff = lds_byte(wc * 32 + fr, fq * 8);
#define PG8_SA(b, h) (((b) * 2 + (h)) * HTB)
#define PG8_SB(b, h) ((4 + (b) * 2 + (h)) * HTB)
#define PG8_STAGE(bufoff, gbase, voff) do { _Pragma("unroll") for (int _i = 0; _i < 2; ++_i) \
        __builtin_amdgcn_global_load_lds((const unsigned*)((const char*)(gbase) + (voff)[_i]), (LAS unsigned*)(lds + (bufoff) + ldsw + _i * 8192), 16, 0, 0); } while (0)
#define PG8_LDA(dst, b, h) do { _Pragma("unroll") for (int m = 0; m < 4; ++m) _Pragma("unroll") for (int k = 0; k < 2; ++k) dst[m][k] = *(const LAS bf16x8*)(lds + PG8_SA(b, h) + aoff + m * 2048 + k * 1024); } while (0)
#define PG8_LDB(dst, b, h) do { _Pragma("unroll") for (int n = 0; n < 2; ++n) _Pragma("unroll") for (int k = 0; k < 2; ++k) dst[n][k] = *(const LAS bf16x8*)(lds + PG8_SB(b, h) + boff + n * 2048 + k * 1024); } while (0)
#define PG8_MMA(ai, bj, At, Bt) do { __builtin_amdgcn_s_setprio(1); _Pragma("unroll") for (int m = 0; m < 4; ++m) _Pragma("unroll") for (int n = 0; n < 2; ++n) _Pragma("unroll") for (int k = 0; k < 2; ++k) \
        acc[ai][bj][m][n] = __builtin_amdgcn_mfma_f32_16x16x32_bf16(Bt[n][k], At[m][k], acc[ai][bj][m][n], 0, 0, 0); __builtin_amdgcn_s_setprio(0); } while (0)
#define PG8_WAIT_V(n) asm volatile("s_waitcnt vmcnt(" #n ")" ::: "memory")
#define PG8_WAIT_L(n) asm volatile("s_waitcnt lgkmcnt(" #n ")" ::: "memory")
#define PG8_BAR __builtin_amdgcn_s_barrier()
#define PG8_SCHED __builtin_amdgcn_sched_barrier(0)
#define PG8_APTR(u) ((const char*)g.A + (((size_t)(u).pm * BM + (HM ? (size_t)(u).hm * HALF : (size_t)0)) * lda + (g.npg ? (size_t)((u).pn / g.npg) * g.a_gs : (size_t)0)) * 2)
#define PG8_BPTR(u) ((const char*)g.Bt + (size_t)(u).pn * BM * K * 2)
    Unit cur, nxt; int ui = 0;
    if (!S.next(0, cur)) return;
    f32x4 acc[2][2][4][2];
#pragma unroll
    for (int a = 0; a < 2; ++a)
#pragma unroll
        for (int b = 0; b < 2; ++b)
#pragma unroll
            for (int m = 0; m < 4; ++m)
#pragma unroll
                for (int n = 0; n < 2; ++n) acc[a][b][m][n] = (f32x4){0.f, 0.f, 0.f, 0.f};
    bf16x8 At[4][2], B0[2][2], B1[2][2];
    const char* cA = PG8_APTR(cur); const char* cB = PG8_BPTR(cur);
    if constexpr (SP2) {
        PG8_STAGE(PG8_SB(0, 0), cB, voffB); PG8_STAGE(PG8_SB(0, 1), cB + hstepB, voffB); PG8_STAGE(PG8_SA(0, 0), cA, voffA); PG8_STAGE(PG8_SA(0, 1), cA + hstepA, voffA);
        if (wr == 1) PG8_BAR;
        PG8_WAIT_V(2); PG8_BAR;
        PG8_STAGE(PG8_SB(1, 0), cB + kstep, voffB); PG8_STAGE(PG8_SA(1, 0), cA + kstep, voffA); PG8_STAGE(PG8_SB(1, 1), cB + hstepB + kstep, voffB);
        PG8_WAIT_V(6); PG8_BAR;
    } else {
        PG8_STAGE(PG8_SB(0, 0), cB, voffB); PG8_STAGE(PG8_SA(0, 0), cA, voffA); PG8_STAGE(PG8_SB(0, 1), cB + hstepB, voffB); PG8_STAGE(PG8_SA(0, 1), cA + hstepA, voffA);
        if (wr == 1) PG8_BAR;
        PG8_WAIT_V(4); PG8_BAR;
        PG8_STAGE(PG8_SB(1, 0), cB + kstep, voffB); PG8_STAGE(PG8_SA(1, 0), cA + kstep, voffA); PG8_STAGE(PG8_SB(1, 1), cB + hstepB + kstep, voffB);
        PG8_WAIT_V(6); PG8_BAR;
    }
    for (;;) {
        const bool has_next = S.next(ui + 1, nxt);
        const char* nA = has_next ? PG8_APTR(nxt) : cA; const char* nB = has_next ? PG8_BPTR(nxt) : cB;
        for (int t = 0; t < nt; t += 2) {
            const bool last = (t == nt - 2);
            const char* a1 = cA + (size_t)(t + 1) * kstep;
            const char* a2 = last ? nA : cA + (size_t)(t + 2) * kstep; const char* b2 = last ? nB : cB + (size_t)(t + 2) * kstep;
            const char* a3 = a2 + kstep; const char* b3 = b2 + kstep;
            if constexpr (SP2) {
            PG8_LDB(B0, 0, 0); PG8_LDB(B1, 0, 1); PG8_SCHED; PG8_LDA(At, 0, 0); PG8_STAGE(PG8_SA(1, 1), a1 + hstepA, voffA);
            PG8_WAIT_V(8); PG8_WAIT_L(0); PG8_BAR; PG8_MMA(0, 0, At, B0); PG8_MMA(0, 1, At, B1); PG8_BAR; PG8_SCHED;
            if constexpr (!HM) PG8_LDA(At, 0, 1); PG8_STAGE(PG8_SB(0, 0), b2, voffB); PG8_STAGE(PG8_SB(0, 1), b2 + hstepB, voffB); PG8_STAGE(PG8_SA(0, 0), a2, voffA);
            PG8_WAIT_V(8); PG8_WAIT_L(0); PG8_BAR; if constexpr (!HM) { PG8_MMA(1, 0, At, B0); PG8_MMA(1, 1, At, B1); } PG8_BAR; PG8_SCHED;
            PG8_LDB(B0, 1, 0); PG8_LDB(B1, 1, 1); PG8_SCHED; PG8_LDA(At, 1, 0); PG8_STAGE(PG8_SA(0, 1), a2 + hstepA, voffA);
            PG8_WAIT_V(8); PG8_WAIT_L(0); PG8_BAR; PG8_MMA(0, 0, At, B0); PG8_MMA(0, 1, At, B1); PG8_BAR; PG8_SCHED;
            if constexpr (!HM) PG8_LDA(At, 1, 1); PG8_STAGE(PG8_SB(1, 0), b3, voffB); PG8_STAGE(PG8_SB(1, 1), b3 + hstepB, voffB); PG8_STAGE(PG8_SA(1, 0), a3, voffA);
            PG8_WAIT_V(8); PG8_WAIT_L(0); PG8_BAR; if constexpr (!HM) { PG8_MMA(1, 0, At, B0); PG8_MMA(1, 1, At, B1); } PG8_BAR; PG8_SCHED;
            } else {
            PG8_LDB(B0, 0, 0); PG8_SCHED; PG8_LDA(At, 0, 0); PG8_STAGE(PG8_SA(1, 1), a1 + hstepA, voffA);
            PG8_WAIT_L(8); PG8_BAR; PG8_WAIT_L(0); PG8_MMA(0, 0, At, B0); PG8_BAR; PG8_SCHED;
            PG8_LDB(B1, 0, 1); PG8_STAGE(PG8_SB(0, 0), b2, voffB);
            PG8_BAR; PG8_WAIT_L(0); PG8_MMA(0, 1, At, B1); PG8_BAR;
            PG8_LDA(At, 0, 1); PG8_STAGE(PG8_SA(0, 0), a2, voffA);
            PG8_BAR; PG8_WAIT_L(0); PG8_MMA(1, 0, At, B0); PG8_BAR; PG8_SCHED;
            PG8_STAGE(PG8_SB(0, 1), b2 + hstepB, voffB);
            PG8_WAIT_V(6); PG8_BAR; PG8_MMA(1, 1, At, B1); PG8_BAR;
            PG8_LDB(B0, 1, 0); PG8_SCHED; PG8_LDA(At, 1, 0); PG8_STAGE(PG8_SA(0, 1), a2 + hstepA, voffA);
            PG8_WAIT_L(8); PG8_BAR; PG8_WAIT_L(0); PG8_MMA(0, 0, At, B0); PG8_BAR; PG8_SCHED;
            PG8_LDB(B1, 1, 1); PG8_STAGE(PG8_SB(1, 0), b3, voffB);
            PG8_BAR; PG8_WAIT_L(0); PG8_MMA(0, 1, At, B1); PG8_BAR;
            PG8_LDA(At, 1, 1); PG8_STAGE(PG8_SA(1, 0), a3, voffA);
            PG8_BAR; PG8_WAIT_L(0); PG8_MMA(1, 0, At, B0); PG8_BAR; PG8_SCHED;
            PG8_STAGE(PG8_SB(1, 1), b3 + hstepB, voffB);
            PG8_WAIT_V(6); PG8_BAR; PG8_MMA(1, 1, At, B1); PG8_BAR;
            }
        }
        if constexpr (ALIGN_EPI) { if (wr == 0) PG8_BAR; }
        E(acc, cur, wr, wc, fr, fq);
        if (!has_next) break;
#pragma unroll
        for (int a = 0; a < 2; ++a)
#pragma unroll
            for (int b = 0; b < 2; ++b)
#pragma unroll
                for (int m = 0; m < 4; ++m)
#pragma unroll
                    for (int n = 0; n < 2; ++n) acc[a][b][m][n] = (f32x4){0.f, 0.f, 0.f, 0.f};
        cur = nxt; cA = nA; cB = nB; ++ui;
        if constexpr (ALIGN_EPI) { if (wr == 1) PG8_BAR; }
    }
    PG8_WAIT_V(0);
    if constexpr (!ALIGN_EPI) { if (wr == 0) PG8_BAR; }
    PG8_BAR;
#undef PG8_SA
#undef PG8_SB
#undef PG8_STAGE
#undef PG8_LDA
#undef PG8_LDB
#undef PG8_MMA
#undef PG8_WAIT_V
#undef PG8_WAIT_L
#undef PG8_BAR
#undef PG8_SCHED
#undef PG8_APTR
#undef PG8_BPTR
}

__device__ __forceinline__ u32x4 pack8(const f32x4 a, const f32x4 b) { u32x4 w; w.x = cvtpk(a[0], a[1]); w.y = cvtpk(a[2], a[3]); w.z = cvtpk(b[0], b[1]); w.w = cvtpk(b[2], b[3]); return w; }

template <bool HM>
struct EpiPlainT {
    bf16_t* O; int ldc; int split_cols; size_t split_stride; const float* rowscale;
    __device__ __forceinline__ void operator()(const f32x4 (&acc)[2][2][4][2], const Unit& u, int wr, int wc, int fr, int fq) const {
        const int row0 = u.pm * BM + (HM ? u.hm * HALF : 0) + wr * 64 + fr, col0 = u.pn * BM + wc * 32 + 8 * fq;
        bf16_t* Ob = O; if (split_cols) { const int tsp = (u.pn * BM) / split_cols; Ob = O + (size_t)tsp * split_stride - (size_t)tsp * split_cols; }
#pragma unroll
        for (int ai = 0; ai < (HM ? 1 : 2); ++ai)
#pragma unroll
            for (int m = 0; m < 4; ++m) { const int row = row0 + ai * HALF + m * 16; bf16_t* rowp = Ob + (size_t)row * ldc + col0; const float rs = rowscale ? ((const GAS float*)rowscale)[row] : 1.0f;
#pragma unroll
                for (int bj = 0; bj < 2; ++bj) *(GAS u32x4*)(rowp + bj * HALF) = pack8(acc[ai][bj][m][0] * rs, acc[ai][bj][m][1] * rs); }
    }
};
using EpiPlain = EpiPlainT<false>;
template <bool HM>
struct EpiGeluT {
    bf16_t* O; int ldc; const float* bias; int split_cols; size_t split_stride;
    __device__ __forceinline__ void operator()(const f32x4 (&acc)[2][2][4][2], const Unit& u, int wr, int wc, int fr, int fq) const {
        const int row0 = u.pm * BM + (HM ? u.hm * HALF : 0) + wr * 64 + fr, col0 = u.pn * BM + wc * 32 + 8 * fq;
        const int tsp = (u.pn * BM) / split_cols; bf16_t* Ob = O + (size_t)tsp * split_stride - (size_t)tsp * split_cols;
        f32x4 bv[2][2];
#pragma unroll
        for (int bj = 0; bj < 2; ++bj)
#pragma unroll
            for (int n = 0; n < 2; ++n) bv[bj][n] = *(const GAS f32x4*)(bias + col0 + bj * HALF + 4 * n);
#pragma unroll
        for (int ai = 0; ai < (HM ? 1 : 2); ++ai)
#pragma unroll
            for (int m = 0; m < 4; ++m) { bf16_t* rowp = Ob + (size_t)(row0 + ai * HALF + m * 16) * ldc + col0;
#pragma unroll
                for (int bj = 0; bj < 2; ++bj) { f32x4 v0 = acc[ai][bj][m][0] + bv[bj][0], v1 = acc[ai][bj][m][1] + bv[bj][1];
#pragma unroll
                    for (int j = 0; j < 4; ++j) { v0[j] = gelu_tanh(v0[j]); v1[j] = gelu_tanh(v1[j]); }
                    *(GAS u32x4*)(rowp + bj * HALF) = pack8(v0, v1); } }
    }
};
using EpiGelu = EpiGeluT<false>;
struct EpiY {
    bf16_t* O; int ldc; const float* colscale; float* ssp; int nsp;
    __device__ __forceinline__ void operator()(const f32x4 (&acc)[2][2][4][2], const Unit& u, int wr, int wc, int fr, int fq) const {
        const int row0 = u.pm * BM + wr * 64 + fr, col0 = u.pn * BM + wc * 32 + 8 * fq;
        f32x4 sv[2][2];
#pragma unroll
        for (int bj = 0; bj < 2; ++bj)
#pragma unroll
            for (int n = 0; n < 2; ++n) sv[bj][n] = colscale ? *(const GAS f32x4*)(colscale + col0 + bj * HALF + 4 * n) : (f32x4){1.f, 1.f, 1.f, 1.f};
#pragma unroll
        for (int ai = 0; ai < 2; ++ai)
#pragma unroll
            for (int m = 0; m < 4; ++m) { const int row = row0 + ai * HALF + m * 16; bf16_t* rowp = O + (size_t)row * ldc + col0; float ss = 0.f;
#pragma unroll
                for (int bj = 0; bj < 2; ++bj) { const f32x4 v0 = acc[ai][bj][m][0] * sv[bj][0], v1 = acc[ai][bj][m][1] * sv[bj][1];
                    ss += (v0[0] * v0[0] + v0[1] * v0[1]) + (v0[2] * v0[2] + v0[3] * v0[3]) + (v1[0] * v1[0] + v1[1] * v1[1]) + (v1[2] * v1[2] + v1[3] * v1[3]);
                    *(GAS u32x4*)(rowp + bj * HALF) = pack8(v0, v1); }
                ss += __int_as_float(__builtin_amdgcn_ds_swizzle(__float_as_int(ss), 0x401F));
                { auto rr = __builtin_amdgcn_permlane32_swap(__float_as_uint(ss), __float_as_uint(ss), false, false); ss = __uint_as_float(rr[0]) + __uint_as_float(rr[1]); }
                if (fq == 0) ((GAS float*)ssp)[(size_t)row * nsp + u.pn * 4 + wc] = ss; }
    }
};
struct EpiNsaIn {
    bf16_t* Q; bf16_t* KV; const float* rowscale;
    __device__ __forceinline__ void operator()(const f32x4 (&acc)[2][2][4][2], const Unit& u, int wr, int wc, int fr, int fq) const {
        const int row0 = u.pm * BM + wr * 64 + fr, col0 = u.pn * BM + wc * 32 + 8 * fq;
#pragma unroll
        for (int ai = 0; ai < 2; ++ai)
#pragma unroll
            for (int m = 0; m < 4; ++m) { const int row = row0 + ai * HALF + m * 16; const float rs = ((const GAS float*)rowscale)[row];
#pragma unroll
                for (int bj = 0; bj < 2; ++bj) { const int col = col0 + bj * HALF; const f32x4 v0 = acc[ai][bj][m][0] * rs, v1 = acc[ai][bj][m][1] * rs;
                    if (u.pn < 16) { *(GAS u32x4*)(Q + (size_t)row * QW + col) = pack8(v0, v1); }
                    else { const int idx = col - QW, br = idx >> 10, rem = idx & 1023, kvs = rem >> 9, gg = (rem >> 7) & 3, dh = rem & 127, b = row >> 13, s = row & (SEQ - 1);
                        *(GAS u32x4*)(KV + ((size_t)((((br * 2 + kvs) * 2 + b) * 4 + gg)) * SEQ + s) * HD + dh) = pack8(v0, v1); }
                } }
    }
};
template <bool HM>
struct EpiGatesT {
    float* GT; const float* rowscale;
    __device__ __forceinline__ void operator()(const f32x4 (&acc)[2][2][4][2], const Unit& u, int wr, int wc, int fr, int fq) const {
        const int row0 = u.pm * BM + (HM ? u.hm * HALF : 0) + wr * 64 + fr, col0 = wc * 32 + 8 * fq;
        if (col0 >= GW_) return;
#pragma unroll
        for (int ai = 0; ai < (HM ? 1 : 2); ++ai)
#pragma unroll
            for (int m = 0; m < 4; ++m) { const int row = row0 + ai * HALF + m * 16; const float rs = ((const GAS float*)rowscale)[row];
                const f32x4 v0 = acc[ai][0][m][0] * rs, v1 = acc[ai][0][m][1] * rs; float* gp = GT + (size_t)row * GW_ + col0; f32x4 a, c;
#pragma unroll
                for (int j = 0; j < 4; ++j) { a[j] = sigmoidf_(v0[j]); c[j] = sigmoidf_(v1[j]); }
                *(f32x4*)gp = a; *(GAS f32x4*)(gp + 4) = c; }
    }
};
using EpiGates = EpiGatesT<false>;

#define DPP4(dst, oldv, srcv, ctrl) do { _Pragma("unroll") for (int j_ = 0; j_ < 4; ++j_) dst[j_] = __int_as_float(__builtin_amdgcn_update_dpp(__float_as_int(oldv[j_]), __float_as_int(srcv[j_]), (ctrl), 0xF, 0xF, false)); } while (0)
struct EpiGateUp {
    bf16_t* ACT; const float* cw; const float* cb; float* HALO; float* EDGE; LAS unsigned char* lds; const float* rowscale;
    __device__ __forceinline__ void operator()(const f32x4 (&acc_in)[2][2][4][2], const Unit& u, int wr, int wc, int fr, int fq) const {
        const int chl = wc * 32 + 8 * fq, ch = u.pn * 128 + chl;
        f32x4 acc[2][2][4][2];
#pragma unroll
        for (int ai = 0; ai < 2; ++ai)
#pragma unroll
            for (int m = 0; m < 4; ++m) { const float rs = ((const GAS float*)rowscale)[u.pm * BM + ai * HALF + wr * 64 + m * 16 + fr];
#pragma unroll
                for (int bj = 0; bj < 2; ++bj) { acc[ai][bj][m][0] = acc_in[ai][bj][m][0] * rs; acc[ai][bj][m][1] = acc_in[ai][bj][m][1] * rs; } }
        LAS float* XCH = (LAS float*)(lds + XCH_OFF);
        if (fr >= 14) {
#pragma unroll
            for (int ai = 0; ai < 2; ++ai) { const int q = 2 * ai + wr; LAS float* x = XCH + ((q * 2 + (fr - 14)) * 128 + chl);
                *(LAS f32x4*)x = acc[ai][0][3][0]; *(LAS f32x4*)(x + 4) = acc[ai][0][3][1];
                if (q == 3) { float* hp = HALO + ((size_t)(u.pm * 2 + (fr - 14))) * DFF + ch; *(f32x4*)hp = acc[ai][0][3][0]; *(GAS f32x4*)(hp + 4) = acc[ai][0][3][1]; } }
        }
        asm volatile("s_waitcnt lgkmcnt(0)" ::: "memory"); __builtin_amdgcn_s_barrier(); asm volatile("" ::: "memory");
        const f32x4 w0a = *(const GAS f32x4*)(cw + ch), w0b = *(const GAS f32x4*)(cw + ch + 4), w1a = *(const GAS f32x4*)(cw + DFF + ch), w1b = *(const GAS f32x4*)(cw + DFF + ch + 4);
        const f32x4 w2a = *(const GAS f32x4*)(cw + 2 * DFF + ch), w2b = *(const GAS f32x4*)(cw + 2 * DFF + ch + 4), bba = *(const GAS f32x4*)(cb + ch), bbb = *(const GAS f32x4*)(cb + ch + 4);
        const bool seqstart = (u.pm & 31) == 0;
        const f32x4 zero4 = (f32x4){0.f, 0.f, 0.f, 0.f};
#define TAPS_CUR(z, c) asm("s_nop 1\n\tv_fmac_f32_dpp %0, %4, %8 row_shr:1 row_mask:0xf bank_mask:0xf bound_ctrl:1\n\tv_fmac_f32_dpp %1, %5, %9 row_shr:1 row_mask:0xf bank_mask:0xf bound_ctrl:1\n\t" \
            "v_fmac_f32_dpp %2, %6, %10 row_shr:1 row_mask:0xf bank_mask:0xf bound_ctrl:1\n\tv_fmac_f32_dpp %3, %7, %11 row_shr:1 row_mask:0xf bank_mask:0xf bound_ctrl:1\n\t" \
            "v_fmac_f32_dpp %0, %4, %12 row_shr:2 row_mask:0xf bank_mask:0xf bound_ctrl:1\n\tv_fmac_f32_dpp %1, %5, %13 row_shr:2 row_mask:0xf bank_mask:0xf bound_ctrl:1\n\t" \
            "v_fmac_f32_dpp %2, %6, %14 row_shr:2 row_mask:0xf bank_mask:0xf bound_ctrl:1\n\tv_fmac_f32_dpp %3, %7, %15 row_shr:2 row_mask:0xf bank_mask:0xf bound_ctrl:1" \
            : "+v"(z##0), "+v"(z##1), "+v"(z##2), "+v"(z##3) : "v"(c[0]), "v"(c[1]), "v"(c[2]), "v"(c[3]), "v"(W1[0]), "v"(W1[1]), "v"(W1[2]), "v"(W1[3]), "v"(W0[0]), "v"(W0[1]), "v"(W0[2]), "v"(W0[3]))
#define TAPS_PREV(z, c, d) asm("s_nop 1\n\tv_fmac_f32_dpp %0, %4, %8 row_shl:15 row_mask:0xf bank_mask:0xf bound_ctrl:1\n\tv_fmac_f32_dpp %1, %5, %9 row_shl:15 row_mask:0xf bank_mask:0xf bound_ctrl:1\n\t" \
            "v_fmac_f32_dpp %2, %6, %10 row_shl:15 row_mask:0xf bank_mask:0xf bound_ctrl:1\n\tv_fmac_f32_dpp %3, %7, %11 row_shl:15 row_mask:0xf bank_mask:0xf bound_ctrl:1\n\t" \
            "v_fmac_f32_dpp %0, %16, %12 row_shl:14 row_mask:0xf bank_mask:0xf bound_ctrl:1\n\tv_fmac_f32_dpp %1, %17, %13 row_shl:14 row_mask:0xf bank_mask:0xf bound_ctrl:1\n\t" \
            "v_fmac_f32_dpp %2, %18, %14 row_shl:14 row_mask:0xf bank_mask:0xf bound_ctrl:1\n\tv_fmac_f32_dpp %3, %19, %15 row_shl:14 row_mask:0xf bank_mask:0xf bound_ctrl:1" \
            : "+v"(z##0), "+v"(z##1), "+v"(z##2), "+v"(z##3) : "v"(c[0]), "v"(c[1]), "v"(c[2]), "v"(c[3]), "v"(W1[0]), "v"(W1[1]), "v"(W1[2]), "v"(W1[3]), "v"(W0[0]), "v"(W0[1]), "v"(W0[2]), "v"(W0[3]), "v"(d[0]), "v"(d[1]), "v"(d[2]), "v"(d[3]))
#pragma unroll
        for (int ai = 0; ai < 2; ++ai) { const int q = 2 * ai + wr;
            f32x4 r63a = zero4, r63b = zero4, r62a = zero4, r62b = zero4;
            if (q > 0) { const LAS float* x = XCH + (((q - 1) * 2) * 128 + chl); r62a = *(const LAS f32x4*)x; r62b = *(const LAS f32x4*)(x + 4); r63a = *(const LAS f32x4*)(x + 128); r63b = *(const LAS f32x4*)(x + 132); }
            const f32x4 s2a = fr == 15 ? r63a : r62a, s2b = fr == 15 ? r63b : r62b;
#pragma unroll
            for (int m = 0; m < 4; ++m) {
                const f32x4 ca = acc[ai][0][m][0], cb_ = acc[ai][0][m][1], ua = acc[ai][1][m][0], ub = acc[ai][1][m][1];
                const int lrow = ai * HALF + wr * 64 + m * 16 + fr;
                f32x4 za = w2a * ca + bba, zb = w2b * cb_ + bbb;
                { float za0 = za[0], za1 = za[1], za2 = za[2], za3 = za[3], zb0 = zb[0], zb1 = zb[1], zb2 = zb[2], zb3 = zb[3];
                  const f32x4 p1a = m == 0 ? r63a : acc[ai][0][m > 0 ? m - 1 : 0][0], p1b = m == 0 ? r63b : acc[ai][0][m > 0 ? m - 1 : 0][1];
                  const f32x4 p2a = m == 0 ? s2a : p1a, p2b = m == 0 ? s2b : p1b;
                  { const f32x4 W1 = w1a, W0 = w0a; TAPS_CUR(za, ca); TAPS_PREV(za, p1a, p2a); }
                  { const f32x4 W1 = w1b, W0 = w0b; TAPS_CUR(zb, cb_); TAPS_PREV(zb, p1b, p2b); }
                  za = (f32x4){za0, za1, za2, za3}; zb = (f32x4){zb0, zb1, zb2, zb3}; }
                if (q == 0 && m == 0 && fr < 2 && !seqstart) {
                    float* ep = EDGE + ((size_t)((u.pm * 2 + fr) * 2)) * DFF + ch;
                    *(f32x4*)ep = ca; *(GAS f32x4*)(ep + 4) = cb_; *(GAS f32x4*)(ep + DFF) = ua; *(GAS f32x4*)(ep + DFF + 4) = ub;
                } else {
                    f32x4 ta = za * (-LOG2E), tb = zb * (-LOG2E);
#pragma unroll
                    for (int j = 0; j < 4; ++j) { ta[j] = __builtin_amdgcn_exp2f(ta[j]); tb[j] = __builtin_amdgcn_exp2f(tb[j]); }
                    ta = ta + 1.0f; tb = tb + 1.0f;
#pragma unroll
                    for (int j = 0; j < 4; ++j) { ta[j] = __builtin_amdgcn_rcpf(ta[j]); tb[j] = __builtin_amdgcn_rcpf(tb[j]); }
                    za = za * ta * ua; zb = zb * tb * ub;
                    *(GAS u32x4*)(ACT + (size_t)(u.pm * BM + lrow) * DFF + ch) = pack8(za, zb);
                }
            }
        }
#undef TAPS_CUR
#undef TAPS_PREV
    }
};
struct EpiKvc {
    bf16_t* KVC;
    __device__ __forceinline__ void operator()(const f32x4 (&acc)[2][2][4][2], const Unit& u, int wr, int wc, int fr, int fq) const {
        const int row0 = u.pm * BM + wr * 64 + fr, col0 = wc * 32 + 8 * fq;
#pragma unroll
        for (int ai = 0; ai < 2; ++ai)
#pragma unroll
            for (int m = 0; m < 4; ++m) { const int row = row0 + ai * HALF + m * 16; const bool dead = (row & 511) == 511;
                const f32x4 z4 = (f32x4){0.f, 0.f, 0.f, 0.f}; const f32x4 v0 = dead ? z4 : acc[ai][0][m][0], v1 = dead ? z4 : acc[ai][0][m][1];
                *(GAS u32x4*)(KVC + ((size_t)u.pn * 4096 + row) * 128 + col0) = pack8(v0, v1); }
    }
};
}

struct Args { const float* in[21]; float* out; unsigned char* ws; int ph_lo, ph_hi; };
struct Frame {
    LAS unsigned char* lds; volatile LAS unsigned* MISC; unsigned* ctl;
    int G, bid, wv;
    unsigned char* ws; float* out;
};
enum { IN_X = 0, IN_MEM, IN_LN_MIX, IN_LN_XA, IN_LN_FFN, IN_MEM_NORM, IN_POOL_W, IN_POOL_SCALE, IN_NSA_W_IN, IN_NSA_W_OUT, IN_CMP_POS, IN_CMP_W1, IN_CMP_B1, IN_CMP_W2,
       IN_XA_WQ, IN_XA_WKV, IN_XA_WO, IN_FFN_WGU, IN_FFN_CONVW, IN_FFN_CONVB, IN_FFN_WDN };

template <int MODE>
__device__ __forceinline__ void p0_transpose_item(const float* W, int K, int N, bf16_t* WT, const float* gk  , LAS unsigned* scr, int item, int lane) {
    const int nblk = (N + 63) / 64, kb = item / nblk, nb = item - kb * nblk, k0 = 64 * kb, n0 = 64 * nb;
    const int rr = lane >> 4, cq = lane & 15, n = n0 + 4 * cq; const bool nok = n < N;
    f32x4 v[16];
#pragma unroll
    for (int i = 0; i < 8; ++i)
#pragma unroll
        for (int e = 0; e < 2; ++e) { const int k = k0 + 8 * i + 2 * rr + e; v[2 * i + e] = nok ? *(const GAS f32x4*)(W + (size_t)k * N + n) : (f32x4){0.f, 0.f, 0.f, 0.f}; }
#pragma unroll
    for (int i = 0; i < 8; ++i) { f32x4 a = v[2 * i], b = v[2 * i + 1];
        if (gk) { const int k = k0 + 8 * i + 2 * rr; a = a * gk[k]; b = b * gk[k + 1]; }
        LAS unsigned* d = scr + (4 * i + rr) * 65 + 4 * cq;
        d[0] = cvtpk(a[0], b[0]); d[1] = cvtpk(a[1], b[1]); d[2] = cvtpk(a[2], b[2]); d[3] = cvtpk(a[3], b[3]); }
    LDS_WAIT(); asm volatile("" ::: "memory");
    int r0 = n0;
    if (MODE == 1) { const int up = n0 >= DFF ? 1 : 0, ch = n0 - up * DFF; r0 = (ch >> 7) * 256 + up * 128 + (ch & 127); }
    const int c = lane & 7;
#pragma unroll
    for (int j = 0; j < 8; ++j) { const int nn = (lane >> 3) + 8 * j; const LAS unsigned* sp = scr + (4 * c) * 65 + nn;
        u32x4 o; o.x = sp[0]; o.y = sp[65]; o.z = sp[130]; o.w = sp[195];
        if (n0 + nn < N) *(GAS u32x4*)(WT + (size_t)(r0 + nn) * K + k0 + 8 * c) = o; }
    LDS_WAIT(); asm volatile("" ::: "memory");
}
__device__ __forceinline__ float row_sumsq(const float* row, int lane) {
    const f32x4* xr = (const f32x4*)row + lane; float s = 0.f;
#pragma unroll
    for (int j = 0; j < 16; ++j) { const f32x4 v = xr[64 * j]; s += (v[0] * v[0] + v[1] * v[1]) + (v[2] * v[2] + v[3] * v[3]); }
    return wave_sum(s);
}
#ifndef XQFILL
#define XQFILL 1
#endif
constexpr int XQF_N = 112 * NWAVES * 11;
#ifndef TAILFILL
#define TAILFILL 1
#endif
#ifndef DEFER_CONV
#define DEFER_CONV 1
#endif
__device__ __forceinline__ void phase_p0(Frame& F, const Args& A) {
    unsigned char* const wsl = optr(F.ws);
    const int tid = otid(), lane = tid & 63, wave = __builtin_amdgcn_readfirstlane(tid >> 6);
    LAS unsigned* scr = (LAS unsigned*)(F.lds + wave * 8448);
    const int gw = F.bid * NWAVES + wave, NGW = F.G * NWAVES;
    unsigned char* ws = wsl;
    int it = gw;
#define P0_MAT(MODE, src, K_, N_, dst, gk_) do { const int n_ = ((K_) / 64) * (((N_) + 63) / 64); for (; it < n_; it += NGW) p0_transpose_item<MODE>((src), (K_), (N_), (bf16_t*)(dst), (gk_), scr, it, lane); it -= n_; } while (0)
    { const int off_ = (XQFILL && F.G == 256) ? XQF_N : 0; const int n_ = (DM / 64) * (DFF2 / 64) - off_;
      for (; it < n_; it += NGW) p0_transpose_item<1>(A.in[IN_FFN_WGU], DM, DFF2, (bf16_t*)(ws + WS_WGU), A.in[IN_LN_FFN], scr, it + off_, lane); it -= n_; }
    for (int l = 1; l < 2 - DEFER_CONV; ++l) P0_MAT(1, A.in[IN_FFN_WGU] + (size_t)l * DM * DFF2, DM, DFF2, ws + WS_WGU + (size_t)l * DFF2 * DM * 2, A.in[IN_LN_FFN] + (size_t)l * 2 * DM);
    for (int l = 0; l < (TAILFILL ? 0 : 2 - DEFER_CONV); ++l) P0_MAT(0, A.in[IN_FFN_WDN] + (size_t)l * DFF * DM, DFF, DM, ws + WS_WDN + (size_t)l * DM * DFF * 2, nullptr);
    P0_MAT(0, A.in[IN_NSA_W_IN], DM, NSA_INW, ws + WS_NSAIN, A.in[IN_LN_MIX] + (size_t)2 * DM);
    if (!DEFER_CONV) P0_MAT(0, A.in[IN_NSA_W_OUT], QW, DM, ws + WS_NSAOUT, nullptr);
    for (int g = 0; g < 4; ++g) P0_MAT(0, A.in[IN_POOL_W] + (size_t)g * PGC * PGC, PGC, PGC, ws + WS_POOLW + (size_t)g * PGC * PGC * 2, nullptr);
    for (int l = 0; l < 2; ++l) P0_MAT(0, A.in[IN_CMP_W1] + (size_t)l * 4096 * CMP_HID, 4096, CMP_HID, ws + WS_CMPW1 + (size_t)l * CMP_HID * 4096 * 2, nullptr);
    for (int l = 0; l < 2; ++l) P0_MAT(0, A.in[IN_CMP_W2] + (size_t)l * CMP_HID * HD, CMP_HID, HD, ws + WS_CMPW2 + (size_t)l * 256 * CMP_HID * 2, nullptr);
    for (int l = 0; l < 2 - DEFER_CONV; ++l) P0_MAT(0, A.in[IN_XA_WQ] + (size_t)l * DM * XAW, DM, XAW, ws + WS_XAQ + (size_t)l * XAW * DM * 2, A.in[IN_LN_XA] + (size_t)l * 2 * DM);
    for (int l = 0; l < 2; ++l) P0_MAT(0, A.in[IN_XA_WKV] + (size_t)l * DM * 2 * XAW, DM, 2 * XAW, ws + WS_XAKV + (size_t)l * 2 * XAW * DM * 2, nullptr);
    for (int l = 0; l < 2 - DEFER_CONV; ++l) P0_MAT(0, A.in[IN_XA_WO] + (size_t)l * XAW * DM, XAW, DM, ws + WS_XAO + (size_t)l * DM * XAW * 2, nullptr);
#undef P0_MAT
    for (int l = 0; l < 2; ++l) { u32x4* z = (u32x4*)(ws + WS_CMPW2 + ((size_t)l * 256 + HD) * CMP_HID * 2); const int n16 = (256 - HD) * CMP_HID * 2 / 16;
      for (int i = gw * 64 + lane; i < n16; i += NGW * 64) *(GAS u32x4*)(z + i) = (u32x4){0u, 0u, 0u, 0u}; }
    { u32x4* z = (u32x4*)(ws + WS_NSAIN + (size_t)NSA_INW * DM * 2); const int n16 = (NSA_INP - NSA_INW) * DM * 2 / 16;
      for (int i = gw * 64 + lane; i < n16; i += NGW * 64) z[i] = (u32x4){0u, 0u, 0u, 0u}; }
    for (int r = gw; r < MMEM; r += NGW) {
        const float* row = A.in[IN_MEM] + (size_t)r * DM; const float rs = 1.0f / sqrtf(row_sumsq(row, lane) * (1.0f / DM) + RMS_EPS);
        bf16_t* o = (bf16_t*)(ws + WS_MEMN) + (size_t)r * DM;
#pragma unroll
        for (int j = 0; j < 8; ++j) { const int c8 = (j * 64 + lane) * 8; const f32x4 a = *(const GAS f32x4*)(row + c8), b = *(const GAS f32x4*)(row + c8 + 4);
            const f32x4 ga = *(const GAS f32x4*)(A.in[IN_MEM_NORM] + c8), gb = *(const GAS f32x4*)(A.in[IN_MEM_NORM] + c8 + 4);
            *(GAS u32x4*)(o + c8) = pg8::pack8(a * rs * ga, b * rs * gb); }
    }
    { float* part = (float*)(ws + WS_CMPB + 65536);
      for (int tk = gw; tk < 256; tk += NGW) { const int kv = tk >> 7, ng = (tk >> 4) & 7, ks = tk & 15, n = ng * 64 + lane;
          const float* pos = A.in[IN_CMP_POS] + (size_t)kv * 4096 + ks * 256; const float* w1 = A.in[IN_CMP_W1] + ((size_t)kv * 4096 + ks * 256) * CMP_HID + n; float s = 0.f;
#pragma unroll 8
          for (int k = 0; k < 256; ++k) s += pos[k] * w1[(size_t)k * CMP_HID];
          part[(kv * 16 + ks) * CMP_HID + n] = s; } }
    { float* xr = (float*)(ws + WS_XR);
      for (int r = gw; r < MTOK; r += NGW) { const float ss = row_sumsq(A.in[IN_X] + (size_t)r * DM, lane); if (lane == 0) xr[r] = 1.0f / sqrtf(ss * (1.0f / DM) + RMS_EPS); } }
}

template <int WIN>
__device__ __forceinline__ void pool_item(const float* X, const float* xr, const f32x4 gv, bf16_t* D0, int t0, int tin0, int c) {
    f32x4 prev[WIN]; f32x4 s = (f32x4){0.f, 0.f, 0.f, 0.f};
#pragma unroll
    for (int i = 0; i < WIN; ++i) { prev[i] = (tin0 - WIN + i >= 0) ? *(const GAS f32x4*)(X + (size_t)(t0 - WIN + i) * DM + c) * ((const GAS float*)xr)[tin0 - WIN + i >= 0 ? t0 - WIN + i : t0] * gv : (f32x4){0.f, 0.f, 0.f, 0.f}; s += prev[i]; }
#pragma unroll 1
    for (int r0 = 0; r0 < 64; r0 += 16) {
        f32x4 cur[16];
#pragma unroll
        for (int r = 0; r < 16; ++r) { const int t = t0 + r0 + r; cur[r] = *(const GAS f32x4*)(X + (size_t)t * DM + c) * ((const GAS float*)xr)[t] * gv; }
#pragma unroll
        for (int r = 0; r < 16; ++r) { const int t = t0 + r0 + r, tin = tin0 + r0 + r;
            const f32x4 old = (r >= WIN) ? cur[r >= WIN ? r - WIN : 0] : prev[r < WIN ? r : 0];
            s += cur[r]; s -= old;
            const float ic = 1.0f / (float)(tin + 1 < WIN ? tin + 1 : WIN);
            const f32x4 d = s * ic - cur[r]; u32x2 w; w.x = cvtpk(d[0], d[1]); w.y = cvtpk(d[2], d[3]);
            *(GAS u32x2*)(D0 + (size_t)t * DM + c) = w; }
#pragma unroll
        for (int i = 0; i < WIN; ++i) prev[i] = cur[16 - WIN + i];
    }
}
__device__ __forceinline__ void phase_poolprep(Frame& F, const Args& A) {
    unsigned char* const wsl = optr(F.ws);
    const float* X = A.in[IN_X]; const float* g0 = A.in[IN_LN_MIX]; const float* xr = (const float*)(wsl + WS_XR); bf16_t* D0 = (bf16_t*)(wsl + WS_HN);
    const int tid = otid();
    constexpr int NQ = DM / 4, TOTAL = (MTOK / 64) * NQ;
    for (int it = F.bid * NTHR + tid; it < TOTAL; it += F.G * NTHR) {
        const int chn = it / NQ, qq = it - chn * NQ, c = 4 * qq, t0 = chn * 64, tin0 = t0 & (SEQ - 1);
        const f32x4 gv = *(const GAS f32x4*)(g0 + c);
        switch (__builtin_amdgcn_readfirstlane(c >> 10)) {
            case 0: pool_item<2>(X, xr, gv, D0, t0, tin0, c); break;
            case 1: pool_item<4>(X, xr, gv, D0, t0, tin0, c); break;
            case 2: pool_item<8>(X, xr, gv, D0, t0, tin0, c); break;
            default: pool_item<16>(X, xr, gv, D0, t0, tin0, c); break;
        }
    }
}

template <bool FIRST, bool LAST>
__device__ __forceinline__ void phase_resid(Frame& F, const float* x, const float* g1) {
    unsigned char* const wsl = optr(F.ws);
    const int tid = otid(), lane = tid & 63, wave = __builtin_amdgcn_readfirstlane(tid >> 6);
    const int gw = F.bid * NWAVES + wave, NGW = F.G * NWAVES;
    const bf16_t* Y = (const bf16_t*)(wsl + WS_Y); const float* ssp = (const float*)(wsl + WS_SSP); bf16_t* H = (bf16_t*)(wsl + WS_HN); float* RS = (float*)(wsl + WS_RS);
    for (int row = gw; row < MTOK; row += NGW) {
        const float ss = wave_sum(((const GAS float*)ssp)[(size_t)row * 64 + lane]); const float rs = 1.0f / sqrtf(ss * (1.0f / DM) + RMS_EPS);
        float s2 = 0.f;
#pragma unroll
        for (int j = 0; j < 8; ++j) { const int c8 = (j * 64 + lane) * 8; const size_t off = (size_t)row * DM + c8;
            const u32x4 yw = *(const GAS u32x4*)(Y + off); f32x4 h0, h1;
            if (FIRST) { h0 = *(const GAS f32x4*)(x + off); h1 = *(const GAS f32x4*)(x + off + 4); }
            else { const u32x4 hw = *(const GAS u32x4*)(H + off); h0 = (f32x4){bflo(hw.x), bfhi(hw.x), bflo(hw.y), bfhi(hw.y)}; h1 = (f32x4){bflo(hw.z), bfhi(hw.z), bflo(hw.w), bfhi(hw.w)}; }
            const f32x4 ga = *(const GAS f32x4*)(g1 + c8), gb = *(const GAS f32x4*)(g1 + c8 + 4);
            const f32x4 y0 = (f32x4){bflo(yw.x), bfhi(yw.x), bflo(yw.y), bfhi(yw.y)}, y1 = (f32x4){bflo(yw.z), bfhi(yw.z), bflo(yw.w), bfhi(yw.w)};
            const f32x4 a = h0 + y0 * rs * ga, b = h1 + y1 * rs * gb;
            if (LAST) { *(GAS f32x4*)(F.out + off) = a; *(GAS f32x4*)(F.out + off + 4) = b; }
            else { *(GAS u32x4*)(H + off) = pg8::pack8(a, b);
                s2 += (a[0] * a[0] + a[1] * a[1]) + (a[2] * a[2] + a[3] * a[3]) + (b[0] * b[0] + b[1] * b[1]) + (b[2] * b[2] + b[3] * b[3]); } }
        if (!LAST) { const float t2 = wave_sum(s2); if (lane == 0) ((GAS float*)RS)[row] = 1.0f / sqrtf(t2 * (1.0f / DM) + RMS_EPS); }
    }
}

__device__ __forceinline__ void unpack8(const u32x4 w, float (&f)[8]) { f[0] = bflo(w.x); f[1] = bfhi(w.x); f[2] = bflo(w.y); f[3] = bfhi(w.y); f[4] = bflo(w.z); f[5] = bfhi(w.z); f[6] = bflo(w.w); f[7] = bfhi(w.w); }
__device__ __forceinline__ void phase_act(Frame& F, const float* cw, const float* cb) {
    unsigned char* const wsl = optr(F.ws);
    const bf16_t* GU = (const bf16_t*)(wsl + WS_GU); bf16_t* ACT = (bf16_t*)(wsl + WS_ACT);
    constexpr int NCG = DFF / 8, RCH = 32, TOTAL = (MTOK / RCH) * NCG;
    const int tid = otid();
    for (int it = F.bid * NTHR + tid; it < TOTAL; it += F.G * NTHR) {
        const int chunk = it / NCG, cg = it - chunk * NCG, ch = cg * 8, colg = (ch >> 7) * 256 + (ch & 127), colu = colg + 128;
        const int t0 = chunk * RCH, tin0 = t0 & (SEQ - 1);
        float w0[8], w1[8], w2[8], bb[8], g2[8], g1[8];
#pragma unroll
        for (int j = 0; j < 8; ++j) { w0[j] = cw[ch + j]; w1[j] = cw[DFF + ch + j]; w2[j] = cw[2 * DFF + ch + j]; bb[j] = cb[ch + j]; g2[j] = 0.f; g1[j] = 0.f; }
        if (tin0 >= 2) { unpack8(*(const GAS u32x4*)(GU + (size_t)(t0 - 2) * DFF2 + colg), g2); unpack8(*(const GAS u32x4*)(GU + (size_t)(t0 - 1) * DFF2 + colg), g1); }
#pragma unroll 2
        for (int r = 0; r < RCH; ++r) { const size_t ro = (size_t)(t0 + r) * DFF2; float gc[8], up[8], o[8];
            unpack8(*(const GAS u32x4*)(GU + ro + colg), gc); unpack8(*(const GAS u32x4*)(GU + ro + colu), up);
#pragma unroll
            for (int j = 0; j < 8; ++j) { const float z = w0[j] * g2[j] + w1[j] * g1[j] + w2[j] * gc[j] + bb[j]; o[j] = z * sigmoidf_(z) * up[j]; g2[j] = g1[j]; g1[j] = gc[j]; }
            u32x4 w; w.x = cvtpk(o[0], o[1]); w.y = cvtpk(o[2], o[3]); w.z = cvtpk(o[4], o[5]); w.w = cvtpk(o[6], o[7]);
            *(GAS u32x4*)(ACT + (size_t)(t0 + r) * DFF + ch) = w; }
    }
}

__device__ __forceinline__ void phase_actfix(Frame& F, const float* cw, const float* cb) {
    unsigned char* const wsl = optr(F.ws);
    const float* HALO = (const float*)(wsl + WS_HALO); const float* EDGE = (const float*)(wsl + WS_EDGE); bf16_t* ACT = (bf16_t*)(wsl + WS_ACT);
    constexpr int NC4 = DFF / 4, TOTAL = 64 * 2 * NC4;
    const int tid = otid();
    for (int it = F.bid * NTHR + tid; it < TOTAL; it += F.G * NTHR) {
        const int c4 = it % NC4, pr = it / NC4, r = pr & 1, pm = pr >> 1, ch = 4 * c4;
        if ((pm & 31) == 0) continue;
        const float* e = EDGE + ((size_t)((pm * 2 + r) * 2)) * DFF + ch; const float* hprev = HALO + ((size_t)((pm - 1) * 2)) * DFF + ch;
        const f32x4 cur = *(const f32x4*)e, up = *(const GAS f32x4*)(e + DFF);
        const f32x4 p1 = r == 0 ? *(const GAS f32x4*)(hprev + DFF) : *(const GAS f32x4*)(EDGE + ((size_t)((pm * 2) * 2)) * DFF + ch);
        const f32x4 p2 = r == 0 ? *(const f32x4*)hprev : *(const GAS f32x4*)(hprev + DFF);
        f32x4 z = *(const GAS f32x4*)(cw + ch) * p2 + *(const GAS f32x4*)(cw + DFF + ch) * p1 + *(const GAS f32x4*)(cw + 2 * DFF + ch) * cur + *(const GAS f32x4*)(cb + ch);
#pragma unroll
        for (int j = 0; j < 4; ++j) z[j] = z[j] * sigmoidf_(z[j]) * up[j];
        u32x2 w; w.x = cvtpk(z[0], z[1]); w.y = cvtpk(z[2], z[3]);
        *(GAS u32x2*)(ACT + (size_t)(pm * 256 + r) * DFF + ch) = w;
    }
}

__device__ __forceinline__ void phase_cmp2(Frame& F) {
    unsigned char* const wsl = optr(F.ws);
    const int tid = otid(), lane = tid & 63, wave = __builtin_amdgcn_readfirstlane(tid >> 6);
    const int gw = F.bid * NWAVES + wave, NGW = F.G * NWAVES;
    const bf16_t* HID = (const bf16_t*)(wsl + WS_HID); const bf16_t* W2 = (const bf16_t*)(wsl + WS_CMPW2); bf16_t* KVC = (bf16_t*)(wsl + WS_KVC);
    for (int r = gw; r < 2 * 4096; r += NGW) { const int kv = r >> 12;
        const bf16_t* h = HID + (size_t)r * CMP_HID; const bf16_t* wa = W2 + ((size_t)kv * HD + 2 * lane) * CMP_HID; const bf16_t* wb = wa + CMP_HID;
        float s0 = 0.f, s1 = 0.f;
#pragma unroll 4
        for (int k = 0; k < CMP_HID; k += 8) { float hf[8], a[8], b[8]; unpack8(*(const GAS u32x4*)(h + k), hf); unpack8(*(const GAS u32x4*)(wa + k), a); unpack8(*(const GAS u32x4*)(wb + k), b);
#pragma unroll
            for (int j = 0; j < 8; ++j) { s0 += hf[j] * a[j]; s1 += hf[j] * b[j]; } }
        if ((r & 511) == 511) { s0 = 0.f; s1 = 0.f; }
        *(GAS unsigned*)(KVC + (size_t)r * HD + 2 * lane) = cvtpk(s0, s1);
    }
}


namespace att {
constexpr int SHM = 16384;
constexpr int V_OFF = 0, K_OFF = 2 * SHM;
constexpr int SG_OFF = 65536, SL_OFF = SG_OFF + 16384, SELW_OFF = SL_OFF + 16384, TL_OFF = SELW_OFF + 512;
constexpr int WUN_OFF = TL_OFF + 640;
constexpr int ALF_OFF = TL_OFF + 1024;
constexpr float THR2 = 11.5f;
#define KSWZ(row, colB) ((row) * 256 + ((colB) ^ (((row) & 7) << 4)))
#define SBAR() __builtin_amdgcn_sched_barrier(0)
__device__ __forceinline__ int v_st(int k, int c) { const int kk = (k & ~0xC) | ((k & 4) << 1) | ((k & 8) >> 1); return ((kk >> 3) * 4 + (c >> 5)) * 512 + ((kk & 7) * 32 + (c & 31)) * 2; }
__device__ __forceinline__ int v_rd_base(int lane) { return ((lane & 3) << 3) | (((lane >> 2) & 3) << 6) | (((lane >> 4) & 1) << 5) | (((lane >> 5) & 1) << 8); }
constexpr int v_rd_off(int d0, int ks, int half) { return d0 * 512 + ks * 4096 + half * 2048; }
__device__ __forceinline__ int crow(int r, int hi) { return (r & 3) + 8 * (r >> 2) + 4 * hi; }

__device__ __forceinline__ void qkt(f32x16& p0, f32x16& p1, const LAS unsigned char* lds  , int r32, int hi, const bf16x8 (&qr)[8]) {
#pragma unroll
    for (int r = 0; r < 16; ++r) { p0[r] = 0.f; p1[r] = 0.f; }
    const LAS unsigned char* kb[4];
#pragma unroll
    for (int dd = 0; dd < 4; ++dd) kb[dd] = lds + KSWZ(r32, (dd * 16 + hi * 8) * 2);
#pragma unroll
    for (int d0 = 0; d0 < 8; ++d0) { const LAS unsigned char* a = kb[d0 & 3] + (d0 >> 2) * 128;
        const bf16x8 b0 = *(const LAS bf16x8*)a;
        const bf16x8 b1 = *(const LAS bf16x8*)(a + 32 * 256);
        p0 = __builtin_amdgcn_mfma_f32_32x32x16_bf16(b0, qr[d0], p0, 0, 0, 0);
        p1 = __builtin_amdgcn_mfma_f32_32x32x16_bf16(b1, qr[d0], p1, 0, 0, 0);
        if ((d0 & 3) == 3) SBAR(); }
}
__device__ __forceinline__ void pv_tile(f32x16 (&o)[4], int vb0  , bf16x8 pa0, bf16x8 pa1, bf16x8 pa2, bf16x8 pa3) {
#define TRRD(dst, off) asm volatile("ds_read_b64_tr_b16 %0, %1 offset:%2" : "=&v"(dst) : "v"(vb0), "i"(off) : "memory")
#define PV_D0(d0) do { s16x4 l0, l1, l2, l3, h0, h1, h2, h3; constexpr int b_ = v_rd_off(d0, 0, 0); \
        TRRD(l0, b_); TRRD(h0, b_ + 2048); TRRD(l1, b_ + 4096); TRRD(h1, b_ + 6144); TRRD(l2, b_ + 8192); TRRD(h2, b_ + 10240); TRRD(l3, b_ + 12288); TRRD(h3, b_ + 14336); \
        asm volatile("s_waitcnt lgkmcnt(0)" ::: "memory"); SBAR(); \
        o[d0] = __builtin_amdgcn_mfma_f32_32x32x16_bf16((bf16x8){l0[0], l0[1], l0[2], l0[3], h0[0], h0[1], h0[2], h0[3]}, pa0, o[d0], 0, 0, 0); \
        o[d0] = __builtin_amdgcn_mfma_f32_32x32x16_bf16((bf16x8){l1[0], l1[1], l1[2], l1[3], h1[0], h1[1], h1[2], h1[3]}, pa1, o[d0], 0, 0, 0); \
        o[d0] = __builtin_amdgcn_mfma_f32_32x32x16_bf16((bf16x8){l2[0], l2[1], l2[2], l2[3], h2[0], h2[1], h2[2], h2[3]}, pa2, o[d0], 0, 0, 0); \
        o[d0] = __builtin_amdgcn_mfma_f32_32x32x16_bf16((bf16x8){l3[0], l3[1], l3[2], l3[3], h3[0], h3[1], h3[2], h3[3]}, pa3, o[d0], 0, 0, 0); } while (0)
    PV_D0(0); PV_D0(1); PV_D0(2); PV_D0(3);
#undef PV_D0
#undef TRRD
}
__device__ __forceinline__ float red8(float v) {
    v += __int_as_float(__builtin_amdgcn_update_dpp(0, __float_as_int(v), 0xB1, 0xF, 0xF, true));
    v += __int_as_float(__builtin_amdgcn_update_dpp(0, __float_as_int(v), 0x4E, 0xF, 0xF, true));
    v += __int_as_float(__builtin_amdgcn_update_dpp(0, __float_as_int(v), 0x141, 0xF, 0xF, true));
    return v;
}
template <int MODE>
__device__ __forceinline__ void score_mod(f32x16& e0, f32x16& e1, int kidx, int t_row, float sl2, int hi, bool rowok) {
    if (MODE == 0) {
#pragma unroll
        for (int r = 0; r < 16; ++r) { e0[r] *= QK_C2; e1[r] *= QK_C2; }
        return;
    }
    constexpr int CS = (MODE == 1) ? 16 : 1;
    constexpr unsigned W = (MODE == 3) ? 512u : 0x7fffffffu;
    const int dqa = (MODE == 1) ? (t_row - 31 - 1024 * kidx - 64 * hi) : (t_row - kidx - 4 * hi);
    const int dqb = dqa - 32 * CS;
    const float slc = sl2 * (float)CS, ba = -sl2 * (float)dqa, bb = -sl2 * (float)dqb;
    const float NEG = -__builtin_inff();
#pragma unroll
    for (int r = 0; r < 16; ++r) { const int c = (r & 3) + 8 * (r >> 2);
        const float xa = fmaf(e0[r], QK_C2, fmaf(slc, (float)c, ba)), xb = fmaf(e1[r], QK_C2, fmaf(slc, (float)c, bb));
        e0[r] = (rowok && (unsigned)(dqa - CS * c) < W) ? xa : NEG;
        e1[r] = (rowok && (unsigned)(dqb - CS * c) < W) ? xb : NEG; }
}
__device__ __forceinline__ void prefetch_k(LAS unsigned char* lds, const bf16_t* Kp, int key0, int buf, int wave_s) {
    const int tid = otid_w(wave_s), wave = __builtin_amdgcn_readfirstlane(tid >> 6);
#pragma unroll
    for (int j = 0; j < 2; ++j) { const int q = 512 * j + tid, row = q >> 4, cc = (q & 15) ^ (row & 7);
        __builtin_amdgcn_global_load_lds((const unsigned*)(Kp + (size_t)key0 * HD + (unsigned)(row * HD + cc * 8)), (LAS unsigned*)(lds + K_OFF + buf * SHM + j * 8192 + wave * 1024), 16, 0, 0); }
}
__device__ __forceinline__ void prefetch_v(LAS unsigned char* lds, const bf16_t* Vp, int key0, int buf, int wave_s) {
    const int tid = otid_w(wave_s), wave = __builtin_amdgcn_readfirstlane(tid >> 6);
#pragma unroll
    for (int j = 0; j < 2; ++j) { const int q = 512 * j + tid, sb = q >> 5, kk = (sb >> 2) * 8 + ((q & 31) >> 2), c = (sb & 3) * 32 + (q & 3) * 8, k = (kk & ~0xC) | ((kk & 4) << 1) | ((kk & 8) >> 1);
        __builtin_amdgcn_global_load_lds((const unsigned*)(Vp + (size_t)key0 * HD + (unsigned)(k * HD + c)), (LAS unsigned*)(lds + V_OFF + buf * SHM + j * 8192 + wave * 1024), 16, 0, 0); }
}
__device__ __forceinline__ void prefetch_k0(LAS unsigned char* lds, const bf16_t* Kp, int key0, int wave_s) { prefetch_k(lds, Kp, key0, 0, wave_s); }
template <int MODE, int PASS, bool PRE = false, bool CHAIN = false>
__device__ __forceinline__ void attn_pass(LAS unsigned char* lds, const bf16_t* Kp, const bf16_t* Vp, int pitch, int NT, int kb0,
                                          const bf16x8 (&qr)[8], float& m, float& l, float gate, float invl, f32x16 (&o)[4], int t_row, float sl2, int tokl, int wave_s, int par0 = 0) {
    const int tid = otid_w(wave_s), lane = tid & 63, r32 = lane & 31, hi = lane >> 5;
    const int sr = tid >> 4, sc = (tid & 15) * 8, vst0 = v_st(sr, sc), vst1 = v_st(32 + sr, sc), kws = KSWZ(sr, sc * 2);
    const int vb0 = (int)(uintptr_t)lds + V_OFF + v_rd_base(lane);
    const LAS int* TL = (const LAS int*)(lds + TL_OFF);
    const LAS unsigned* SELW = (const LAS unsigned*)(lds + SELW_OFF);
    LAS float* SG = (LAS float*)(lds + SG_OFF); LAS float* SL = (LAS float*)(lds + SL_OFF);
    bf16x8 st_k0, st_k1, st_v0, st_v1;
#define KEY0(i) ((MODE == 2) ? 64 * TL[(i)] : kb0 + 64 * (i))
#define A_LOAD(k0_) do { st_k0 = *(const GAS bf16x8*)(Kp + (size_t)((k0_) + sr) * pitch + sc); st_k1 = *(const GAS bf16x8*)(Kp + (size_t)((k0_) + 32 + sr) * pitch + sc); \
        if (PASS == 2) { st_v0 = *(const GAS bf16x8*)(Vp + (size_t)((k0_) + sr) * pitch + sc); st_v1 = *(const GAS bf16x8*)(Vp + (size_t)((k0_) + 32 + sr) * pitch + sc); } } while (0)
#define A_WRITE(bf) do { *(LAS bf16x8*)(lds + K_OFF + (bf) * SHM + kws) = st_k0; *(LAS bf16x8*)(lds + K_OFF + (bf) * SHM + kws + 32 * 256) = st_k1; \
        if (PASS == 2) { *(LAS bf16x8*)(lds + V_OFF + (bf) * SHM + vst0) = st_v0; *(LAS bf16x8*)(lds + V_OFF + (bf) * SHM + vst1) = st_v1; } } while (0)
#define A_STEP(i, BUF) do { \
        const bool more_ = (i) + 1 < NT; const int kcur_ = KEY0(i); \
        if (more_) { const int kn_ = KEY0((i) + 1); A_LOAD(kn_); } else if (CHAIN) { prefetch_k(lds, Kp, kb0, (BUF) ^ 1, wave_s); } \
        bool rowok_ = true; bool act_ = true; \
        if (MODE == 2) { const int n_ = kcur_ >> 6; rowok_ = ((SELW[tokl * 4 + (n_ >> 5)] >> (n_ & 31)) & 1u) != 0u; act_ = __any(rowok_); } \
        if (act_) { \
            f32x16 e0, e1; qkt(e0, e1, lds + K_OFF + (BUF) * SHM, r32, hi, qr); SBAR(); \
              \
              \
            const int dq_ = (MODE == 1) ? (t_row - 31 - 1024 * (i) - 64 * hi) : 0; \
            const float slc_ = (MODE == 1) ? 16.0f * sl2 : 0.f; \
            const float b00_ = ((MODE == 1) ? -sl2 * (float)dq_ : 0.f) - sh_; \
            f32x2 bp_ = {b00_, b00_ + slc_}; const f32x2 s2_ = {2.0f * slc_, 2.0f * slc_}, s6_ = {6.0f * slc_, 6.0f * slc_}, dB_ = {32.0f * slc_, 32.0f * slc_}, c2v_ = {QK_C2, QK_C2}; \
            _Pragma("unroll") for (int r = 0; r < 16; r += 2) { \
                const f32x2 xa_ = __builtin_elementwise_fma((f32x2){e0[r], e0[r + 1]}, c2v_, bp_), xb_ = __builtin_elementwise_fma((f32x2){e1[r], e1[r + 1]}, c2v_, bp_ + dB_); \
                e0[r] = xa_[0]; e0[r + 1] = xa_[1]; e1[r] = xb_[0]; e1[r + 1] = xb_[1]; \
                if (MODE == 1) bp_ += ((r & 2) == 0) ? s2_ : s6_; } \
            if (MODE == 1 && __any(dq_ - 944 < 0)) { \
                const float NEG_ = -__builtin_inff(); \
                _Pragma("unroll") for (int r = 0; r < 16; ++r) { const int c = (r & 3) + 8 * (r >> 2); \
                    if (dq_ - 16 * c < 0) e0[r] = NEG_; \
                    if (dq_ - 512 - 16 * c < 0) e1[r] = NEG_; } } \
            if (PASS == 1) { \
                float tmax = e0[0]; _Pragma("unroll") for (int r = 1; r < 16; ++r) tmax = fmaxf(tmax, e0[r]); _Pragma("unroll") for (int r = 0; r < 16; ++r) tmax = fmaxf(tmax, e1[r]); \
                { auto rr = __builtin_amdgcn_permlane32_swap(__float_as_uint(tmax), __float_as_uint(tmax), false, false); tmax = fmaxf(__uint_as_float(rr[0]), __uint_as_float(rr[1])); } \
                const float mn = fmaxf(m, tmax); const f32x2 nm_ = {-mn, -mn}; f32x2 ps2_ = {0.f, 0.f}; \
                _Pragma("unroll") for (int r = 0; r < 16; r += 2) { const f32x2 ya_ = (f32x2){e0[r], e0[r + 1]} + nm_, yb_ = (f32x2){e1[r], e1[r + 1]} + nm_; \
                    ps2_ += (f32x2){__builtin_amdgcn_exp2f(ya_[0]), __builtin_amdgcn_exp2f(ya_[1])}; ps2_ += (f32x2){__builtin_amdgcn_exp2f(yb_[0]), __builtin_amdgcn_exp2f(yb_[1])}; } \
                float ps = ps2_[0] + ps2_[1]; \
                { auto rr = __builtin_amdgcn_permlane32_swap(__float_as_uint(ps), __float_as_uint(ps), false, false); ps = __uint_as_float(rr[0]) + __uint_as_float(rr[1]); } \
                l = l * __builtin_amdgcn_exp2f(m - mn) + ps; m = mn; \
            } else { \
                _Pragma("unroll") for (int r = 0; r < 16; ++r) { e0[r] = __builtin_amdgcn_exp2f(e0[r]); e1[r] = __builtin_amdgcn_exp2f(e1[r]); } \
                if (MODE == 1) {        \
                    f32x4 gav_, lav_, gbv_, lbv_; \
                    _Pragma("unroll") for (int rq = 0; rq < 4; ++rq) { \
                        float ga = (e0[4 * rq] + e0[4 * rq + 1]) + (e0[4 * rq + 2] + e0[4 * rq + 3]), la = e0[4 * rq + 3]; \
                        float gb = (e1[4 * rq] + e1[4 * rq + 1]) + (e1[4 * rq + 2] + e1[4 * rq + 3]), lb = e1[4 * rq + 3]; \
                        gav_[rq] = red8(ga); lav_[rq] = red8(la); gbv_[rq] = red8(gb); lbv_[rq] = red8(lb); } \
                      \
                    if ((r32 & 7) == 0) { const int sa_ = tokl * 128 + 16 * (i) + 4 * hi; \
                        *(LAS f32x4*)(SG + sa_) = gav_ * rg_; *(LAS f32x4*)(SL + sa_) = lav_ * rg_; *(LAS f32x4*)(SG + sa_ + 8) = gbv_ * rg_; *(LAS f32x4*)(SL + sa_ + 8) = lbv_ * rg_; } \
                } \
                bf16x8 pa0, pa1, pa2, pa3; \
                PK4(e0, 0, pa0); PK4(e0, 8, pa1); PK4(e1, 0, pa2); PK4(e1, 8, pa3); \
                SBAR(); pv_tile(o, vb0 + (BUF) * SHM, pa0, pa1, pa2, pa3); \
            } \
        } \
        if (more_) { VM_WAIT(); A_WRITE((BUF) ^ 1); } \
        __syncthreads(); } while (0)
#define PK4(P, B_, OUT) do { unsigned a0 = cvtpk(P[B_ + 0], P[B_ + 1]), a1 = cvtpk(P[B_ + 2], P[B_ + 3]); \
        unsigned b0 = cvtpk(P[B_ + 4], P[B_ + 5]), b1 = cvtpk(P[B_ + 6], P[B_ + 7]); \
        auto r0 = __builtin_amdgcn_permlane32_swap(a0, b0, false, false); auto r1 = __builtin_amdgcn_permlane32_swap(a1, b1, false, false); \
        u32x4 w = {r0[0], r1[0], r0[1], r1[1]}; OUT = *reinterpret_cast<bf16x8*>(&w); } while (0)
    if (NT <= 0) return;
    const float gc_ = fmaxf(gate, 1e-30f), sh_ = (PASS == 2) ? m - __builtin_amdgcn_logf(gc_ * invl) : 0.f, rg_ = __builtin_amdgcn_rcpf(gc_);
    if (!PRE) { const int k0 = KEY0(0); A_LOAD(k0); VM_WAIT(); A_WRITE(par0); } else { VM_WAIT(); }
    __syncthreads();
#pragma unroll 1
    for (int i = 0; i < NT; ++i) { const int buf = (i + par0) & 1; A_STEP(i, buf); }
#undef PK4
#undef A_STEP
#undef A_WRITE
#undef A_LOAD
#undef KEY0
}

template <int MODE, bool PRE = false, int PITCH = HD>
__device__ __forceinline__ void attn_online(LAS unsigned char* lds, const bf16_t* Kp, const bf16_t* Vp, int NT, int kb0,
                                            const bf16x8 (&qr)[8], float& m, float& l, f32x16 (&o)[4], int t_row, int tw0, float sl2, int tokl, int wave_s) {
    const int tid = otid_w(wave_s), lane = tid & 63, r32 = lane & 31, hi = lane >> 5, wave = __builtin_amdgcn_readfirstlane(tid >> 6);
    const int vb0 = (int)(uintptr_t)lds + V_OFF + v_rd_base(lane);
    const LAS int* TL = (const LAS int*)(lds + TL_OFF);
    const LAS unsigned* SELW = (const LAS unsigned*)(lds + SELW_OFF);
    constexpr int pitch = PITCH;
    unsigned gko[2], gvo[2];
#pragma unroll
    for (int j = 0; j < 2; ++j) { const int q = 512 * j + tid;
        { const int row = q >> 4, cc = (q & 15) ^ (row & 7); gko[j] = (unsigned)(row * pitch + cc * 8); }
        { const int sb = q >> 5, kk = (sb >> 2) * 8 + ((q & 31) >> 2), c = (sb & 3) * 32 + (q & 3) * 8, k = (kk & ~0xC) | ((kk & 4) << 1) | ((kk & 8) >> 1); gvo[j] = (unsigned)(k * pitch + c); } }
    const unsigned ldsw = (unsigned)wave * 1024u;
    bf16x8 kx0, kx1, qx;
    { const float kr = (float)r32, bh = sl2 * (1.0f / QK_C2); const unsigned bhb = cvtpk(bh, 0.f) & 0xffffu; const float bl = bh - __uint_as_float(bhb << 16);
      u32x4 a = {hi == 0 ? cvtpk(kr, kr) : 0u, 0u, 0u, 0u}, b = {hi == 0 ? cvtpk(kr + 32.f, kr + 32.f) : 0u, 0u, 0u, 0u}, c = {hi == 0 ? cvtpk(bh, bl) : 0u, 0u, 0u, 0u};
      kx0 = *reinterpret_cast<bf16x8*>(&a); kx1 = *reinterpret_cast<bf16x8*>(&b); qx = *reinterpret_cast<bf16x8*>(&c); }
#define KEY0(i) ((MODE == 2) ? 64 * TL[(i)] : kb0 + 64 * (i))
#define DMA_K(k0_, bf) do { _Pragma("unroll") for (int j_ = 0; j_ < 2; ++j_) \
        __builtin_amdgcn_global_load_lds((const unsigned*)(Kp + (size_t)(k0_) * pitch + gko[j_]), (LAS unsigned*)(lds + K_OFF + (bf) * SHM + j_ * 8192 + ldsw), 16, 0, 0); } while (0)
#define DMA_V(k0_, bf) do { _Pragma("unroll") for (int j_ = 0; j_ < 2; ++j_) \
        __builtin_amdgcn_global_load_lds((const unsigned*)(Vp + (size_t)(k0_) * pitch + gvo[j_]), (LAS unsigned*)(lds + V_OFF + (bf) * SHM + j_ * 8192 + ldsw), 16, 0, 0); } while (0)
#define PK4(P, B_, OUT) do { unsigned a0 = cvtpk(P[B_ + 0], P[B_ + 1]), a1 = cvtpk(P[B_ + 2], P[B_ + 3]); \
        unsigned b0 = cvtpk(P[B_ + 4], P[B_ + 5]), b1 = cvtpk(P[B_ + 6], P[B_ + 7]); \
        auto r0 = __builtin_amdgcn_permlane32_swap(a0, b0, false, false); auto r1 = __builtin_amdgcn_permlane32_swap(a1, b1, false, false); \
        u32x4 w = {r0[0], r1[0], r0[1], r1[1]}; OUT = *reinterpret_cast<bf16x8*>(&w); } while (0)
#define QK_TILE(i_, E0, E1, ROK, ACT) do { const int kc_ = KEY0(i_); ROK = true; ACT = true; \
        if (MODE == 2) { const int n_ = kc_ >> 6; ROK = ((SELW[tokl * 4 + (n_ >> 5)] >> (n_ & 31)) & 1u) != 0u; ACT = __any(ROK); } \
        if (ACT) { qkt(E0, E1, lds + K_OFF + ((i_) & 1) * SHM, r32, hi, qr); \
            E0 = __builtin_amdgcn_mfma_f32_32x32x16_bf16(kx0, qx, E0, 0, 0, 0); \
            E1 = __builtin_amdgcn_mfma_f32_32x32x16_bf16(kx1, qx, E1, 0, 0, 0); } } while (0)
#define PART_SM(i_, E0, E1, ROK, AL_) do { const int kcur = KEY0(i_); \
        const float NEG = -__builtin_inff(); \
        const float tb = (ROK) ? -sl2 * (float)(t_row - kcur) : NEG; \
        const bool interior = (MODE == 3) ? (kcur + 63 <= tw0 && kcur >= tw0 + 3 - 511) : (kcur + 63 <= tw0); \
        if (!interior) { \
            constexpr unsigned W = (MODE == 3) ? 512u : 0x7fffffffu; \
            const int dqa = t_row - kcur - 4 * hi, dqb = dqa - 32; \
            _Pragma("unroll") for (int r = 0; r < 16; ++r) { const int c = (r & 3) + 8 * (r >> 2); \
                if ((unsigned)(dqa - c) >= W) E0[r] = NEG; \
                if ((unsigned)(dqb - c) >= W) E1[r] = NEG; } \
        } \
        float pmax = E0[0];        \
        _Pragma("unroll") for (int r = 1; r < 16; ++r) pmax = fmaxf(pmax, E0[r]); \
        _Pragma("unroll") for (int r = 0; r < 16; ++r) pmax = fmaxf(pmax, E1[r]); \
        { auto rr = __builtin_amdgcn_permlane32_swap(__float_as_uint(pmax), __float_as_uint(pmax), false, false); pmax = fmaxf(__uint_as_float(rr[0]), __uint_as_float(rr[1])); } \
        pmax = fmaf(pmax, QK_C2, tb); \
        float mn; \
        if (__all((pmax - m) <= THR2)) { mn = m; AL_ = 1.f; } \
        else { mn = fmaxf(m, pmax); AL_ = __builtin_amdgcn_exp2f(m - mn); m = mn; } \
        const float c0_ = tb - mn; \
        _Pragma("unroll") for (int r = 0; r < 16; r += 2) { \
            const f32x2 xa_ = __builtin_elementwise_fma((f32x2){E0[r], E0[r + 1]}, (f32x2){QK_C2, QK_C2}, (f32x2){c0_, c0_}), xb_ = __builtin_elementwise_fma((f32x2){E1[r], E1[r + 1]}, (f32x2){QK_C2, QK_C2}, (f32x2){c0_, c0_}); \
            E0[r] = __builtin_amdgcn_exp2f(xa_[0]); E0[r + 1] = __builtin_amdgcn_exp2f(xa_[1]); E1[r] = xb_[0]; E1[r + 1] = xb_[1]; } \
        if (__any(AL_ < 1.f)) {        \
            _Pragma("unroll") for (int d0 = 0; d0 < 4; ++d0) \
                _Pragma("unroll") for (int r = 0; r < 16; ++r) o[d0][r] *= AL_; } } while (0)
#define FIN_SM(E0, E1, AL_) do { \
        f32x2 ps2 = {0.f, 0.f}; \
        _Pragma("unroll") for (int r = 0; r < 16; r += 2) { E1[r] = __builtin_amdgcn_exp2f(E1[r]); E1[r + 1] = __builtin_amdgcn_exp2f(E1[r + 1]); \
            ps2 += (f32x2){E0[r], E0[r + 1]}; ps2 += (f32x2){E1[r], E1[r + 1]}; } \
        float ps = ps2[0] + ps2[1]; \
        { auto rr = __builtin_amdgcn_permlane32_swap(__float_as_uint(ps), __float_as_uint(ps), false, false); ps = __uint_as_float(rr[0]) + __uint_as_float(rr[1]); } \
        l = l * AL_ + ps; \
        PK4(E0, 0, pa0); PK4(E0, 8, pa1); PK4(E1, 0, pa2); PK4(E1, 8, pa3); } while (0)
#define PSTEP(t_, X0, X1, ROKX, ACTX, ALX, Y0, Y1, ACTY, ALY) do { \
        if ((t_) + 1 < NT) { const int k1_ = KEY0((t_) + 1); DMA_K(k1_, ((t_) + 1) & 1); } \
        if ((t_) < NT) { const int k0_ = KEY0(t_); DMA_V(k0_, (t_) & 1); QK_TILE(t_, X0, X1, ROKX, ACTX); } else { ACTX = false; } \
        if ((t_) > 0 && ACTY) { bf16x8 pa0, pa1, pa2, pa3; FIN_SM(Y0, Y1, ALY); pv_tile(o, vb0 + (((t_) + 1) & 1) * SHM, pa0, pa1, pa2, pa3); } \
        if (ACTX) PART_SM(t_, X0, X1, ROKX, ALX); \
        VM_WAIT(); \
        __syncthreads(); } while (0)
    if (NT <= 0) return;
    { if (!PRE) { const int k0 = KEY0(0); DMA_K(k0, 0); } VM_WAIT(); }
    __syncthreads();
    f32x16 eA0, eA1, eB0, eB1; bool rokA = true, actA = false, rokB = true, actB = false; float alA = 1.f, alB = 1.f;
#pragma unroll
    for (int r = 0; r < 16; ++r) { eA0[r] = 0.f; eA1[r] = 0.f; eB0[r] = 0.f; eB1[r] = 0.f; }
#pragma unroll 1
    for (int t = 0; t <= NT; t += 2) {
        PSTEP(t, eA0, eA1, rokA, actA, alA, eB0, eB1, actB, alB);
        if (t + 1 <= NT) PSTEP(t + 1, eB0, eB1, rokB, actB, alB, eA0, eA1, actA, alA);
    }
#undef PART_SM
#undef FIN_SM
#undef PSTEP
#undef QK_TILE
#undef PK4
#undef DMA_V
#undef DMA_K
#undef KEY0
}
__device__ __forceinline__ void scale_rows(f32x16 (&o)[4], float fac) {
#pragma unroll
    for (int d0 = 0; d0 < 4; ++d0)
#pragma unroll
        for (int r = 0; r < 16; ++r) o[d0][r] *= fac;
}
#define ATT_STORE_O(ROWPTR) do { bf16_t* op_ = (ROWPTR) + (hi ? 8 : 0); \
    _Pragma("unroll") for (int d0 = 0; d0 < 4; ++d0) { \
        _Pragma("unroll") for (int rg = 0; rg < 4; rg += 2) { \
            unsigned ax = cvtpk(o[d0][4 * rg + 0], o[d0][4 * rg + 1]), ay = cvtpk(o[d0][4 * rg + 2], o[d0][4 * rg + 3]); \
            unsigned bx = cvtpk(o[d0][4 * rg + 4], o[d0][4 * rg + 5]), by = cvtpk(o[d0][4 * rg + 6], o[d0][4 * rg + 7]); \
            { auto rr = __builtin_amdgcn_permlane32_swap(ax, bx, false, false); ax = rr[0]; bx = rr[1]; } \
            { auto rr = __builtin_amdgcn_permlane32_swap(ay, by, false, false); ay = rr[0]; by = rr[1]; } \
            u32x4 w_ = {ax, ay, bx, by}; *(GAS u32x4*)(op_ + d0 * 32 + rg * 8) = w_; } } } while (0)
}

__device__ __forceinline__ void phase_xattn(Frame& F, int L) {
    unsigned char* const wsl = optr(F.ws);
    const bf16_t* QX = (const bf16_t*)(wsl + WS_QX); const bf16_t* KVM = (const bf16_t*)(wsl + WS_KVMEM) + (size_t)L * MMEM * 2 * XAW; bf16_t* OX = (bf16_t*)(wsl + WS_OX);
    for (int u = F.bid; u < BATCH * 4 * (SEQ / 256); u += F.G) {
        const int tid = otid(), lane = tid & 63, r32 = lane & 31, hi = lane >> 5, wave = __builtin_amdgcn_readfirstlane(tid >> 6);
        const int qb = u % (SEQ / 256), hd = (u / (SEQ / 256)) & 3, b = u / (4 * (SEQ / 256));
        const int t = qb * 256 + wave * 32 + r32; const size_t row = (size_t)b * SEQ + t;
        bf16x8 qr[8];
#pragma unroll
        for (int d0 = 0; d0 < 8; ++d0) qr[d0] = *(const GAS bf16x8*)(QX + row * XAW + hd * HD + d0 * 16 + hi * 8);
        const bf16_t* Kp = KVM + (size_t)b * MEMLEN * 2 * XAW + hd * HD; const bf16_t* Vp = Kp + XAW;
        f32x16 o[4];
#pragma unroll
        for (int d0 = 0; d0 < 4; ++d0)
#pragma unroll
            for (int r = 0; r < 16; ++r) o[d0][r] = 0.f;
        float m = -1e30f, l = 0.f;
        att::attn_online<3, false, 2 * XAW>(F.lds, Kp, Vp, MEMLEN / 64, 0, qr, m, l, o, 0, 300, 0.f, 0, F.wv);
        att::scale_rows(o, l > 0.f ? 1.0f / l : 0.f);
        ATT_STORE_O(OX + ((size_t)b * SEQ + qb * 256 + wave * 32 + r32) * XAW + hd * HD);
    }
}

#ifndef TP_NSA_SEC
#define TP_NSA_SEC 0
#endif
__device__ __forceinline__ void phase_nsa(Frame& F, unsigned long long& tp_acc, const Args& A) {
    unsigned char* const wsl = optr(F.ws);
    unsigned long long tp_s = 0ull;
#define NSEC_B(k) do { if (TP_NSA_SEC == (k)) tp_s = __builtin_amdgcn_s_memrealtime(); } while (0)
#define NSEC_E(k) do { if (TP_NSA_SEC == (k)) tp_acc += __builtin_amdgcn_s_memrealtime() - tp_s; } while (0)
    const bf16_t* NQ = (const bf16_t*)(wsl + WS_NQ); const bf16_t* NKV = (const bf16_t*)(wsl + WS_NKV); const bf16_t* KVC = (const bf16_t*)(wsl + WS_KVC);
    const float* GT = (const float*)(wsl + WS_GATES); bf16_t* NO = (bf16_t*)(wsl + WS_NO);
    LAS unsigned char* lds = F.lds;
    LAS float* SG = (LAS float*)(lds + att::SG_OFF); LAS float* SL = (LAS float*)(lds + att::SL_OFF);
    LAS unsigned* SELW = (LAS unsigned*)(lds + att::SELW_OFF); LAS int* TL = (LAS int*)(lds + att::TL_OFF); LAS unsigned* WUN = (LAS unsigned*)(lds + att::WUN_OFF);
    constexpr int NQB = SEQ / 32, NUNITS = BATCH * NSA_G * NQB;
    bf16x8 qr[8];
#define NSA_SEAM(u_) do { const int tid_ = otid(), ln_ = tid_ & 63, wv_ = __builtin_amdgcn_readfirstlane(tid_ >> 6); \
        const int qb_ = NQB - 1 - (u_) / (BATCH * NSA_G), bg_ = (u_) % (BATCH * NSA_G), b_ = bg_ >> 2, g_ = bg_ & 3, t0_ = qb_ * 32; \
        const size_t row_ = (size_t)b_ * SEQ + t0_ + 4 * wv_ + ((ln_ & 31) >> 3); const int head_ = g_ * 8 + (ln_ & 7); \
        _Pragma("unroll") for (int d0 = 0; d0 < 8; ++d0) qr[d0] = *(const GAS bf16x8*)(NQ + row_ * QW + head_ * HD + d0 * 16 + (ln_ >> 5) * 8); \
        att::prefetch_k0(lds, NKV + ((size_t)((((2 * 2 + 0) * 2 + b_) * 4 + g_)) * SEQ) * HD, ((t0_ - 511 > 0 ? t0_ - 511 : 0) >> 6) * 64, F.wv); } while (0)
    LAS int* NXT = (LAS int*)(lds + att::TL_OFF + 600);
    unsigned* qctr = F.ctl + 1024;
    if (F.bid < NUNITS) NSA_SEAM(F.bid);
    constexpr int CV_NGU = (DM / 64) * (DFF2 / 64), CV_NDN = TAILFILL ? 0 : (DFF / 64) * (DM / 64), CV_NNO = (QW / 64) * (DM / 64), CV_NXQ = (DM / 64) * (XAW / 64), CV_NXO = (XAW / 64) * (DM / 64);
    constexpr int CV_E1 = CV_NGU + CV_NDN, CV_E2 = CV_E1 + CV_NNO, CV_E3 = CV_E2 + CV_NXQ, CV_ALL = CV_E3 + CV_NXO;
    int cv_it = DEFER_CONV ? F.bid * NWAVES + F.wv : CV_ALL;
#define NSA_CONV(maxn_) do { LAS unsigned* scr_ = (LAS unsigned*)(lds + F.wv * 8448); const int ln_c = otid() & 63; \
        _Pragma("unroll 1") for (int c_ = 0; c_ < (maxn_) && cv_it < CV_ALL; ++c_, cv_it += F.G * NWAVES) { \
            if (cv_it < CV_NGU) p0_transpose_item<1>(A.in[IN_FFN_WGU] + (size_t)DM * DFF2, DM, DFF2, (bf16_t*)(wsl + WS_WGU + (size_t)DFF2 * DM * 2), A.in[IN_LN_FFN] + (size_t)2 * DM, scr_, cv_it, ln_c); \
            else if (cv_it < CV_E1) p0_transpose_item<0>(A.in[IN_FFN_WDN] + (size_t)DFF * DM, DFF, DM, (bf16_t*)(wsl + WS_WDN + (size_t)DM * DFF * 2), nullptr, scr_, cv_it - CV_NGU, ln_c); \
            else if (cv_it < CV_E2) p0_transpose_item<0>(A.in[IN_NSA_W_OUT], QW, DM, (bf16_t*)(wsl + WS_NSAOUT), nullptr, scr_, cv_it - CV_E1, ln_c); \
            else if (cv_it < CV_E3) p0_transpose_item<0>(A.in[IN_XA_WQ] + (size_t)DM * XAW, DM, XAW, (bf16_t*)(wsl + WS_XAQ + (size_t)XAW * DM * 2), A.in[IN_LN_XA] + (size_t)2 * DM, scr_, cv_it - CV_E2, ln_c); \
            else p0_transpose_item<0>(A.in[IN_XA_WO] + (size_t)XAW * DM, XAW, DM, (bf16_t*)(wsl + WS_XAO + (size_t)DM * XAW * 2), nullptr, scr_, cv_it - CV_E3, ln_c); } } while (0)
    int it_ = 0;
    for (int u = F.bid; u < NUNITS; ) {
        const int tid = otid(), lane = tid & 63, r32 = lane & 31, hi = lane >> 5, wave = __builtin_amdgcn_readfirstlane(tid >> 6);
        if (tid == 0) NXT[it_ & 1] = F.G + (int)__hip_atomic_fetch_add(qctr, 1u, __ATOMIC_RELAXED, __HIP_MEMORY_SCOPE_AGENT);
        const int qb = NQB - 1 - u / (BATCH * NSA_G), bg = u % (BATCH * NSA_G), b = bg >> 2, g = bg & 3;
        const int t0 = qb * 32, tokl = 4 * wave + (r32 >> 3), j = r32 & 7, t = t0 + tokl, head = g * 8 + j;
        const float sl2 = __builtin_amdgcn_exp2f(-0.25f * (float)(head + 1)) * LOG2E;
        f32x16 o[4];
#pragma unroll
        for (int d0 = 0; d0 < 4; ++d0)
#pragma unroll
            for (int r = 0; r < 16; ++r) o[d0][r] = 0.f;
        const int tw0 = t0 + 4 * wave;
        NSEC_B(1);
        { const int jlo = (t0 - 511 > 0 ? t0 - 511 : 0) >> 6, jhi = (t0 + 31) >> 6, NTw = jhi - jlo + 1;
          const bf16_t* Kw = NKV + ((size_t)((((2 * 2 + 0) * 2 + b) * 4 + g)) * SEQ) * HD; const bf16_t* Vw = NKV + ((size_t)((((2 * 2 + 1) * 2 + b) * 4 + g)) * SEQ) * HD;
          float m = -1e30f, l = 0.f;
          att::attn_online<3, true>(lds, Kw, Vw, NTw, jlo * 64, qr, m, l, o, t, tw0, sl2, tokl, F.wv);
          att::prefetch_k(lds, KVC + (size_t)(bg * 512) * HD, 0, 0, F.wv);
          int tg_g_w = t; asm volatile("" : "+v"(tg_g_w)); const float g_w = *(const GAS float*)(GT + ((size_t)b * SEQ + tg_g_w) * GW_ + 64 + head); att::scale_rows(o, l > 0.f ? g_w / l : 0.f); }
        NSEC_E(1); NSEC_B(2);
        { const bf16_t* Kc = KVC + (size_t)(bg * 512) * HD; const bf16_t* Vc = KVC + (size_t)(4096 + bg * 512) * HD;
          const int NTc = t0 / 1024 + 1; float m = -1e30f, l = 0.f; int tg_g_c = t; asm volatile("" : "+v"(tg_g_c)); const float g_c = *(const GAS float*)(GT + ((size_t)b * SEQ + tg_g_c) * GW_ + head);
          const int p2 = NTc & 1;
          att::prefetch_v(lds, Vc, 0, p2, F.wv);
          att::attn_pass<1, 1, true, true>(lds, Kc, Vc, HD, NTc, 0, qr, m, l, g_c, 0.f, o, t, sl2, tokl, F.wv, 0);
          const float invl = l > 0.f ? 1.0f / l : 0.f;
          att::attn_pass<1, 2, true>(lds, Kc, Vc, HD, NTc, 0, qr, m, l, g_c, invl, o, t, sl2, tokl, F.wv, p2); }
        att::prefetch_k0(lds, NKV + ((size_t)((((1 * 2 + 0) * 2 + b) * 4 + g)) * SEQ) * HD, 0, F.wv);
        NSEC_E(2); NSEC_B(3);
        {
            unsigned wsel[4][4];
#pragma unroll
            for (int i4 = 0; i4 < 4; ++i4) {
                const int tk = 4 * wave + i4, cur = (t0 + tk) >> 6, n0 = lane, n1 = lane + 64;
                const int nlim = 16 * (t0 / 1024 + 1);
#define SGSLOT(n_) (((n_) & ~15) | (((((n_) >> 3) & 1) * 2 + ((n_) & 1)) << 2) | (((n_) >> 1) & 3))
                const float s0 = (n0 < nlim ? SG[tk * 128 + SGSLOT(n0)] : 0.f) + ((n0 > 0 && n0 <= nlim) ? SL[tk * 128 + SGSLOT(n0 - 1)] : 0.f), s1 = (n1 < nlim ? SG[tk * 128 + SGSLOT(n1)] : 0.f) + (n1 <= nlim ? SL[tk * 128 + SGSLOT(n1 - 1)] : 0.f);
#undef SGSLOT
                const float v0 = (n0 == 0 || n0 == cur || n0 == cur - 1) ? 1e6f : fmaxf(s0, 0.f), v1 = (n1 == cur || n1 == cur - 1) ? 1e6f : fmaxf(s1, 0.f);
                const unsigned k0 = n0 > cur ? 0u : __float_as_uint(v0) + 1u, k1 = n1 > cur ? 0u : __float_as_uint(v1) + 1u;
                unsigned T = 0u;
#pragma unroll
                for (int bit = 30; bit >= 0; --bit) { const unsigned cand = T | (1u << bit);
                    const int cnt = __builtin_popcountll(__ballot(k0 >= cand)) + __builtin_popcountll(__ballot(k1 >= cand));
                    T = cnt >= 16 ? cand : T; }
                unsigned long long g0 = __ballot(k0 > T), g1 = __ballot(k1 > T);
                unsigned long long q0 = T ? __ballot(k0 == T) : 0ull, q1 = T ? __ballot(k1 == T) : 0ull;
                int need = 16 - __builtin_popcountll(g0) - __builtin_popcountll(g1);
                while (need > 0 && q0) { const unsigned long long lb = q0 & (0ull - q0); g0 |= lb; q0 ^= lb; --need; }
                while (need > 0 && q1) { const unsigned long long lb = q1 & (0ull - q1); g1 |= lb; q1 ^= lb; --need; }
                wsel[i4][0] = (unsigned)g0; wsel[i4][1] = (unsigned)(g0 >> 32); wsel[i4][2] = (unsigned)g1; wsel[i4][3] = (unsigned)(g1 >> 32);
            }
            if (lane == 0) {
#pragma unroll
                for (int i4 = 0; i4 < 4; ++i4) { const int tk = 4 * wave + i4; SELW[tk * 4 + 0] = wsel[i4][0]; SELW[tk * 4 + 1] = wsel[i4][1]; SELW[tk * 4 + 2] = wsel[i4][2]; SELW[tk * 4 + 3] = wsel[i4][3]; }
#pragma unroll
                for (int q = 0; q < 4; ++q) WUN[wave * 4 + q] = wsel[0][q] | wsel[1][q] | wsel[2][q] | wsel[3][q];
            }
        }
        asm volatile("s_waitcnt lgkmcnt(0)" ::: "memory"); __builtin_amdgcn_s_barrier(); asm volatile("" ::: "memory");
        if (wave == 0) {
            unsigned u0 = 0u, u1 = 0u;
#pragma unroll
            for (int wv = 0; wv < 8; ++wv) { u0 |= (WUN[wv * 4 + (lane >> 5)] >> (lane & 31)) & 1u; u1 |= (WUN[wv * 4 + 2 + (lane >> 5)] >> (lane & 31)) & 1u; }
            const unsigned long long b0 = __ballot(u0 != 0u), b1 = __ballot(u1 != 0u), lt = (1ull << lane) - 1ull; const int c0 = __builtin_popcountll(b0);
            if (u0) TL[__builtin_popcountll(b0 & lt)] = lane;
            if (u1) TL[c0 + __builtin_popcountll(b1 & lt)] = 64 + lane;
            if (lane == 0) TL[128] = c0 + __builtin_popcountll(b1);
        }
        { const int ln_ = otid() & 63; u32x4* stash = (u32x4*)((float*)(wsl + WS_STASH) + ((size_t)(F.bid * NWAVES + wave) * 64) * 64) + ln_;
#pragma unroll
        for (int d0 = 0; d0 < 4; ++d0)
#pragma unroll
            for (int rp = 0; rp < 2; ++rp) { u32x4 w_; w_.x = cvtpk(o[d0][8 * rp], o[d0][8 * rp + 1]); w_.y = cvtpk(o[d0][8 * rp + 2], o[d0][8 * rp + 3]); w_.z = cvtpk(o[d0][8 * rp + 4], o[d0][8 * rp + 5]); w_.w = cvtpk(o[d0][8 * rp + 6], o[d0][8 * rp + 7]);
                *(GAS u32x4*)(stash + (d0 * 2 + rp) * 64) = w_;
#pragma unroll
                for (int r = 0; r < 8; ++r) o[d0][8 * rp + r] = 0.f; } }
        asm volatile("s_waitcnt lgkmcnt(0)" ::: "memory"); __builtin_amdgcn_s_barrier(); asm volatile("" ::: "memory");
        NSEC_E(3); NSEC_B(4);
        { const int NTs = TL[128]; if (TP_NSA_SEC == 9) tp_acc += (unsigned long long)NTs * 100ull; if (TP_NSA_SEC == 10) { const LAS unsigned* SW_ = (const LAS unsigned*)(lds + att::SELW_OFF); int na_ = 0; for (int i_ = 0; i_ < NTs; ++i_) { const int n_ = ((const LAS int*)(lds + att::TL_OFF))[i_]; unsigned any_ = 0u; for (int k_ = 0; k_ < 4; ++k_) any_ |= (SW_[(4 * wave + k_) * 4 + (n_ >> 5)] >> (n_ & 31)) & 1u; na_ += (int)any_; } tp_acc += (unsigned long long)na_ * 100ull; } const bf16_t* Ks = NKV + ((size_t)((((1 * 2 + 0) * 2 + b) * 4 + g)) * SEQ) * HD; const bf16_t* Vs = NKV + ((size_t)((((1 * 2 + 1) * 2 + b) * 4 + g)) * SEQ) * HD;
          float m = -1e30f, l = 0.f;
          att::attn_online<2, true>(lds, Ks, Vs, NTs, 0, qr, m, l, o, t, tw0, sl2, tokl, F.wv);
          int tg_g_s = t; asm volatile("" : "+v"(tg_g_s)); const float g_s = *(const GAS float*)(GT + ((size_t)b * SEQ + tg_g_s) * GW_ + 32 + head); att::scale_rows(o, l > 0.f ? g_s / l : 0.f); }
        NSEC_E(4);
        if (DEFER_CONV) { NSA_CONV(2); __syncthreads(); }
        const int un = __builtin_amdgcn_readfirstlane(NXT[it_ & 1]);
        if (un < NUNITS) NSA_SEAM(un);
        { const int ln_ = otid() & 63, r32 = ln_ & 31, hi = ln_ >> 5; const u32x4* stash = (const u32x4*)((const float*)(wsl + WS_STASH) + ((size_t)(F.bid * NWAVES + wave) * 64) * 64) + ln_;
#pragma unroll
        for (int d0 = 0; d0 < 4; ++d0)
#pragma unroll
            for (int rp = 0; rp < 2; ++rp) { const u32x4 w_ = *(const GAS u32x4*)(stash + (d0 * 2 + rp) * 64);
                o[d0][8 * rp + 0] += __uint_as_float(w_.x << 16); o[d0][8 * rp + 1] += __uint_as_float(w_.x & 0xffff0000u); o[d0][8 * rp + 2] += __uint_as_float(w_.y << 16); o[d0][8 * rp + 3] += __uint_as_float(w_.y & 0xffff0000u);
                o[d0][8 * rp + 4] += __uint_as_float(w_.z << 16); o[d0][8 * rp + 5] += __uint_as_float(w_.z & 0xffff0000u); o[d0][8 * rp + 6] += __uint_as_float(w_.w << 16); o[d0][8 * rp + 7] += __uint_as_float(w_.w & 0xffff0000u); }
        ATT_STORE_O(NO + ((size_t)b * SEQ + t0 + 4 * wave + (r32 >> 3)) * QW + (g * 8 + (r32 & 7)) * HD); }
        u = un; ++it_;
    }
    if (DEFER_CONV) { __syncthreads(); NSA_CONV(1 << 30); }
#undef NSA_CONV
}

constexpr int NPH = 30;
#ifndef HALFM
#define HALFM 1
#endif
__global__ void __launch_bounds__(NTHR, 2) mk_fwd(Args args) {
    extern __shared__ __attribute__((aligned(16))) unsigned char lds_raw[];
    Frame F;
    F.lds = (LAS unsigned char*)lds_raw;
    F.MISC = (volatile LAS unsigned*)(F.lds + MISC_OFF);
    F.wv = __builtin_amdgcn_readfirstlane((int)threadIdx.x >> 6);
    F.G = gridDim.x; F.bid = blockIdx.x; F.ws = args.ws; F.out = args.out;
    F.ctl = (unsigned*)(args.ws + WS_CTL);
    for (int u = threadIdx.x; u < (LDS_BYTES - LDSCTL_OFF) / 4; u += NTHR) ((LAS unsigned*)(F.lds + LDSCTL_OFF))[u] = 0u;
    __syncthreads();
    const int lo = args.ph_lo, hi = args.ph_hi;
    XcdBarrier bar; bar.bar = F.ctl + CW_BAR; bar.x = 0; bar.st = nullptr;
    if (hi - lo > 1) bar = xcd_barrier_post(F.ctl + CW_BAR, F.MISC + 8);
#ifndef PH_MASK
#define PH_MASK 0xffffffffu
#endif
#define EN(i) ((PH_MASK >> (i)) & 1u)
#ifndef REP_MASK
#define REP_MASK 0u
#endif
#define REPS(i) (1 + (int)((REP_MASK >> (i)) & 1u))
#define IN(k) (lo <= (k) && (k) < hi)
#ifndef TP_MODE
#define TP_MODE 0
#endif
#ifndef TP_AMP
#define TP_AMP 3
#endif
    unsigned long long tp_acc = 0ull, tp_t0 = 0ull;
#ifndef TP_MASK
#define TP_MASK 0u
#endif
#define TPS(i) ((TP_MASK >> (i)) & 1u)
#define TP_BEGIN(mode) do { if (TP_MODE == (mode)) tp_t0 = __builtin_amdgcn_s_memrealtime(); } while (0)
#define TP_END(mode) do { if (TP_MODE == (mode)) tp_acc += __builtin_amdgcn_s_memrealtime() - tp_t0; } while (0)
#define HN ((bf16_t*)(ws + WS_HN))
#define Yb ((bf16_t*)(ws + WS_Y))
#define SSP ((float*)(ws + WS_SSP))
#define SEAM(k) do { if ((k) + 1 < hi) { TP_BEGIN(1); xcd_barrier(bar); TP_END(1); } } while (0)
    unsigned char* const ws_k = args.ws;

    if (EN(0) && IN(0)) { if (TPS(0)) tp_t0 = __builtin_amdgcn_s_memrealtime(); for (int rep_ = 0; rep_ < REPS(0); ++rep_) { phase_p0(F, args); } if (TPS(0)) tp_acc += __builtin_amdgcn_s_memrealtime() - tp_t0; SEAM(0); }
    if (EN(1) && IN(1)) { if (TPS(1)) tp_t0 = __builtin_amdgcn_s_memrealtime();
        _Pragma("unroll 1") for (int rep_ = 0; rep_ < REPS(1); ++rep_) { unsigned char* const ws = optr(ws_k);
        phase_poolprep(F, args);
        }
        if (TPS(1)) tp_acc += __builtin_amdgcn_s_memrealtime() - tp_t0;
        SEAM(1);
    }
#pragma unroll 1
    for (int L = 0; L < 2; ++L) {
        const int pb = 2 + 14 * L;
        const float* ln_mix = args.in[IN_LN_MIX] + (size_t)L * 2 * DM; const float* ln_xa = args.in[IN_LN_XA] + (size_t)L * 2 * DM; const float* ln_ffn = args.in[IN_LN_FFN] + (size_t)L * 2 * DM;
        if (L == 0) {
            if (EN(2) && IN(pb)) { if (TPS(2)) tp_t0 = __builtin_amdgcn_s_memrealtime();
                _Pragma("unroll 1") for (int rep_ = 0; rep_ < REPS(2); ++rep_) { unsigned char* const ws = optr(ws_k);
                pg8::Gemm g{HN, (const bf16_t*)(ws + WS_POOLW), DM, PGC, 4, (size_t)PGC}; pg8::PanelOrder S; S.init(F.G, F.bid);
                pg8::EpiY E{Yb, DM, args.in[IN_POOL_SCALE], SSP, 64};
                pg8::gemm_phase<pg8::EpiY, pg8::PanelOrder>(F.lds, g, S, E, F.wv);
                }
                if (TPS(2)) tp_acc += __builtin_amdgcn_s_memrealtime() - tp_t0;
                SEAM(pb);
            }
        } else {
            if (EN(3) && IN(pb)) { if (TPS(3)) tp_t0 = __builtin_amdgcn_s_memrealtime();
                _Pragma("unroll 1") for (int rep_ = 0; rep_ < REPS(3); ++rep_) { unsigned char* const ws = optr(ws_k);
                pg8::Gemm g{HN, (const bf16_t*)(ws + WS_NSAIN), DM, DM, 0, 0}; pg8::StaticOrder S; S.init(MTOK, QW + KVW, F.G, F.bid);
                pg8::EpiNsaIn E{(bf16_t*)(ws + WS_NQ), (bf16_t*)(ws + WS_NKV), (const float*)(ws + WS_RS)};
                pg8::gemm_phase<pg8::EpiNsaIn>(F.lds, g, S, E, F.wv);
                }
                if (TPS(3)) tp_acc += __builtin_amdgcn_s_memrealtime() - tp_t0;
                SEAM(pb);
            }
            if (EN(4) && IN(pb + 1)) { if (TPS(4)) tp_t0 = __builtin_amdgcn_s_memrealtime();
                _Pragma("unroll 1") for (int rep_ = 0; rep_ < REPS(4); ++rep_) { unsigned char* const ws = optr(ws_k);
#if HALFM
                if (F.G >= 256) {
                    pg8::Gemm g{(const bf16_t*)(ws + WS_NKV), (const bf16_t*)(ws + WS_CMPW1), 2048, 4096, 2, (size_t)8 * SEQ * HD}; pg8::HalfOrder S; S.init(4096, 2 * CMP_HID, F.bid);
                    pg8::EpiGeluT<true> E{(bf16_t*)(ws + WS_HID), CMP_HID, (const float*)(ws + WS_CMPB), CMP_HID, (size_t)4096 * CMP_HID};
                    pg8::gemm_phase<pg8::EpiGeluT<true>, pg8::HalfOrder, true, true, true>(F.lds, g, S, E, F.wv);
                    pg8::Gemm g2{HN, (const bf16_t*)(ws + WS_NSAIN) + (size_t)(QW + KVW) * DM, DM, DM, 0, 0}; pg8::HalfOrder S2; S2.init(MTOK, 256, F.bid - 128);
                    pg8::EpiGatesT<true> E2{(float*)(ws + WS_GATES), (const float*)(ws + WS_RS)};
                    pg8::gemm_phase<pg8::EpiGatesT<true>, pg8::HalfOrder, true, true, true>(F.lds, g2, S2, E2, F.wv);
                } else
#endif
                {
                pg8::Gemm g{(const bf16_t*)(ws + WS_NKV), (const bf16_t*)(ws + WS_CMPW1), 2048, 4096, 2, (size_t)8 * SEQ * HD}; pg8::StaticOrder S; S.init(4096, 2 * CMP_HID, F.G, F.bid);
                pg8::EpiGelu E{(bf16_t*)(ws + WS_HID), CMP_HID, (const float*)(ws + WS_CMPB), CMP_HID, (size_t)4096 * CMP_HID};
                pg8::gemm_phase<pg8::EpiGelu>(F.lds, g, S, E, F.wv);
                }
                if (F.bid >= 64 && (!HALFM || F.G < 256)) {
                    pg8::Gemm g2{HN, (const bf16_t*)(ws + WS_NSAIN) + (size_t)(QW + KVW) * DM, DM, DM, 0, 0}; pg8::StaticOrder S2; S2.init(MTOK, 256, F.G, F.bid - 64);
                    pg8::EpiGates E2{(float*)(ws + WS_GATES), (const float*)(ws + WS_RS)};
                    pg8::gemm_phase<pg8::EpiGates>(F.lds, g2, S2, E2, F.wv);
                }
                }
                if (TPS(4)) tp_acc += __builtin_amdgcn_s_memrealtime() - tp_t0;
                SEAM(pb + 1);
            }
            if (EN(5) && IN(pb + 2)) { if (TPS(5)) tp_t0 = __builtin_amdgcn_s_memrealtime(); _Pragma("unroll 1") for (int rep_ = 0; rep_ < REPS(5); ++rep_) { unsigned char* const ws = optr(ws_k);
                pg8::Gemm g{(const bf16_t*)(ws + WS_HID), (const bf16_t*)(ws + WS_CMPW2), CMP_HID, CMP_HID, 1, (size_t)4096 * CMP_HID}; pg8::StaticOrder S; S.init(4096, 512, F.G, F.bid);
                pg8::EpiKvc E{(bf16_t*)(ws + WS_KVC)};
                pg8::gemm_phase<pg8::EpiKvc>(F.lds, g, S, E, F.wv); } if (TPS(5)) tp_acc += __builtin_amdgcn_s_memrealtime() - tp_t0; SEAM(pb + 2); }
            if (EN(6) && IN(pb + 3)) { if (TPS(6)) tp_t0 = __builtin_amdgcn_s_memrealtime(); for (int rep_ = 0; rep_ < REPS(6); ++rep_) { phase_nsa(F, tp_acc, args); } if (TPS(6)) tp_acc += __builtin_amdgcn_s_memrealtime() - tp_t0; SEAM(pb + 3); }
            if (EN(7) && IN(pb + 4)) { if (TPS(7)) tp_t0 = __builtin_amdgcn_s_memrealtime();
                _Pragma("unroll 1") for (int rep_ = 0; rep_ < REPS(7); ++rep_) { unsigned char* const ws = optr(ws_k);
                pg8::Gemm g{(const bf16_t*)(ws + WS_NO), (const bf16_t*)(ws + WS_NSAOUT), QW, QW, 0, 0}; pg8::PanelOrder S; S.init(F.G, F.bid);
                pg8::EpiY E{Yb, DM, nullptr, SSP, 64};
                pg8::gemm_phase<pg8::EpiY, pg8::PanelOrder>(F.lds, g, S, E, F.wv);
                }
                if (TPS(7)) tp_acc += __builtin_amdgcn_s_memrealtime() - tp_t0;
                SEAM(pb + 4);
            }
        }
        if (EN(8) && IN(pb + 5)) { if (TPS(8)) tp_t0 = __builtin_amdgcn_s_memrealtime(); for (int rep_ = 0; rep_ < REPS(8); ++rep_) { if (L == 0) phase_resid<true, false>(F, args.in[IN_X], ln_mix + DM); else phase_resid<false, false>(F, nullptr, ln_mix + DM); } if (TPS(8)) tp_acc += __builtin_amdgcn_s_memrealtime() - tp_t0; SEAM(pb + 5); }
        if (EN(9) && IN(pb + 6)) { if (TPS(9)) tp_t0 = __builtin_amdgcn_s_memrealtime();
            _Pragma("unroll 1") for (int rep_ = 0; rep_ < REPS(9); ++rep_) { unsigned char* const ws = optr(ws_k);
#if HALFM
            if (L == 1 && F.G >= 256) {
                pg8::Gemm g{HN, (const bf16_t*)(ws + WS_XAQ) + (size_t)L * XAW * DM, DM, DM, 0, 0}; pg8::HalfOrder S; S.init(MTOK, XAW, F.bid);
                pg8::EpiPlainT<true> E{(bf16_t*)(ws + WS_QX), XAW, 0, 0, (const float*)(ws + WS_RS)};
                pg8::gemm_phase<pg8::EpiPlainT<true>, pg8::HalfOrder, true, true, true>(F.lds, g, S, E, F.wv);
            } else
#endif
            {
            pg8::Gemm g{HN, (const bf16_t*)(ws + WS_XAQ) + (size_t)L * XAW * DM, DM, DM, 0, 0}; pg8::StaticOrder S; S.init(MTOK, XAW, F.G, F.bid);
            pg8::EpiPlain E{(bf16_t*)(ws + WS_QX), XAW, 0, 0, (const float*)(ws + WS_RS)};
            pg8::gemm_phase<pg8::EpiPlain>(F.lds, g, S, E, F.wv);
            }
            if (L == 0) {
                if (F.bid >= 128) {
                    pg8::Gemm g2{(const bf16_t*)(ws + WS_MEMN), (const bf16_t*)(ws + WS_XAKV), DM, DM, 0, 0}; pg8::StaticOrder S2; S2.init(MMEM, 2 * 2 * XAW, F.G, F.bid - 128);
                    pg8::EpiPlain E2{(bf16_t*)(ws + WS_KVMEM), 2 * XAW, 2 * XAW, (size_t)MMEM * 2 * XAW, nullptr};
                    pg8::gemm_phase<pg8::EpiPlain>(F.lds, g2, S2, E2, F.wv);
                }
                const int idx = (F.bid - 160) * NTHR + otid();
                if (idx >= 0 && idx < 2 * CMP_HID) { const float* part = (const float*)(ws + WS_CMPB + 65536); float sacc = args.in[IN_CMP_B1][idx];
                    for (int ks = 0; ks < 16; ++ks) sacc += part[((idx >> 9) * 16 + ks) * CMP_HID + (idx & 511)];
                    ((float*)(ws + WS_CMPB))[idx] = sacc; }
                if (XQFILL && F.G == 256 && F.bid >= 144) {
                    LAS unsigned* scr = (LAS unsigned*)(F.lds + F.wv * 8448); const int lane_ = otid() & 63;
                    _Pragma("unroll 1") for (int it = ((int)F.bid - 144) * NWAVES + F.wv; it < XQF_N; it += 112 * NWAVES)
                        p0_transpose_item<1>(args.in[IN_FFN_WGU], DM, DFF2, (bf16_t*)(ws + WS_WGU), args.in[IN_LN_FFN], scr, it, lane_); }
            }
            }
            if (TPS(9)) tp_acc += __builtin_amdgcn_s_memrealtime() - tp_t0;
            SEAM(pb + 6);
        }
        if (EN(10) && IN(pb + 7)) { if (TPS(10)) tp_t0 = __builtin_amdgcn_s_memrealtime(); for (int rep_ = 0; rep_ < REPS(10); ++rep_) { phase_xattn(F, L); } if (TPS(10)) tp_acc += __builtin_amdgcn_s_memrealtime() - tp_t0; SEAM(pb + 7); }
        if (EN(11) && IN(pb + 8)) { if (TPS(11)) tp_t0 = __builtin_amdgcn_s_memrealtime();
            _Pragma("unroll 1") for (int rep_ = 0; rep_ < REPS(11); ++rep_) { unsigned char* const ws = optr(ws_k);
            pg8::Gemm g{(const bf16_t*)(ws + WS_OX), (const bf16_t*)(ws + WS_XAO) + (size_t)L * DM * XAW, XAW, XAW, 0, 0}; pg8::PanelOrder S; S.init(F.G, F.bid);
            pg8::EpiY E{Yb, DM, nullptr, SSP, 64};
            pg8::gemm_phase<pg8::EpiY, pg8::PanelOrder>(F.lds, g, S, E, F.wv);
            }
            if (TPS(11)) tp_acc += __builtin_amdgcn_s_memrealtime() - tp_t0;
            SEAM(pb + 8);
        }
        if (EN(12) && IN(pb + 9)) { if (TPS(12)) tp_t0 = __builtin_amdgcn_s_memrealtime(); for (int rep_ = 0; rep_ < REPS(12); ++rep_) { phase_resid<false, false>(F, nullptr, ln_xa + DM); } if (TPS(12)) tp_acc += __builtin_amdgcn_s_memrealtime() - tp_t0; SEAM(pb + 9); }
        if (EN(13) && IN(pb + 10)) { if (TPS(13)) tp_t0 = __builtin_amdgcn_s_memrealtime();
            _Pragma("unroll 1") for (int rep_ = 0; rep_ < REPS(13); ++rep_) { unsigned char* const ws = optr(ws_k);
            pg8::Gemm g{HN, (const bf16_t*)(ws + WS_WGU) + (size_t)L * DFF2 * DM, DM, DM, 0, 0}; pg8::StaticOrder S; S.init(MTOK, DFF2, F.G, F.bid);
            pg8::EpiGateUp E{(bf16_t*)(ws + WS_ACT), args.in[IN_FFN_CONVW] + (size_t)L * 3 * DFF, args.in[IN_FFN_CONVB] + (size_t)L * DFF, (float*)(ws + WS_HALO), (float*)(ws + WS_EDGE), F.lds, (const float*)(ws + WS_RS)};
            pg8::gemm_phase<pg8::EpiGateUp>(F.lds, g, S, E, F.wv);
            if (TAILFILL) {
                const int nb0 = (F.G == 256) ? 128 : 0, nbk = F.G - nb0;
                if ((int)F.bid >= nb0) { LAS unsigned* scr = (LAS unsigned*)(F.lds + F.wv * 8448); const int lane_ = otid() & 63;
                    _Pragma("unroll 1") for (int it = ((int)F.bid - nb0) * NWAVES + F.wv; it < (DFF / 64) * (DM / 64); it += nbk * NWAVES)
                        p0_transpose_item<0>(args.in[IN_FFN_WDN] + (size_t)L * DFF * DM, DFF, DM, (bf16_t*)(ws + WS_WDN + (size_t)L * DM * DFF * 2), nullptr, scr, it, lane_); } }
            }
            if (TPS(13)) tp_acc += __builtin_amdgcn_s_memrealtime() - tp_t0;
            SEAM(pb + 10);
        }
        if (EN(14) && IN(pb + 11)) { if (TPS(14)) tp_t0 = __builtin_amdgcn_s_memrealtime(); for (int rep_ = 0; rep_ < REPS(14); ++rep_) { phase_actfix(F, args.in[IN_FFN_CONVW] + (size_t)L * 3 * DFF, args.in[IN_FFN_CONVB] + (size_t)L * DFF); } if (TPS(14)) tp_acc += __builtin_amdgcn_s_memrealtime() - tp_t0; SEAM(pb + 11); }
        if (EN(15) && IN(pb + 12)) { if (TPS(15)) tp_t0 = __builtin_amdgcn_s_memrealtime();
            _Pragma("unroll 1") for (int rep_ = 0; rep_ < REPS(15); ++rep_) { unsigned char* const ws = optr(ws_k);
            pg8::Gemm g{(const bf16_t*)(ws + WS_ACT), (const bf16_t*)(ws + WS_WDN) + (size_t)L * DM * DFF, DFF, DFF, 0, 0}; pg8::PanelOrder S; S.init(F.G, F.bid);
            pg8::EpiY E{Yb, DM, nullptr, SSP, 64};
            pg8::gemm_phase<pg8::EpiY, pg8::PanelOrder>(F.lds, g, S, E, F.wv);
            }
            if (TPS(15)) tp_acc += __builtin_amdgcn_s_memrealtime() - tp_t0;
            SEAM(pb + 12);
        }
        if (EN(16) && IN(pb + 13)) { if (TPS(16)) tp_t0 = __builtin_amdgcn_s_memrealtime(); for (int rep_ = 0; rep_ < REPS(16); ++rep_) { if (L == 0) phase_resid<false, false>(F, nullptr, ln_ffn + DM); else phase_resid<false, true>(F, nullptr, ln_ffn + DM); } if (TPS(16)) tp_acc += __builtin_amdgcn_s_memrealtime() - tp_t0; SEAM(pb + 13); }
    }
    if ((TP_MODE != 0 || TP_MASK != 0u || TP_NSA_SEC != 0) && blockIdx.x == 0) { const unsigned long long t1 = __builtin_amdgcn_s_memrealtime(); while (__builtin_amdgcn_s_memrealtime() - t1 < (unsigned long long)TP_AMP * tp_acc) __builtin_amdgcn_s_sleep(8); }
#undef HN
#undef Yb
#undef SSP
#undef IN
#undef EN
#undef SEAM
}

extern "C" void kernel_launch(void* const* d_in, const int* in_sizes, int n_in, void* d_out, int out_size, void* d_ws, size_t ws_size, hipStream_t stream) {
    static int grid = 0;
    if (grid == 0) {
        if (n_in != 21 || in_sizes[0] != MTOK * DM || out_size != MTOK * DM || ws_size < WS_END) {
            fprintf(stderr, "kernel_launch: unexpected shapes (n_in %d, in0 %d, out %d, ws %zu; need ws >= %zu); nothing launched\n", n_in, n_in > 0 ? in_sizes[0] : -1, out_size, ws_size, (size_t)WS_END); grid = -1; return; }
        int dev = 0, cus = 0, per_cu = 0;
        if (hipGetDevice(&dev) != hipSuccess || hipDeviceGetAttribute(&cus, hipDeviceAttributeMultiprocessorCount, dev) != hipSuccess) { fprintf(stderr, "kernel_launch: device query failed\n"); grid = -1; return; }
        if (hipFuncSetAttribute((const void*)mk_fwd, hipFuncAttributeMaxDynamicSharedMemorySize, LDS_BYTES) != hipSuccess) { fprintf(stderr, "kernel_launch: hipFuncSetAttribute failed\n"); grid = -1; return; }
        if (hipOccupancyMaxActiveBlocksPerMultiprocessor(&per_cu, (const void*)mk_fwd, NTHR, LDS_BYTES) != hipSuccess || per_cu < 1)
            fprintf(stderr, "kernel_launch: note: occupancy query reports %d workgroups per CU\n", per_cu);
        (void)hipGetLastError();
        grid = cus;
    }
    if (grid < 0) return;
    if (hipMemsetAsync((char*)d_ws + WS_CTL, 0, CTL_ZERO_BYTES, stream) != hipSuccess) { fprintf(stderr, "kernel_launch: memset failed\n"); return; }
    Args a{};
    for (int i = 0; i < 21; ++i) a.in[i] = (const float*)d_in[i];
    a.out = (float*)d_out; a.ws = (unsigned char*)d_ws;
#if MK_N_LAUNCHES == 1
    a.ph_lo = 0; a.ph_hi = NPH;
    hipLaunchKernelGGL(mk_fwd, dim3(grid), dim3(NTHR), LDS_BYTES, stream, a);
#else
    for (int ph = 0; ph < NPH; ++ph) {
        if (ph >= 3 && ph <= 6) continue;
        a.ph_lo = ph; a.ph_hi = ph + 1;
        hipLaunchKernelGGL(mk_fwd, dim3(grid), dim3(NTHR), LDS_BYTES, stream, a);
    }
#endif
    const hipError_t le = hipPeekAtLastError();
    if (le != hipSuccess) fprintf(stderr, "kernel_launch: launch failed: %s\n", hipGetErrorName(le));
}
```

```cpp
#include <hip/hip_runtime.h>
#include <cstdio>
#include <cstdint>

#ifndef MK_N_LAUNCHES
#define MK_N_LAUNCHES 1
#endif

#define GAS __attribute__((address_space(1)))
#define LAS __attribute__((address_space(3)))
typedef unsigned short bf16_t;
typedef short bf16x8 __attribute__((ext_vector_type(8)));
typedef short s16x4 __attribute__((ext_vector_type(4)));
typedef float f32x4 __attribute__((ext_vector_type(4)));
typedef float f32x2 __attribute__((ext_vector_type(2)));
typedef float f32x16 __attribute__((ext_vector_type(16)));
typedef unsigned u32x4 __attribute__((ext_vector_type(4)));
typedef unsigned u32x2 __attribute__((ext_vector_type(2)));

constexpr int NWAVES = 8, NTHR = 512;
constexpr int BATCH = 2, SEQ = 8192, DM = 4096, MTOK = BATCH * SEQ;
constexpr int MEMLEN = 256, MMEM = BATCH * MEMLEN;
constexpr int PGC = 1024;
constexpr int HD = 128, NSA_G = 4, NSA_J = 8;
constexpr int QW = 4096, KVW = 3072, GW_ = 96, NSA_INW = QW + KVW + GW_;
constexpr int NSA_INP = 7424;
constexpr int CMP_HID = 512, NCMP = 511, NSEL = 128;
constexpr int XAW = 512;
constexpr int DFF = 11008, DFF2 = 22016;
constexpr float RMS_EPS = 1e-6f;
constexpr float LOG2E = 1.4426950408889634f;
constexpr float QK_C2 = 1.4426950408889634f * 0.08838834764831845f;

constexpr size_t MiB = 1u << 20;
constexpr size_t WS_CTL = 0, CTL_ZERO_BYTES = 64 * 1024;
constexpr size_t WS_POOLW = 1 * MiB;
constexpr size_t WS_NSAIN = 9 * MiB;
constexpr size_t WS_NSAOUT = 67 * MiB;
constexpr size_t WS_CMPW1 = 99 * MiB;
constexpr size_t WS_CMPW2 = 107 * MiB;
constexpr size_t WS_XAQ = 108 * MiB;
constexpr size_t WS_XAKV = 116 * MiB;
constexpr size_t WS_XAO = 132 * MiB;
constexpr size_t WS_WGU = 140 * MiB;
constexpr size_t WS_WDN = 484 * MiB;
constexpr size_t WS_HN = 656 * MiB;
constexpr size_t WS_Y = 784 * MiB;
constexpr size_t WS_SSP = 912 * MiB;
constexpr size_t WS_XR = 916 * MiB;
constexpr size_t WS_RS = 916 * MiB + 256 * 1024;
constexpr size_t WS_CMPB = 916 * MiB + 512 * 1024;
constexpr size_t WS_MEMN = 917 * MiB;
constexpr size_t WS_KVMEM = 921 * MiB;
constexpr size_t WS_QX = 923 * MiB;
constexpr size_t WS_OX = 939 * MiB;
constexpr size_t WS_GU = 955 * MiB;
constexpr size_t WS_ACT = 1643 * MiB;
constexpr size_t WS_NQ = 1987 * MiB;
constexpr size_t WS_NKV = 2115 * MiB;
constexpr size_t WS_GATES = 2212 * MiB;
constexpr size_t WS_HID = 2218 * MiB;
constexpr size_t WS_KVC = 2226 * MiB;
constexpr size_t WS_NO = 2228 * MiB;
constexpr size_t WS_STASH = 2356 * MiB;
constexpr size_t WS_HALO = 2420 * MiB;
constexpr size_t WS_EDGE = 2426 * MiB;
constexpr size_t WS_END = 2438 * MiB;
constexpr int CW_BAR = 4096;

constexpr int RING_BYTES = 131072;
constexpr int LDSCTL_OFF = RING_BYTES, MISC_OFF = LDSCTL_OFF + 320;
constexpr int XCH_OFF = LDSCTL_OFF + 1024;
constexpr int LDS_BYTES = 147456;

#define LDS_WAIT() asm volatile("s_waitcnt lgkmcnt(0)" ::: "memory")
#define VM_WAIT() asm volatile("s_waitcnt vmcnt(0)" ::: "memory")
__device__ __forceinline__ unsigned cvtpk(float lo, float hi) { unsigned r; asm volatile("v_cvt_pk_bf16_f32 %0, %1, %2" : "=v"(r) : "v"(lo), "v"(hi)); return r; }
__device__ __forceinline__ float bflo(unsigned w) { return __uint_as_float(w << 16); }
__device__ __forceinline__ float bfhi(unsigned w) { return __uint_as_float(w & 0xffff0000u); }
__device__ __forceinline__ int otid_w(int wave_s) { int z; asm volatile("v_mov_b32 %0, 0" : "=v"(z)); const int l = __builtin_amdgcn_mbcnt_hi(~0u, __builtin_amdgcn_mbcnt_lo(~0u, z)); return wave_s * 64 + l; }
#define otid() otid_w(F.wv)
template <class T> __device__ __forceinline__ T* optr(T* p) { asm volatile("" : "+s"(p)); return p; }
#define DPPF0(v, ctrl) __int_as_float(__builtin_amdgcn_update_dpp(0, __float_as_int(v), (ctrl), 0xF, 0xF, true))
__device__ __forceinline__ float wave_sum(float v) {
    v += DPPF0(v, 0xB1); v += DPPF0(v, 0x4E); v += DPPF0(v, 0x141); v += DPPF0(v, 0x140);
    v += __int_as_float(__builtin_amdgcn_ds_swizzle(__float_as_int(v), 0x401F));
    { auto rr = __builtin_amdgcn_permlane32_swap(__float_as_uint(v), __float_as_uint(v), false, false); v = __uint_as_float(rr[0]) + __uint_as_float(rr[1]); }
    return v;
}
#define DPPF(v, ctrl) __int_as_float(__builtin_amdgcn_update_dpp(__float_as_int(v), __float_as_int(v), (ctrl), 0xF, 0xF, false))
__device__ __forceinline__ float wave_max(float v) {
    v = fmaxf(v, DPPF(v, 0xB1)); v = fmaxf(v, DPPF(v, 0x4E)); v = fmaxf(v, DPPF(v, 0x141)); v = fmaxf(v, DPPF(v, 0x140));
    v = fmaxf(v, DPPF(v, 0x142)); v = fmaxf(v, DPPF(v, 0x143));
    return __int_as_float(__builtin_amdgcn_readlane(__float_as_int(v), 63));
}
__device__ __forceinline__ float sigmoidf_(float x) { return __builtin_amdgcn_rcpf(1.0f + __builtin_amdgcn_exp2f(-x * LOG2E)); }
__device__ __forceinline__ float gelu_tanh(float x) { const float u = 0.7978845608028654f * (x + 0.044715f * x * x * x); return x * __builtin_amdgcn_rcpf(1.0f + __builtin_amdgcn_exp2f(-2.0f * LOG2E * u)); }

#define XB_TMO      128
#define XB_XCNT(j)  (256  + 64 * (j))
#define XB_XSUB(j)  (1280 + 64 * (j))
#define XB_XGEN(j)  (2304 + 64 * (j))
#define XB_TOP      3328
#define XB_TOPGEN   3392
#define XCD_BAR_WORDS 3456
#define XB_SPIN_CAP (1u << 18)
__device__ __forceinline__ unsigned xb_ld(unsigned* p)              { return __hip_atomic_load(p, __ATOMIC_RELAXED, __HIP_MEMORY_SCOPE_AGENT); }
__device__ __forceinline__ unsigned xb_add(unsigned* p, unsigned v) { return __hip_atomic_fetch_add(p, v, __ATOMIC_RELAXED, __HIP_MEMORY_SCOPE_AGENT); }
__device__ __forceinline__ unsigned xb_xcc_id() { return (unsigned)__builtin_amdgcn_s_getreg((3 << 11) | 20) & 0xFu; }
#define XB_SPIN(cond, bar) do { unsigned _sp = 0; while (cond) { __builtin_amdgcn_s_sleep(1); \
    if ((++_sp & 255u) == 0u) { if (xb_ld(&(bar)[XB_TMO])) break; if (_sp > XB_SPIN_CAP) { atomicAdd(&(bar)[XB_TMO], 1u); break; } } } } while (0)
struct XcdBarrier { unsigned* bar; unsigned x; volatile LAS unsigned* st; };
__device__ __forceinline__ XcdBarrier xcd_barrier_post(unsigned* bar, volatile LAS unsigned* st) {
    XcdBarrier b; b.bar = bar; b.x = xb_xcc_id(); b.st = st;
    if (threadIdx.x == 0) (void)xb_add(&bar[XB_XCNT(b.x)], 1u);
    return b;
}
__device__ __forceinline__ void xcd_barrier_complete(unsigned* bar, unsigned x, unsigned& nloc, unsigned& nx) {
    const unsigned G = gridDim.x * gridDim.y * gridDim.z;
    unsigned sum, cnt, mine, sp = 0u;
    for (;;) {
        sum = 0u; cnt = 0u; mine = 0u;
#pragma unroll 1
        for (unsigned j = 0; j < 16; ++j) { const unsigned c = xb_ld(&bar[XB_XCNT(j)]); sum += c; cnt += (c > 0u) ? 1u : 0u; mine = (j == x) ? c : mine; }
        if (sum == G) break;
        __builtin_amdgcn_s_sleep(1);
        if ((++sp & 255u) == 0u) { if (xb_ld(&bar[XB_TMO])) break; if (sp > XB_SPIN_CAP) { atomicAdd(&bar[XB_TMO], 1u); break; } }
    }
    nloc = mine > 0u ? mine : 1u; nx = cnt > 0u ? cnt : 1u;
}
__device__ __forceinline__ void xcd_barrier(const XcdBarrier& b) {
    asm volatile("s_waitcnt vmcnt(0)" ::: "memory");
    __syncthreads();
    if (threadIdx.x == 0) {
        unsigned* bar = b.bar;
        __builtin_amdgcn_s_waitcnt(0);
        unsigned nloc = b.st[0], nx = b.st[1];
        if (nloc == 0u) { xcd_barrier_complete(bar, b.x, nloc, nx); b.st[0] = nloc; b.st[1] = nx; }
        const unsigned old = xb_add(&bar[XB_XSUB(b.x)], 1u);
        const unsigned gen = old / nloc;
        if (old + 1u == (gen + 1u) * nloc) {
            __builtin_amdgcn_fence(__ATOMIC_RELEASE, "agent");
            asm volatile("s_waitcnt vmcnt(0)" ::: "memory");
            const unsigned og = xb_add(&bar[XB_TOP], 1u);
            const unsigned tg = og / nx;
            if (og + 1u == (tg + 1u) * nx) xb_add(&bar[XB_TOPGEN], 1u);
            else XB_SPIN(xb_ld(&bar[XB_TOPGEN]) == tg, bar);
            __builtin_amdgcn_fence(__ATOMIC_ACQUIRE, "agent");
            xb_add(&bar[XB_XGEN(b.x)], 1u);
            asm volatile("s_waitcnt vmcnt(0)" ::: "memory");
        } else {
            XB_SPIN(xb_ld(&bar[XB_XGEN(b.x)]) == gen, bar);
            __builtin_amdgcn_fence(__ATOMIC_ACQUIRE, "agent");
            asm volatile("s_waitcnt vmcnt(0)" ::: "memory");
        }
    }
    __syncthreads();
}

namespace pg8 {
constexpr int BM = 256, BK = 64, HALF = 128, HTB = HALF * BK * 2, STAGE_BYTES = 8 * HTB, NXCD = 8, WGM = 8;
__host__ __device__ __forceinline__ int lds_byte(int r, int c) { const int st = (r >> 4) * 2 + (c >> 5), rr = r & 15, cc = c & 31, ob = rr * 64 + cc * 2; return st * 1024 + (ob ^ (((ob >> 9) & 1) << 5)); }
__host__ __device__ __forceinline__ void stage_rc(int b, int& R, int& C) { const int st = b / 1024, sb = b % 1024, swz = sb ^ (((sb >> 9) & 1) << 5); R = (st >> 1) * 16 + swz / 64; C = (st & 1) * 32 + (swz % 64) / 2; }
__host__ __device__ __forceinline__ int perm32(int rho) { const int n = rho >> 4, i = rho & 15; return 8 * (i >> 2) + 4 * n + (i & 3); }

struct Unit { int pm, pn, hm; };
struct Gemm { const bf16_t* A; const bf16_t* Bt; int lda, K, npg; size_t a_gs; };

struct StaticOrder {
    int nM, nN, nwg, G, c;
    __device__ void init(int M, int N, int G_, int c_) { nM = M / BM; nN = N / BM; nwg = nM * nN; G = G_; c = c_; }
    __device__ bool next(int i, Unit& u) const {
        const long L = (long)i * G + c; if (L >= nwg) return false;
        int wgid = (int)L; { const int q = nwg / NXCD, r = nwg % NXCD, xcd = wgid % NXCD, off = wgid / NXCD; wgid = (xcd < r ? xcd * (q + 1) : r * (q + 1) + (xcd - r) * q) + off; }
        const int nig = WGM * nN, gid = wgid / nig, fm = gid * WGM, gsz = (nM - fm) < WGM ? (nM - fm) : WGM;
        u.pm = fm + ((wgid % nig) % gsz); u.pn = (wgid % nig) / gsz; u.hm = 0; return true;
    }
};

struct PanelOrder {
    int G, c;
    __device__ void init(int G_, int c_) { G = G_; c = c_; }
    __device__ bool next(int i, Unit& u) const {
        const long j = (long)i * G + c; if (j >= 1024) return false;
        const int r = (int)j >> 8, p = (int)j & 255, x = p & 7, k = p >> 3; u.pm = 16 * r + 4 * (x >> 1) + (k >> 3); u.pn = 8 * (x & 1) + (k & 7); u.hm = 0; return true;
    }
};
struct HalfOrder {
    int nM, nN, c;
    __device__ void init(int M, int N, int c_) { nM = M / BM; nN = N / BM; c = c_; }
    __device__ bool next(int i, Unit& u) const { if (i != 0 || c < 0 || c >= 2 * nM * nN) return false;
        const int x = c & 7, sl = c >> 3, t = sl >> 1; u.hm = sl & 1; u.pn = t % nN; u.pm = x * (nM >> 3) + t / nN; return true; }
};
template <class Epi, class Sched = StaticOrder, bool ALIGN_EPI = true, bool SP2 = true, bool HM = false>
__device__ __forceinline__ void gemm_phase(LAS unsigned char* lds, const Gemm g, const Sched& S, const Epi& E, int wave_s) {
    const int tid = otid_w(wave_s), wid = __builtin_amdgcn_readfirstlane(tid >> 6), lane = tid & 63, wr = wid >> 2, wc = wid & 3, fr = lane & 15, fq = lane >> 4;
    const int K = g.K, nt = K / BK, lda = g.lda;
    unsigned voffA[2], voffB[2];
#pragma unroll
    for (int i = 0; i < 2; ++i) { int R, C; stage_rc(tid * 16 + i * 8192, R, C); const int Rb = (R & ~31) + perm32(R & 31);
        voffA[i] = (unsigned)(R * lda + C) * 2u; voffB[i] = (unsigned)(Rb * K + C) * 2u; }
    const size_t kstep = (size_t)(BK * 2);
    const size_t hstepA = HM ? (size_t)0 : (size_t)HALF * lda * 2, hstepB = (size_t)HALF * K * 2;
    const unsigned ldsw = (unsigned)wid * 1024u;
    const int aoff = lds_byte(wr * 64 + fr, fq * 8), boff = lds_byte(wc * 32 + fr, fq * 8);
#define PG8_SA(b, h) (((b) * 2 + (h)) * HTB)
#define PG8_SB(b, h) ((4 + (b) * 2 + (h)) * HTB)
#define PG8_STAGE(bufoff, gbase, voff) do { _Pragma("unroll") for (int _i = 0; _i < 2; ++_i) \
        __builtin_amdgcn_global_load_lds((const unsigned*)((const char*)(gbase) + (voff)[_i]), (LAS unsigned*)(lds + (bufoff) + ldsw + _i * 8192), 16, 0, 0); } while (0)
#define PG8_LDA(dst, b, h) do { _Pragma("unroll") for (int m = 0; m < 4; ++m) _Pragma("unroll") for (int k = 0; k < 2; ++k) dst[m][k] = *(const LAS bf16x8*)(lds + PG8_SA(b, h) + aoff + m * 2048 + k * 1024); } while (0)
#define PG8_LDB(dst, b, h) do { _Pragma("unroll") for (int n = 0; n < 2; ++n) _Pragma("unroll") for (int k = 0; k < 2; ++k) dst[n][k] = *(const LAS bf16x8*)(lds + PG8_SB(b, h) + boff + n * 2048 + k * 1024); } while (0)
#define PG8_MMA(ai, bj, At, Bt) do { __builtin_amdgcn_s_setprio(1); _Pragma("unroll") for (int m = 0; m < 4; ++m) _Pragma("unroll") for (int n = 0; n < 2; ++n) _Pragma("unroll") for (int k = 0; k < 2; ++k) \
        acc[ai][bj][m][n] = __builtin_amdgcn_mfma_f32_16x16x32_bf16(Bt[n][k], At[m][k], acc[ai][bj][m][n], 0, 0, 0); __builtin_amdgcn_s_setprio(0); } while (0)
#define PG8_WAIT_V(n) asm volatile("s_waitcnt vmcnt(" #n ")" ::: "memory")
#define PG8_WAIT_L(n) asm volatile("s_waitcnt lgkmcnt(" #n ")" ::: "memory")
#define PG8_BAR __builtin_amdgcn_s_barrier()
#define PG8_SCHED __builtin_amdgcn_sched_barrier(0)
#define PG8_APTR(u) ((const char*)g.A + (((size_t)(u).pm * BM + (HM ? (size_t)(u).hm * HALF : (size_t)0)) * lda + (g.npg ? (size_t)((u).pn / g.npg) * g.a_gs : (size_t)0)) * 2)
#define PG8_BPTR(u) ((const char*)g.Bt + (size_t)(u).pn * BM * K * 2)
    Unit cur, nxt; int ui = 0;
    if (!S.next(0, cur)) return;
    f32x4 acc[2][2][4][2];
#pragma unroll
    for (int a = 0; a < 2; ++a)
#pragma unroll
        for (int b = 0; b < 2; ++b)
#pragma unroll
            for (int m = 0; m < 4; ++m)
#pragma unroll
                for (int n = 0; n < 2; ++n) acc[a][b][m][n] = (f32x4){0.f, 0.f, 0.f, 0.f};
    bf16x8 At[4][2], B0[2][2], B1[2][2];
    const char* cA = PG8_APTR(cur); const char* cB = PG8_BPTR(cur);
    if constexpr (SP2) {
        PG8_STAGE(PG8_SB(0, 0), cB, voffB); PG8_STAGE(PG8_SB(0, 1), cB + hstepB, voffB); PG8_STAGE(PG8_SA(0, 0), cA, voffA); PG8_STAGE(PG8_SA(0, 1), cA + hstepA, voffA);
        if (wr == 1) PG8_BAR;
        PG8_WAIT_V(2); PG8_BAR;
        PG8_STAGE(PG8_SB(1, 0), cB + kstep, voffB); PG8_STAGE(PG8_SA(1, 0), cA + kstep, voffA); PG8_STAGE(PG8_SB(1, 1), cB + hstepB + kstep, voffB);
        PG8_WAIT_V(6); PG8_BAR;
    } else {
        PG8_STAGE(PG8_SB(0, 0), cB, voffB); PG8_STAGE(PG8_SA(0, 0), cA, voffA); PG8_STAGE(PG8_SB(0, 1), cB + hstepB, voffB); PG8_STAGE(PG8_SA(0, 1), cA + hstepA, voffA);
        if (wr == 1) PG8_BAR;
        PG8_WAIT_V(4); PG8_BAR;
        PG8_STAGE(PG8_SB(1, 0), cB + kstep, voffB); PG8_STAGE(PG8_SA(1, 0), cA + kstep, voffA); PG8_STAGE(PG8_SB(1, 1), cB + hstepB + kstep, voffB);
        PG8_WAIT_V(6); PG8_BAR;
    }
    for (;;) {
        const bool has_next = S.next(ui + 1, nxt);
        const char* nA = has_next ? PG8_APTR(nxt) : cA; const char* nB = has_next ? PG8_BPTR(nxt) : cB;
        for (int t = 0; t < nt; t += 2) {
            const bool last = (t == nt - 2);
            const char* a1 = cA + (size_t)(t + 1) * kstep;
            const char* a2 = last ? nA : cA + (size_t)(t + 2) * kstep; const char* b2 = last ? nB : cB + (size_t)(t + 2) * kstep;
            const char* a3 = a2 + kstep; const char* b3 = b2 + kstep;
            if constexpr (SP2) {
            PG8_LDB(B0, 0, 0); PG8_LDB(B1, 0, 1); PG8_SCHED; PG8_LDA(At, 0, 0); PG8_STAGE(PG8_SA(1, 1), a1 + hstepA, voffA);
            PG8_WAIT_V(8); PG8_WAIT_L(0); PG8_BAR; PG8_MMA(0, 0, At, B0); PG8_MMA(0, 1, At, B1); PG8_BAR; PG8_SCHED;
            if constexpr (!HM) PG8_LDA(At, 0, 1); PG8_STAGE(PG8_SB(0, 0), b2, voffB); PG8_STAGE(PG8_SB(0, 1), b2 + hstepB, voffB); PG8_STAGE(PG8_SA(0, 0), a2, voffA);
            PG8_WAIT_V(8); PG8_WAIT_L(0); PG8_BAR; if constexpr (!HM) { PG8_MMA(1, 0, At, B0); PG8_MMA(1, 1, At, B1); } PG8_BAR; PG8_SCHED;
            PG8_LDB(B0, 1, 0); PG8_LDB(B1, 1, 1); PG8_SCHED; PG8_LDA(At, 1, 0); PG8_STAGE(PG8_SA(0, 1), a2 + hstepA, voffA);
            PG8_WAIT_V(8); PG8_WAIT_L(0); PG8_BAR; PG8_MMA(0, 0, At, B0); PG8_MMA(0, 1, At, B1); PG8_BAR; PG8_SCHED;
            if constexpr (!HM) PG8_LDA(At, 1, 1); PG8_STAGE(PG8_SB(1, 0), b3, voffB); PG8_STAGE(PG8_SB(1, 1), b3 + hstepB, voffB); PG8_STAGE(PG8_SA(1, 0), a3, voffA);
            PG8_WAIT_V(8); PG8_WAIT_L(0); PG8_BAR; if constexpr (!HM) { PG8_MMA(1, 0, At, B0); PG8_MMA(1, 1, At, B1); } PG8_BAR; PG8_SCHED;
            } else {
            PG8_LDB(B0, 0, 0); PG8_SCHED; PG8_LDA(At, 0, 0); PG8_STAGE(PG8_SA(1, 1), a1 + hstepA, voffA);
            PG8_WAIT_L(8); PG8_BAR; PG8_WAIT_L(0); PG8_MMA(0, 0, At, B0); PG8_BAR; PG8_SCHED;
            PG8_LDB(B1, 0, 1); PG8_STAGE(PG8_SB(0, 0), b2, voffB);
            PG8_BAR; PG8_WAIT_L(0); PG8_MMA(0, 1, At, B1); PG8_BAR;
            PG8_LDA(At, 0, 1); PG8_STAGE(PG8_SA(0, 0), a2, voffA);
            PG8_BAR; PG8_WAIT_L(0); PG8_MMA(1, 0, At, B0); PG8_BAR; PG8_SCHED;
            PG8_STAGE(PG8_SB(0, 1), b2 + hstepB, voffB);
            PG8_WAIT_V(6); PG8_BAR; PG8_MMA(1, 1, At, B1); PG8_BAR;
            PG8_LDB(B0, 1, 0); PG8_SCHED; PG8_LDA(At, 1, 0); PG8_STAGE(PG8_SA(0, 1), a2 + hstepA, voffA);
            PG8_WAIT_L(8); PG8_BAR; PG8_WAIT_L(0); PG8_MMA(0, 0, At, B0); PG8_BAR; PG8_SCHED;
            PG8_LDB(B1, 1, 1); PG8_STAGE(PG8_SB(1, 0), b3, voffB);
            PG8_BAR; PG8_WAIT_L(0); PG8_MMA(0, 1, At, B1); PG8_BAR;
            PG8_LDA(At, 1, 1); PG8_STAGE(PG8_SA(1, 0), a3, voffA);
            PG8_BAR; PG8_WAIT_L(0); PG8_MMA(1, 0, At, B0); PG8_BAR; PG8_SCHED;
            PG8_STAGE(PG8_SB(1, 1), b3 + hstepB, voffB);
            PG8_WAIT_V(6); PG8_BAR; PG8_MMA(1, 1, At, B1); PG8_BAR;
            }
        }
        if constexpr (ALIGN_EPI) { if (wr == 0) PG8_BAR; }
        E(acc, cur, wr, wc, fr, fq);
        if (!has_next) break;
#pragma unroll
        for (int a = 0; a < 2; ++a)
#pragma unroll
            for (int b = 0; b < 2; ++b)
#pragma unroll
                for (int m = 0; m < 4; ++m)
#pragma unroll
                    for (int n = 0; n < 2; ++n) acc[a][b][m][n] = (f32x4){0.f, 0.f, 0.f, 0.f};
        cur = nxt; cA = nA; cB = nB; ++ui;
        if constexpr (ALIGN_EPI) { if (wr == 1) PG8_BAR; }
    }
    PG8_WAIT_V(0);
    if constexpr (!ALIGN_EPI) { if (wr == 0) PG8_BAR; }
    PG8_BAR;
#undef PG8_SA
#undef PG8_SB
#undef PG8_STAGE
#undef PG8_LDA
#undef PG8_LDB
#undef PG8_MMA
#undef PG8_WAIT_V
#undef PG8_WAIT_L
#undef PG8_BAR
#undef PG8_SCHED
#undef PG8_APTR
#undef PG8_BPTR
}

__device__ __forceinline__ u32x4 pack8(const f32x4 a, const f32x4 b) { u32x4 w; w.x = cvtpk(a[0], a[1]); w.y = cvtpk(a[2], a[3]); w.z = cvtpk(b[0], b[1]); w.w = cvtpk(b[2], b[3]); return w; }

template <bool HM>
struct EpiPlainT {
    bf16_t* O; int ldc; int split_cols; size_t split_stride; const float* rowscale;
    __device__ __forceinline__ void operator()(const f32x4 (&acc)[2][2][4][2], const Unit& u, int wr, int wc, int fr, int fq) const {
        const int row0 = u.pm * BM + (HM ? u.hm * HALF : 0) + wr * 64 + fr, col0 = u.pn * BM + wc * 32 + 8 * fq;
        bf16_t* Ob = O; if (split_cols) { const int tsp = (u.pn * BM) / split_cols; Ob = O + (size_t)tsp * split_stride - (size_t)tsp * split_cols; }
#pragma unroll
        for (int ai = 0; ai < (HM ? 1 : 2); ++ai)
#pragma unroll
            for (int m = 0; m < 4; ++m) { const int row = row0 + ai * HALF + m * 16; bf16_t* rowp = Ob + (size_t)row * ldc + col0; const float rs = rowscale ? ((const GAS float*)rowscale)[row] : 1.0f;
#pragma unroll
                for (int bj = 0; bj < 2; ++bj) *(GAS u32x4*)(rowp + bj * HALF) = pack8(acc[ai][bj][m][0] * rs, acc[ai][bj][m][1] * rs); }
    }
};
using EpiPlain = EpiPlainT<false>;
template <bool HM>
struct EpiGeluT {
    bf16_t* O; int ldc; const float* bias; int split_cols; size_t split_stride;
    __device__ __forceinline__ void operator()(const f32x4 (&acc)[2][2][4][2], const Unit& u, int wr, int wc, int fr, int fq) const {
        const int row0 = u.pm * BM + (HM ? u.hm * HALF : 0) + wr * 64 + fr, col0 = u.pn * BM + wc * 32 + 8 * fq;
        const int tsp = (u.pn * BM) / split_cols; bf16_t* Ob = O + (size_t)tsp * split_stride - (size_t)tsp * split_cols;
        f32x4 bv[2][2];
#pragma unroll
        for (int bj = 0; bj < 2; ++bj)
#pragma unroll
            for (int n = 0; n < 2; ++n) bv[bj][n] = *(const GAS f32x4*)(bias + col0 + bj * HALF + 4 * n);
#pragma unroll
        for (int ai = 0; ai < (HM ? 1 : 2); ++ai)
#pragma unroll
            for (int m = 0; m < 4; ++m) { bf16_t* rowp = Ob + (size_t)(row0 + ai * HALF + m * 16) * ldc + col0;
#pragma unroll
                for (int bj = 0; bj < 2; ++bj) { f32x4 v0 = acc[ai][bj][m][0] + bv[bj][0], v1 = acc[ai][bj][m][1] + bv[bj][1];
#pragma unroll
                    for (int j = 0; j < 4; ++j) { v0[j] = gelu_tanh(v0[j]); v1[j] = gelu_tanh(v1[j]); }
                    *(GAS u32x4*)(rowp + bj * HALF) = pack8(v0, v1); } }
    }
};
using EpiGelu = EpiGeluT<false>;
struct EpiY {
    bf16_t* O; int ldc; const float* colscale; float* ssp; int nsp;
    __device__ __forceinline__ void operator()(const f32x4 (&acc)[2][2][4][2], const Unit& u, int wr, int wc, int fr, int fq) const {
        const int row0 = u.pm * BM + wr * 64 + fr, col0 = u.pn * BM + wc * 32 + 8 * fq;
        f32x4 sv[2][2];
#pragma unroll
        for (int bj = 0; bj < 2; ++bj)
#pragma unroll
            for (int n = 0; n < 2; ++n) sv[bj][n] = colscale ? *(const GAS f32x4*)(colscale + col0 + bj * HALF + 4 * n) : (f32x4){1.f, 1.f, 1.f, 1.f};
#pragma unroll
        for (int ai = 0; ai < 2; ++ai)
#pragma unroll
            for (int m = 0; m < 4; ++m) { const int row = row0 + ai * HALF + m * 16; bf16_t* rowp = O + (size_t)row * ldc + col0; float ss = 0.f;
#pragma unroll
                for (int bj = 0; bj < 2; ++bj) { const f32x4 v0 = acc[ai][bj][m][0] * sv[bj][0], v1 = acc[ai][bj][m][1] * sv[bj][1];
                    ss += (v0[0] * v0[0] + v0[1] * v0[1]) + (v0[2] * v0[2] + v0[3] * v0[3]) + (v1[0] * v1[0] + v1[1] * v1[1]) + (v1[2] * v1[2] + v1[3] * v1[3]);
                    *(GAS u32x4*)(rowp + bj * HALF) = pack8(v0, v1); }
                ss += __int_as_float(__builtin_amdgcn_ds_swizzle(__float_as_int(ss), 0x401F));
                { auto rr = __builtin_amdgcn_permlane32_swap(__float_as_uint(ss), __float_as_uint(ss), false, false); ss = __uint_as_float(rr[0]) + __uint_as_float(rr[1]); }
                if (fq == 0) ((GAS float*)ssp)[(size_t)row * nsp + u.pn * 4 + wc] = ss; }
    }
};
struct EpiNsaIn {
    bf16_t* Q; bf16_t* KV; const float* rowscale;
    __device__ __forceinline__ void operator()(const f32x4 (&acc)[2][2][4][2], const Unit& u, int wr, int wc, int fr, int fq) const {
        const int row0 = u.pm * BM + wr * 64 + fr, col0 = u.pn * BM + wc * 32 + 8 * fq;
#pragma unroll
        for (int ai = 0; ai < 2; ++ai)
#pragma unroll
            for (int m = 0; m < 4; ++m) { const int row = row0 + ai * HALF + m * 16; const float rs = ((const GAS float*)rowscale)[row];
#pragma unroll
                for (int bj = 0; bj < 2; ++bj) { const int col = col0 + bj * HALF; const f32x4 v0 = acc[ai][bj][m][0] * rs, v1 = acc[ai][bj][m][1] * rs;
                    if (u.pn < 16) { *(GAS u32x4*)(Q + (size_t)row * QW + col) = pack8(v0, v1); }
                    else { const int idx = col - QW, br = idx >> 10, rem = idx & 1023, kvs = rem >> 9, gg = (rem >> 7) & 3, dh = rem & 127, b = row >> 13, s = row & (SEQ - 1);
                        *(GAS u32x4*)(KV + ((size_t)((((br * 2 + kvs) * 2 + b) * 4 + gg)) * SEQ + s) * HD + dh) = pack8(v0, v1); }
                } }
    }
};
template <bool HM>
struct EpiGatesT {
    float* GT; const float* rowscale;
    __device__ __forceinline__ void operator()(const f32x4 (&acc)[2][2][4][2], const Unit& u, int wr, int wc, int fr, int fq) const {
        const int row0 = u.pm * BM + (HM ? u.hm * HALF : 0) + wr * 64 + fr, col0 = wc * 32 + 8 * fq;
        if (col0 >= GW_) return;
#pragma unroll
        for (int ai = 0; ai < (HM ? 1 : 2); ++ai)
#pragma unroll
            for (int m = 0; m < 4; ++m) { const int row = row0 + ai * HALF + m * 16; const float rs = ((const GAS float*)rowscale)[row];
                const f32x4 v0 = acc[ai][0][m][0] * rs, v1 = acc[ai][0][m][1] * rs; float* gp = GT + (size_t)row * GW_ + col0; f32x4 a, c;
#pragma unroll
                for (int j = 0; j < 4; ++j) { a[j] = sigmoidf_(v0[j]); c[j] = sigmoidf_(v1[j]); }
                *(f32x4*)gp = a; *(GAS f32x4*)(gp + 4) = c; }
    }
};
using EpiGates = EpiGatesT<false>;

#define DPP4(dst, oldv, srcv, ctrl) do { _Pragma("unroll") for (int j_ = 0; j_ < 4; ++j_) dst[j_] = __int_as_float(__builtin_amdgcn_update_dpp(__float_as_int(oldv[j_]), __float_as_int(srcv[j_]), (ctrl), 0xF, 0xF, false)); } while (0)
struct EpiGateUp {
    bf16_t* ACT; const float* cw; const float* cb; float* HALO; float* EDGE; LAS unsigned char* lds; const float* rowscale;
    __device__ __forceinline__ void operator()(const f32x4 (&acc_in)[2][2][4][2], const Unit& u, int wr, int wc, int fr, int fq) const {
        const int chl = wc * 32 + 8 * fq, ch = u.pn * 128 + chl;
        f32x4 acc[2][2][4][2];
#pragma unroll
        for (int ai = 0; ai < 2; ++ai)
#pragma unroll
            for (int m = 0; m < 4; ++m) { const float rs = ((const GAS float*)rowscale)[u.pm * BM + ai * HALF + wr * 64 + m * 16 + fr];
#pragma unroll
                for (int bj = 0; bj < 2; ++bj) { acc[ai][bj][m][0] = acc_in[ai][bj][m][0] * rs; acc[ai][bj][m][1] = acc_in[ai][bj][m][1] * rs; } }
        LAS float* XCH = (LAS float*)(lds + XCH_OFF);
        if (fr >= 14) {
#pragma unroll
            for (int ai = 0; ai < 2; ++ai) { const int q = 2 * ai + wr; LAS float* x = XCH + ((q * 2 + (fr - 14)) * 128 + chl);
                *(LAS f32x4*)x = acc[ai][0][3][0]; *(LAS f32x4*)(x + 4) = acc[ai][0][3][1];
                if (q == 3) { float* hp = HALO + ((size_t)(u.pm * 2 + (fr - 14))) * DFF + ch; *(f32x4*)hp = acc[ai][0][3][0]; *(GAS f32x4*)(hp + 4) = acc[ai][0][3][1]; } }
        }
        asm volatile("s_waitcnt lgkmcnt(0)" ::: "memory"); __builtin_amdgcn_s_barrier(); asm volatile("" ::: "memory");
        const f32x4 w0a = *(const GAS f32x4*)(cw + ch), w0b = *(const GAS f32x4*)(cw + ch + 4), w1a = *(const GAS f32x4*)(cw + DFF + ch), w1b = *(const GAS f32x4*)(cw + DFF + ch + 4);
        const f32x4 w2a = *(const GAS f32x4*)(cw + 2 * DFF + ch), w2b = *(const GAS f32x4*)(cw + 2 * DFF + ch + 4), bba = *(const GAS f32x4*)(cb + ch), bbb = *(const GAS f32x4*)(cb + ch + 4);
        const bool seqstart = (u.pm & 31) == 0;
        const f32x4 zero4 = (f32x4){0.f, 0.f, 0.f, 0.f};
#define TAPS_CUR(z, c) asm("s_nop 1\n\tv_fmac_f32_dpp %0, %4, %8 row_shr:1 row_mask:0xf bank_mask:0xf bound_ctrl:1\n\tv_fmac_f32_dpp %1, %5, %9 row_shr:1 row_mask:0xf bank_mask:0xf bound_ctrl:1\n\t" \
            "v_fmac_f32_dpp %2, %6, %10 row_shr:1 row_mask:0xf bank_mask:0xf bound_ctrl:1\n\tv_fmac_f32_dpp %3, %7, %11 row_shr:1 row_mask:0xf bank_mask:0xf bound_ctrl:1\n\t" \
            "v_fmac_f32_dpp %0, %4, %12 row_shr:2 row_mask:0xf bank_mask:0xf bound_ctrl:1\n\tv_fmac_f32_dpp %1, %5, %13 row_shr:2 row_mask:0xf bank_mask:0xf bound_ctrl:1\n\t" \
            "v_fmac_f32_dpp %2, %6, %14 row_shr:2 row_mask:0xf bank_mask:0xf bound_ctrl:1\n\tv_fmac_f32_dpp %3, %7, %15 row_shr:2 row_mask:0xf bank_mask:0xf bound_ctrl:1" \
            : "+v"(z##0), "+v"(z##1), "+v"(z##2), "+v"(z##3) : "v"(c[0]), "v"(c[1]), "v"(c[2]), "v"(c[3]), "v"(W1[0]), "v"(W1[1]), "v"(W1[2]), "v"(W1[3]), "v"(W0[0]), "v"(W0[1]), "v"(W0[2]), "v"(W0[3]))
#define TAPS_PREV(z, c, d) asm("s_nop 1\n\tv_fmac_f32_dpp %0, %4, %8 row_shl:15 row_mask:0xf bank_mask:0xf bound_ctrl:1\n\tv_fmac_f32_dpp %1, %5, %9 row_shl:15 row_mask:0xf bank_mask:0xf bound_ctrl:1\n\t" \
            "v_fmac_f32_dpp %2, %6, %10 row_shl:15 row_mask:0xf bank_mask:0xf bound_ctrl:1\n\tv_fmac_f32_dpp %3, %7, %11 row_shl:15 row_mask:0xf bank_mask:0xf bound_ctrl:1\n\t" \
            "v_fmac_f32_dpp %0, %16, %12 row_shl:14 row_mask:0xf bank_mask:0xf bound_ctrl:1\n\tv_fmac_f32_dpp %1, %17, %13 row_shl:14 row_mask:0xf bank_mask:0xf bound_ctrl:1\n\t" \
            "v_fmac_f32_dpp %2, %18, %14 row_shl:14 row_mask:0xf bank_mask:0xf bound_ctrl:1\n\tv_fmac_f32_dpp %3, %19, %15 row_shl:14 row_mask:0xf bank_mask:0xf bound_ctrl:1" \
            : "+v"(z##0), "+v"(z##1), "+v"(z##2), "+v"(z##3) : "v"(c[0]), "v"(c[1]), "v"(c[2]), "v"(c[3]), "v"(W1[0]), "v"(W1[1]), "v"(W1[2]), "v"(W1[3]), "v"(W0[0]), "v"(W0[1]), "v"(W0[2]), "v"(W0[3]), "v"(d[0]), "v"(d[1]), "v"(d[2]), "v"(d[3]))
#pragma unroll
        for (int ai = 0; ai < 2; ++ai) { const int q = 2 * ai + wr;
            f32x4 r63a = zero4, r63b = zero4, r62a = zero4, r62b = zero4;
            if (q > 0) { const LAS float* x = XCH + (((q - 1) * 2) * 128 + chl); r62a = *(const LAS f32x4*)x; r62b = *(const LAS f32x4*)(x + 4); r63a = *(const LAS f32x4*)(x + 128); r63b = *(const LAS f32x4*)(x + 132); }
            const f32x4 s2a = fr == 15 ? r63a : r62a, s2b = fr == 15 ? r63b : r62b;
#pragma unroll
            for (int m = 0; m < 4; ++m) {
                const f32x4 ca = acc[ai][0][m][0], cb_ = acc[ai][0][m][1], ua = acc[ai][1][m][0], ub = acc[ai][1][m][1];
                const int lrow = ai * HALF + wr * 64 + m * 16 + fr;
                f32x4 za = w2a * ca + bba, zb = w2b * cb_ + bbb;
                { float za0 = za[0], za1 = za[1], za2 = za[2], za3 = za[3], zb0 = zb[0], zb1 = zb[1], zb2 = zb[2], zb3 = zb[3];
                  const f32x4 p1a = m == 0 ? r63a : acc[ai][0][m > 0 ? m - 1 : 0][0], p1b = m == 0 ? r63b : acc[ai][0][m > 0 ? m - 1 : 0][1];
                  const f32x4 p2a = m == 0 ? s2a : p1a, p2b = m == 0 ? s2b : p1b;
                  { const f32x4 W1 = w1a, W0 = w0a; TAPS_CUR(za, ca); TAPS_PREV(za, p1a, p2a); }
                  { const f32x4 W1 = w1b, W0 = w0b; TAPS_CUR(zb, cb_); TAPS_PREV(zb, p1b, p2b); }
                  za = (f32x4){za0, za1, za2, za3}; zb = (f32x4){zb0, zb1, zb2, zb3}; }
                if (q == 0 && m == 0 && fr < 2 && !seqstart) {
                    float* ep = EDGE + ((size_t)((u.pm * 2 + fr) * 2)) * DFF + ch;
                    *(f32x4*)ep = ca; *(GAS f32x4*)(ep + 4) = cb_; *(GAS f32x4*)(ep + DFF) = ua; *(GAS f32x4*)(ep + DFF + 4) = ub;
                } else {
                    f32x4 ta = za * (-LOG2E), tb = zb * (-LOG2E);
#pragma unroll
                    for (int j = 0; j < 4; ++j) { ta[j] = __builtin_amdgcn_exp2f(ta[j]); tb[j] = __builtin_amdgcn_exp2f(tb[j]); }
                    ta = ta + 1.0f; tb = tb + 1.0f;
#pragma unroll
                    for (int j = 0; j < 4; ++j) { ta[j] = __builtin_amdgcn_rcpf(ta[j]); tb[j] = __builtin_amdgcn_rcpf(tb[j]); }
                    za = za * ta * ua; zb = zb * tb * ub;
                    *(GAS u32x4*)(ACT + (size_t)(u.pm * BM + lrow) * DFF + ch) = pack8(za, zb);
                }
            }
        }
#undef TAPS_CUR
#undef TAPS_PREV
    }
};
struct EpiKvc {
    bf16_t* KVC;
    __device__ __forceinline__ void operator()(const f32x4 (&acc)[2][2][4][2], const Unit& u, int wr, int wc, int fr, int fq) const {
        const int row0 = u.pm * BM + wr * 64 + fr, col0 = wc * 32 + 8 * fq;
#pragma unroll
        for (int ai = 0; ai < 2; ++ai)
#pragma unroll
            for (int m = 0; m < 4; ++m) { const int row = row0 + ai * HALF + m * 16; const bool dead = (row & 511) == 511;
                const f32x4 z4 = (f32x4){0.f, 0.f, 0.f, 0.f}; const f32x4 v0 = dead ? z4 : acc[ai][0][m][0], v1 = dead ? z4 : acc[ai][0][m][1];
                *(GAS u32x4*)(KVC + ((size_t)u.pn * 4096 + row) * 128 + col0) = pack8(v0, v1); }
    }
};
}

struct Args { const float* in[21]; float* out; unsigned char* ws; int ph_lo, ph_hi; };
struct Frame {
    LAS unsigned char* lds; volatile LAS unsigned* MISC; unsigned* ctl;
    int G, bid, wv;
    unsigned char* ws; float* out;
};
enum { IN_X = 0, IN_MEM, IN_LN_MIX, IN_LN_XA, IN_LN_FFN, IN_MEM_NORM, IN_POOL_W, IN_POOL_SCALE, IN_NSA_W_IN, IN_NSA_W_OUT, IN_CMP_POS, IN_CMP_W1, IN_CMP_B1, IN_CMP_W2,
       IN_XA_WQ, IN_XA_WKV, IN_XA_WO, IN_FFN_WGU, IN_FFN_CONVW, IN_FFN_CONVB, IN_FFN_WDN };

template <int MODE>
__device__ __forceinline__ void p0_transpose_item(const float* W, int K, int N, bf16_t* WT, const float* gk  , LAS unsigned* scr, int item, int lane) {
    const int nblk = (N + 63) / 64, kb = item / nblk, nb = item - kb * nblk, k0 = 64 * kb, n0 = 64 * nb;
    const int rr = lane >> 4, cq = lane & 15, n = n0 + 4 * cq; const bool nok = n < N;
    f32x4 v[16];
#pragma unroll
    for (int i = 0; i < 8; ++i)
#pragma unroll
        for (int e = 0; e < 2; ++e) { const int k = k0 + 8 * i + 2 * rr + e; v[2 * i + e] = nok ? *(const GAS f32x4*)(W + (size_t)k * N + n) : (f32x4){0.f, 0.f, 0.f, 0.f}; }
#pragma unroll
    for (int i = 0; i < 8; ++i) { f32x4 a = v[2 * i], b = v[2 * i + 1];
        if (gk) { const int k = k0 + 8 * i + 2 * rr; a = a * gk[k]; b = b * gk[k + 1]; }
        LAS unsigned* d = scr + (4 * i + rr) * 65 + 4 * cq;
        d[0] = cvtpk(a[0], b[0]); d[1] = cvtpk(a[1], b[1]); d[2] = cvtpk(a[2], b[2]); d[3] = cvtpk(a[3], b[3]); }
    LDS_WAIT(); asm volatile("" ::: "memory");
    int r0 = n0;
    if (MODE == 1) { const int up = n0 >= DFF ? 1 : 0, ch = n0 - up * DFF; r0 = (ch >> 7) * 256 + up * 128 + (ch & 127); }
    const int c = lane & 7;
#pragma unroll
    for (int j = 0; j < 8; ++j) { const int nn = (lane >> 3) + 8 * j; const LAS unsigned* sp = scr + (4 * c) * 65 + nn;
        u32x4 o; o.x = sp[0]; o.y = sp[65]; o.z = sp[130]; o.w = sp[195];
        if (n0 + nn < N) *(GAS u32x4*)(WT + (size_t)(r0 + nn) * K + k0 + 8 * c) = o; }
    LDS_WAIT(); asm volatile("" ::: "memory");
}
__device__ __forceinline__ float row_sumsq(const float* row, int lane) {
    const f32x4* xr = (const f32x4*)row + lane; float s = 0.f;
#pragma unroll
    for (int j = 0; j < 16; ++j) { const f32x4 v = xr[64 * j]; s += (v[0] * v[0] + v[1] * v[1]) + (v[2] * v[2] + v[3] * v[3]); }
    return wave_sum(s);
}
#ifndef XQFILL
#define XQFILL 1
#endif
constexpr int XQF_N = 112 * NWAVES * 11;
#ifndef TAILFILL
#define TAILFILL 1
#endif
#ifndef DEFER_CONV
#define DEFER_CONV 1
#endif
__device__ __forceinline__ void phase_p0(Frame& F, const Args& A) {
    unsigned char* const wsl = optr(F.ws);
    const int tid = otid(), lane = tid & 63, wave = __builtin_amdgcn_readfirstlane(tid >> 6);
    LAS unsigned* scr = (LAS unsigned*)(F.lds + wave * 8448);
    const int gw = F.bid * NWAVES + wave, NGW = F.G * NWAVES;
    unsigned char* ws = wsl;
    int it = gw;
#define P0_MAT(MODE, src, K_, N_, dst, gk_) do { const int n_ = ((K_) / 64) * (((N_) + 63) / 64); for (; it < n_; it += NGW) p0_transpose_item<MODE>((src), (K_), (N_), (bf16_t*)(dst), (gk_), scr, it, lane); it -= n_; } while (0)
    { const int off_ = (XQFILL && F.G == 256) ? XQF_N : 0; const int n_ = (DM / 64) * (DFF2 / 64) - off_;
      for (; it < n_; it += NGW) p0_transpose_item<1>(A.in[IN_FFN_WGU], DM, DFF2, (bf16_t*)(ws + WS_WGU), A.in[IN_LN_FFN], scr, it + off_, lane); it -= n_; }
    for (int l = 1; l < 2 - DEFER_CONV; ++l) P0_MAT(1, A.in[IN_FFN_WGU] + (size_t)l * DM * DFF2, DM, DFF2, ws + WS_WGU + (size_t)l * DFF2 * DM * 2, A.in[IN_LN_FFN] + (size_t)l * 2 * DM);
    for (int l = 0; l < (TAILFILL ? 0 : 2 - DEFER_CONV); ++l) P0_MAT(0, A.in[IN_FFN_WDN] + (size_t)l * DFF * DM, DFF, DM, ws + WS_WDN + (size_t)l * DM * DFF * 2, nullptr);
    P0_MAT(0, A.in[IN_NSA_W_IN], DM, NSA_INW, ws + WS_NSAIN, A.in[IN_LN_MIX] + (size_t)2 * DM);
    if (!DEFER_CONV) P0_MAT(0, A.in[IN_NSA_W_OUT], QW, DM, ws + WS_NSAOUT, nullptr);
    for (int g = 0; g < 4; ++g) P0_MAT(0, A.in[IN_POOL_W] + (size_t)g * PGC * PGC, PGC, PGC, ws + WS_POOLW + (size_t)g * PGC * PGC * 2, nullptr);
    for (int l = 0; l < 2; ++l) P0_MAT(0, A.in[IN_CMP_W1] + (size_t)l * 4096 * CMP_HID, 4096, CMP_HID, ws + WS_CMPW1 + (size_t)l * CMP_HID * 4096 * 2, nullptr);
    for (int l = 0; l < 2; ++l) P0_MAT(0, A.in[IN_CMP_W2] + (size_t)l * CMP_HID * HD, CMP_HID, HD, ws + WS_CMPW2 + (size_t)l * 256 * CMP_HID * 2, nullptr);
    for (int l = 0; l < 2 - DEFER_CONV; ++l) P0_MAT(0, A.in[IN_XA_WQ] + (size_t)l * DM * XAW, DM, XAW, ws + WS_XAQ + (size_t)l * XAW * DM * 2, A.in[IN_LN_XA] + (size_t)l * 2 * DM);
    for (int l = 0; l < 2; ++l) P0_MAT(0, A.in[IN_XA_WKV] + (size_t)l * DM * 2 * XAW, DM, 2 * XAW, ws + WS_XAKV + (size_t)l * 2 * XAW * DM * 2, nullptr);
    for (int l = 0; l < 2 - DEFER_CONV; ++l) P0_MAT(0, A.in[IN_XA_WO] + (size_t)l * XAW * DM, XAW, DM, ws + WS_XAO + (size_t)l * DM * XAW * 2, nullptr);
#undef P0_MAT
    for (int l = 0; l < 2; ++l) { u32x4* z = (u32x4*)(ws + WS_CMPW2 + ((size_t)l * 256 + HD) * CMP_HID * 2); const int n16 = (256 - HD) * CMP_HID * 2 / 16;
      for (int i = gw * 64 + lane; i < n16; i += NGW * 64) *(GAS u32x4*)(z + i) = (u32x4){0u, 0u, 0u, 0u}; }
    { u32x4* z = (u32x4*)(ws + WS_NSAIN + (size_t)NSA_INW * DM * 2); const int n16 = (NSA_INP - NSA_INW) * DM * 2 / 16;
      for (int i = gw * 64 + lane; i < n16; i += NGW * 64) z[i] = (u32x4){0u, 0u, 0u, 0u}; }
    for (int r = gw; r < MMEM; r += NGW) {
        const float* row = A.in[IN_MEM] + (size_t)r * DM; const float rs = 1.0f / sqrtf(row_sumsq(row, lane) * (1.0f / DM) + RMS_EPS);
        bf16_t* o = (bf16_t*)(ws + WS_MEMN) + (size_t)r * DM;
#pragma unroll
        for (int j = 0; j < 8; ++j) { const int c8 = (j * 64 + lane) * 8; const f32x4 a = *(const GAS f32x4*)(row + c8), b = *(const GAS f32x4*)(row + c8 + 4);
            const f32x4 ga = *(const GAS f32x4*)(A.in[IN_MEM_NORM] + c8), gb = *(const GAS f32x4*)(A.in[IN_MEM_NORM] + c8 + 4);
            *(GAS u32x4*)(o + c8) = pg8::pack8(a * rs * ga, b * rs * gb); }
    }
    { float* part = (float*)(ws + WS_CMPB + 65536);
      for (int tk = gw; tk < 256; tk += NGW) { const int kv = tk >> 7, ng = (tk >> 4) & 7, ks = tk & 15, n = ng * 64 + lane;
          const float* pos = A.in[IN_CMP_POS] + (size_t)kv * 4096 + ks * 256; const float* w1 = A.in[IN_CMP_W1] + ((size_t)kv * 4096 + ks * 256) * CMP_HID + n; float s = 0.f;
#pragma unroll 8
          for (int k = 0; k < 256; ++k) s += pos[k] * w1[(size_t)k * CMP_HID];
          part[(kv * 16 + ks) * CMP_HID + n] = s; } }
    { float* xr = (float*)(ws + WS_XR);
      for (int r = gw; r < MTOK; r += NGW) { const float ss = row_sumsq(A.in[IN_X] + (size_t)r * DM, lane); if (lane == 0) xr[r] = 1.0f / sqrtf(ss * (1.0f / DM) + RMS_EPS); } }
}

template <int WIN>
__device__ __forceinline__ void pool_item(const float* X, const float* xr, const f32x4 gv, bf16_t* D0, int t0, int tin0, int c) {
    f32x4 prev[WIN]; f32x4 s = (f32x4){0.f, 0.f, 0.f, 0.f};
#pragma unroll
    for (int i = 0; i < WIN; ++i) { prev[i] = (tin0 - WIN + i >= 0) ? *(const GAS f32x4*)(X + (size_t)(t0 - WIN + i) * DM + c) * ((const GAS float*)xr)[tin0 - WIN + i >= 0 ? t0 - WIN + i : t0] * gv : (f32x4){0.f, 0.f, 0.f, 0.f}; s += prev[i]; }
#pragma unroll 1
    for (int r0 = 0; r0 < 64; r0 += 16) {
        f32x4 cur[16];
#pragma unroll
        for (int r = 0; r < 16; ++r) { const int t = t0 + r0 + r; cur[r] = *(const GAS f32x4*)(X + (size_t)t * DM + c) * ((const GAS float*)xr)[t] * gv; }
#pragma unroll
        for (int r = 0; r < 16; ++r) { const int t = t0 + r0 + r, tin = tin0 + r0 + r;
            const f32x4 old = (r >= WIN) ? cur[r >= WIN ? r - WIN : 0] : prev[r < WIN ? r : 0];
            s += cur[r]; s -= old;
            const float ic = 1.0f / (float)(tin + 1 < WIN ? tin + 1 : WIN);
            const f32x4 d = s * ic - cur[r]; u32x2 w; w.x = cvtpk(d[0], d[1]); w.y = cvtpk(d[2], d[3]);
            *(GAS u32x2*)(D0 + (size_t)t * DM + c) = w; }
#pragma unroll
        for (int i = 0; i < WIN; ++i) prev[i] = cur[16 - WIN + i];
    }
}
__device__ __forceinline__ void phase_poolprep(Frame& F, const Args& A) {
    unsigned char* const wsl = optr(F.ws);
    const float* X = A.in[IN_X]; const float* g0 = A.in[IN_LN_MIX]; const float* xr = (const float*)(wsl + WS_XR); bf16_t* D0 = (bf16_t*)(wsl + WS_HN);
    const int tid = otid();
    constexpr int NQ = DM / 4, TOTAL = (MTOK / 64) * NQ;
    for (int it = F.bid * NTHR + tid; it < TOTAL; it += F.G * NTHR) {
        const int chn = it / NQ, qq = it - chn * NQ, c = 4 * qq, t0 = chn * 64, tin0 = t0 & (SEQ - 1);
        const f32x4 gv = *(const GAS f32x4*)(g0 + c);
        switch (__builtin_amdgcn_readfirstlane(c >> 10)) {
            case 0: pool_item<2>(X, xr, gv, D0, t0, tin0, c); break;
            case 1: pool_item<4>(X, xr, gv, D0, t0, tin0, c); break;
            case 2: pool_item<8>(X, xr, gv, D0, t0, tin0, c); break;
            default: pool_item<16>(X, xr, gv, D0, t0, tin0, c); break;
        }
    }
}

template <bool FIRST, bool LAST>
__device__ __forceinline__ void phase_resid(Frame& F, const float* x, const float* g1) {
    unsigned char* const wsl = optr(F.ws);
    const int tid = otid(), lane = tid & 63, wave = __builtin_amdgcn_readfirstlane(tid >> 6);
    const int gw = F.bid * NWAVES + wave, NGW = F.G * NWAVES;
    const bf16_t* Y = (const bf16_t*)(wsl + WS_Y); const float* ssp = (const float*)(wsl + WS_SSP); bf16_t* H = (bf16_t*)(wsl + WS_HN); float* RS = (float*)(wsl + WS_RS);
    for (int row = gw; row < MTOK; row += NGW) {
        const float ss = wave_sum(((const GAS float*)ssp)[(size_t)row * 64 + lane]); const float rs = 1.0f / sqrtf(ss * (1.0f / DM) + RMS_EPS);
        float s2 = 0.f;
#pragma unroll
        for (int j = 0; j < 8; ++j) { const int c8 = (j * 64 + lane) * 8; const size_t off = (size_t)row * DM + c8;
            const u32x4 yw = *(const GAS u32x4*)(Y + off); f32x4 h0, h1;
            if (FIRST) { h0 = *(const GAS f32x4*)(x + off); h1 = *(const GAS f32x4*)(x + off + 4); }
            else { const u32x4 hw = *(const GAS u32x4*)(H + off); h0 = (f32x4){bflo(hw.x), bfhi(hw.x), bflo(hw.y), bfhi(hw.y)}; h1 = (f32x4){bflo(hw.z), bfhi(hw.z), bflo(hw.w), bfhi(hw.w)}; }
            const f32x4 ga = *(const GAS f32x4*)(g1 + c8), gb = *(const GAS f32x4*)(g1 + c8 + 4);
            const f32x4 y0 = (f32x4){bflo(yw.x), bfhi(yw.x), bflo(yw.y), bfhi(yw.y)}, y1 = (f32x4){bflo(yw.z), bfhi(yw.z), bflo(yw.w), bfhi(yw.w)};
            const f32x4 a = h0 + y0 * rs * ga, b = h1 + y1 * rs * gb;
            if (LAST) { *(GAS f32x4*)(F.out + off) = a; *(GAS f32x4*)(F.out + off + 4) = b; }
            else { *(GAS u32x4*)(H + off) = pg8::pack8(a, b);
                s2 += (a[0] * a[0] + a[1] * a[1]) + (a[2] * a[2] + a[3] * a[3]) + (b[0] * b[0] + b[1] * b[1]) + (b[2] * b[2] + b[3] * b[3]); } }
        if (!LAST) { const float t2 = wave_sum(s2); if (lane == 0) ((GAS float*)RS)[row] = 1.0f / sqrtf(t2 * (1.0f / DM) + RMS_EPS); }
    }
}

__device__ __forceinline__ void unpack8(const u32x4 w, float (&f)[8]) { f[0] = bflo(w.x); f[1] = bfhi(w.x); f[2] = bflo(w.y); f[3] = bfhi(w.y); f[4] = bflo(w.z); f[5] = bfhi(w.z); f[6] = bflo(w.w); f[7] = bfhi(w.w); }
__device__ __forceinline__ void phase_act(Frame& F, const float* cw, const float* cb) {
    unsigned char* const wsl = optr(F.ws);
    const bf16_t* GU = (const bf16_t*)(wsl + WS_GU); bf16_t* ACT = (bf16_t*)(wsl + WS_ACT);
    constexpr int NCG = DFF / 8, RCH = 32, TOTAL = (MTOK / RCH) * NCG;
    const int tid = otid();
    for (int it = F.bid * NTHR + tid; it < TOTAL; it += F.G * NTHR) {
        const int chunk = it / NCG, cg = it - chunk * NCG, ch = cg * 8, colg = (ch >> 7) * 256 + (ch & 127), colu = colg + 128;
        const int t0 = chunk * RCH, tin0 = t0 & (SEQ - 1);
        float w0[8], w1[8], w2[8], bb[8], g2[8], g1[8];
#pragma unroll
        for (int j = 0; j < 8; ++j) { w0[j] = cw[ch + j]; w1[j] = cw[DFF + ch + j]; w2[j] = cw[2 * DFF + ch + j]; bb[j] = cb[ch + j]; g2[j] = 0.f; g1[j] = 0.f; }
        if (tin0 >= 2) { unpack8(*(const GAS u32x4*)(GU + (size_t)(t0 - 2) * DFF2 + colg), g2); unpack8(*(const GAS u32x4*)(GU + (size_t)(t0 - 1) * DFF2 + colg), g1); }
#pragma unroll 2
        for (int r = 0; r < RCH; ++r) { const size_t ro = (size_t)(t0 + r) * DFF2; float gc[8], up[8], o[8];
            unpack8(*(const GAS u32x4*)(GU + ro + colg), gc); unpack8(*(const GAS u32x4*)(GU + ro + colu), up);
#pragma unroll
            for (int j = 0; j < 8; ++j) { const float z = w0[j] * g2[j] + w1[j] * g1[j] + w2[j] * gc[j] + bb[j]; o[j] = z * sigmoidf_(z) * up[j]; g2[j] = g1[j]; g1[j] = gc[j]; }
            u32x4 w; w.x = cvtpk(o[0], o[1]); w.y = cvtpk(o[2], o[3]); w.z = cvtpk(o[4], o[5]); w.w = cvtpk(o[6], o[7]);
            *(GAS u32x4*)(ACT + (size_t)(t0 + r) * DFF + ch) = w; }
    }
}

__device__ __forceinline__ void phase_actfix(Frame& F, const float* cw, const float* cb) {
    unsigned char* const wsl = optr(F.ws);
    const float* HALO = (const float*)(wsl + WS_HALO); const float* EDGE = (const float*)(wsl + WS_EDGE); bf16_t* ACT = (bf16_t*)(wsl + WS_ACT);
    constexpr int NC4 = DFF / 4, TOTAL = 64 * 2 * NC4;
    const int tid = otid();
    for (int it = F.bid * NTHR + tid; it < TOTAL; it += F.G * NTHR) {
        const int c4 = it % NC4, pr = it / NC4, r = pr & 1, pm = pr >> 1, ch = 4 * c4;
        if ((pm & 31) == 0) continue;
        const float* e = EDGE + ((size_t)((pm * 2 + r) * 2)) * DFF + ch; const float* hprev = HALO + ((size_t)((pm - 1) * 2)) * DFF + ch;
        const f32x4 cur = *(const f32x4*)e, up = *(const GAS f32x4*)(e + DFF);
        const f32x4 p1 = r == 0 ? *(const GAS f32x4*)(hprev + DFF) : *(const GAS f32x4*)(EDGE + ((size_t)((pm * 2) * 2)) * DFF + ch);
        const f32x4 p2 = r == 0 ? *(const f32x4*)hprev : *(const GAS f32x4*)(hprev + DFF);
        f32x4 z = *(const GAS f32x4*)(cw + ch) * p2 + *(const GAS f32x4*)(cw + DFF + ch) * p1 + *(const GAS f32x4*)(cw + 2 * DFF + ch) * cur + *(const GAS f32x4*)(cb + ch);
#pragma unroll
        for (int j = 0; j < 4; ++j) z[j] = z[j] * sigmoidf_(z[j]) * up[j];
        u32x2 w; w.x = cvtpk(z[0], z[1]); w.y = cvtpk(z[2], z[3]);
        *(GAS u32x2*)(ACT + (size_t)(pm * 256 + r) * DFF + ch) = w;
    }
}

__device__ __forceinline__ void phase_cmp2(Frame& F) {
    unsigned char* const wsl = optr(F.ws);
    const int tid = otid(), lane = tid & 63, wave = __builtin_amdgcn_readfirstlane(tid >> 6);
    const int gw = F.bid * NWAVES + wave, NGW = F.G * NWAVES;
    const bf16_t* HID = (const bf16_t*)(wsl + WS_HID); const bf16_t* W2 = (const bf16_t*)(wsl + WS_CMPW2); bf16_t* KVC = (bf16_t*)(wsl + WS_KVC);
    for (int r = gw; r < 2 * 4096; r += NGW) { const int kv = r >> 12;
        const bf16_t* h = HID + (size_t)r * CMP_HID; const bf16_t* wa = W2 + ((size_t)kv * HD + 2 * lane) * CMP_HID; const bf16_t* wb = wa + CMP_HID;
        float s0 = 0.f, s1 = 0.f;
#pragma unroll 4
        for (int k = 0; k < CMP_HID; k += 8) { float hf[8], a[8], b[8]; unpack8(*(const GAS u32x4*)(h + k), hf); unpack8(*(const GAS u32x4*)(wa + k), a); unpack8(*(const GAS u32x4*)(wb + k), b);
#pragma unroll
            for (int j = 0; j < 8; ++j) { s0 += hf[j] * a[j]; s1 += hf[j] * b[j]; } }
        if ((r & 511) == 511) { s0 = 0.f; s1 = 0.f; }
        *(GAS unsigned*)(KVC + (size_t)r * HD + 2 * lane) = cvtpk(s0, s1);
    }
}


namespace att {
constexpr int SHM = 16384;
constexpr int V_OFF = 0, K_OFF = 2 * SHM;
constexpr int SG_OFF = 65536, SL_OFF = SG_OFF + 16384, SELW_OFF = SL_OFF + 16384, TL_OFF = SELW_OFF + 512;
constexpr int WUN_OFF = TL_OFF + 640;
constexpr int ALF_OFF = TL_OFF + 1024;
constexpr float THR2 = 11.5f;
#define KSWZ(row, colB) ((row) * 256 + ((colB) ^ (((row) & 7) << 4)))
#define SBAR() __builtin_amdgcn_sched_barrier(0)
__device__ __forceinline__ int v_st(int k, int c) { const int kk = (k & ~0xC) | ((k & 4) << 1) | ((k & 8) >> 1); return ((kk >> 3) * 4 + (c >> 5)) * 512 + ((kk & 7) * 32 + (c & 31)) * 2; }
__device__ __forceinline__ int v_rd_base(int lane) { return ((lane & 3) << 3) | (((lane >> 2) & 3) << 6) | (((lane >> 4) & 1) << 5) | (((lane >> 5) & 1) << 8); }
constexpr int v_rd_off(int d0, int ks, int half) { return d0 * 512 + ks * 4096 + half * 2048; }
__device__ __forceinline__ int crow(int r, int hi) { return (r & 3) + 8 * (r >> 2) + 4 * hi; }

__device__ __forceinline__ void qkt(f32x16& p0, f32x16& p1, const LAS unsigned char* lds  , int r32, int hi, const bf16x8 (&qr)[8]) {
#pragma unroll
    for (int r = 0; r < 16; ++r) { p0[r] = 0.f; p1[r] = 0.f; }
    const LAS unsigned char* kb[4];
#pragma unroll
    for (int dd = 0; dd < 4; ++dd) kb[dd] = lds + KSWZ(r32, (dd * 16 + hi * 8) * 2);
#pragma unroll
    for (int d0 = 0; d0 < 8; ++d0) { const LAS unsigned char* a = kb[d0 & 3] + (d0 >> 2) * 128;
        const bf16x8 b0 = *(const LAS bf16x8*)a;
        const bf16x8 b1 = *(const LAS bf16x8*)(a + 32 * 256);
        p0 = __builtin_amdgcn_mfma_f32_32x32x16_bf16(b0, qr[d0], p0, 0, 0, 0);
        p1 = __builtin_amdgcn_mfma_f32_32x32x16_bf16(b1, qr[d0], p1, 0, 0, 0);
        if ((d0 & 3) == 3) SBAR(); }
}
__device__ __forceinline__ void pv_tile(f32x16 (&o)[4], int vb0  , bf16x8 pa0, bf16x8 pa1, bf16x8 pa2, bf16x8 pa3) {
#define TRRD(dst, off) asm volatile("ds_read_b64_tr_b16 %0, %1 offset:%2" : "=&v"(dst) : "v"(vb0), "i"(off) : "memory")
#define PV_D0(d0) do { s16x4 l0, l1, l2, l3, h0, h1, h2, h3; constexpr int b_ = v_rd_off(d0, 0, 0); \
        TRRD(l0, b_); TRRD(h0, b_ + 2048); TRRD(l1, b_ + 4096); TRRD(h1, b_ + 6144); TRRD(l2, b_ + 8192); TRRD(h2, b_ + 10240); TRRD(l3, b_ + 12288); TRRD(h3, b_ + 14336); \
        asm volatile("s_waitcnt lgkmcnt(0)" ::: "memory"); SBAR(); \
        o[d0] = __builtin_amdgcn_mfma_f32_32x32x16_bf16((bf16x8){l0[0], l0[1], l0[2], l0[3], h0[0], h0[1], h0[2], h0[3]}, pa0, o[d0], 0, 0, 0); \
        o[d0] = __builtin_amdgcn_mfma_f32_32x32x16_bf16((bf16x8){l1[0], l1[1], l1[2], l1[3], h1[0], h1[1], h1[2], h1[3]}, pa1, o[d0], 0, 0, 0); \
        o[d0] = __builtin_amdgcn_mfma_f32_32x32x16_bf16((bf16x8){l2[0], l2[1], l2[2], l2[3], h2[0], h2[1], h2[2], h2[3]}, pa2, o[d0], 0, 0, 0); \
        o[d0] = __builtin_amdgcn_mfma_f32_32x32x16_bf16((bf16x8){l3[0], l3[1], l3[2], l3[3], h3[0], h3[1], h3[2], h3[3]}, pa3, o[d0], 0, 0, 0); } while (0)
    PV_D0(0); PV_D0(1); PV_D0(2); PV_D0(3);
#undef PV_D0
#undef TRRD
}
__device__ __forceinline__ float red8(float v) {
    v += __int_as_float(__builtin_amdgcn_update_dpp(0, __float_as_int(v), 0xB1, 0xF, 0xF, true));
    v += __int_as_float(__builtin_amdgcn_update_dpp(0, __float_as_int(v), 0x4E, 0xF, 0xF, true));
    v += __int_as_float(__builtin_amdgcn_update_dpp(0, __float_as_int(v), 0x141, 0xF, 0xF, true));
    return v;
}
template <int MODE>
__device__ __forceinline__ void score_mod(f32x16& e0, f32x16& e1, int kidx, int t_row, float sl2, int hi, bool rowok) {
    if (MODE == 0) {
#pragma unroll
        for (int r = 0; r < 16; ++r) { e0[r] *= QK_C2; e1[r] *= QK_C2; }
        return;
    }
    constexpr int CS = (MODE == 1) ? 16 : 1;
    constexpr unsigned W = (MODE == 3) ? 512u : 0x7fffffffu;
    const int dqa = (MODE == 1) ? (t_row - 31 - 1024 * kidx - 64 * hi) : (t_row - kidx - 4 * hi);
    const int dqb = dqa - 32 * CS;
    const float slc = sl2 * (float)CS, ba = -sl2 * (float)dqa, bb = -sl2 * (float)dqb;
    const float NEG = -__builtin_inff();
#pragma unroll
    for (int r = 0; r < 16; ++r) { const int c = (r & 3) + 8 * (r >> 2);
        const float xa = fmaf(e0[r], QK_C2, fmaf(slc, (float)c, ba)), xb = fmaf(e1[r], QK_C2, fmaf(slc, (float)c, bb));
        e0[r] = (rowok && (unsigned)(dqa - CS * c) < W) ? xa : NEG;
        e1[r] = (rowok && (unsigned)(dqb - CS * c) < W) ? xb : NEG; }
}
__device__ __forceinline__ void prefetch_k(LAS unsigned char* lds, const bf16_t* Kp, int key0, int buf, int wave_s) {
    const int tid = otid_w(wave_s), wave = __builtin_amdgcn_readfirstlane(tid >> 6);
#pragma unroll
    for (int j = 0; j < 2; ++j) { const int q = 512 * j + tid, row = q >> 4, cc = (q & 15) ^ (row & 7);
        __builtin_amdgcn_global_load_lds((const unsigned*)(Kp + (size_t)key0 * HD + (unsigned)(row * HD + cc * 8)), (LAS unsigned*)(lds + K_OFF + buf * SHM + j * 8192 + wave * 1024), 16, 0, 0); }
}
__device__ __forceinline__ void prefetch_v(LAS unsigned char* lds, const bf16_t* Vp, int key0, int buf, int wave_s) {
    const int tid = otid_w(wave_s), wave = __builtin_amdgcn_readfirstlane(tid >> 6);
#pragma unroll
    for (int j = 0; j < 2; ++j) { const int q = 512 * j + tid, sb = q >> 5, kk = (sb >> 2) * 8 + ((q & 31) >> 2), c = (sb & 3) * 32 + (q & 3) * 8, k = (kk & ~0xC) | ((kk & 4) << 1) | ((kk & 8) >> 1);
        __builtin_amdgcn_global_load_lds((const unsigned*)(Vp + (size_t)key0 * HD + (unsigned)(k * HD + c)), (LAS unsigned*)(lds + V_OFF + buf * SHM + j * 8192 + wave * 1024), 16, 0, 0); }
}
__device__ __forceinline__ void prefetch_k0(LAS unsigned char* lds, const bf16_t* Kp, int key0, int wave_s) { prefetch_k(lds, Kp, key0, 0, wave_s); }
template <int MODE, int PASS, bool PRE = false, bool CHAIN = false>
__device__ __forceinline__ void attn_pass(LAS unsigned char* lds, const bf16_t* Kp, const bf16_t* Vp, int pitch, int NT, int kb0,
                                          const bf16x8 (&qr)[8], float& m, float& l, float gate, float invl, f32x16 (&o)[4], int t_row, float sl2, int tokl, int wave_s, int par0 = 0) {
    const int tid = otid_w(wave_s), lane = tid & 63, r32 = lane & 31, hi = lane >> 5;
    const int sr = tid >> 4, sc = (tid & 15) * 8, vst0 = v_st(sr, sc), vst1 = v_st(32 + sr, sc), kws = KSWZ(sr, sc * 2);
    const int vb0 = (int)(uintptr_t)lds + V_OFF + v_rd_base(lane);
    const LAS int* TL = (const LAS int*)(lds + TL_OFF);
    const LAS unsigned* SELW = (const LAS unsigned*)(lds + SELW_OFF);
    LAS float* SG = (LAS float*)(lds + SG_OFF); LAS float* SL = (LAS float*)(lds + SL_OFF);
    bf16x8 st_k0, st_k1, st_v0, st_v1;
#define KEY0(i) ((MODE == 2) ? 64 * TL[(i)] : kb0 + 64 * (i))
#define A_LOAD(k0_) do { st_k0 = *(const GAS bf16x8*)(Kp + (size_t)((k0_) + sr) * pitch + sc); st_k1 = *(const GAS bf16x8*)(Kp + (size_t)((k0_) + 32 + sr) * pitch + sc); \
        if (PASS == 2) { st_v0 = *(const GAS bf16x8*)(Vp + (size_t)((k0_) + sr) * pitch + sc); st_v1 = *(const GAS bf16x8*)(Vp + (size_t)((k0_) + 32 + sr) * pitch + sc); } } while (0)
#define A_WRITE(bf) do { *(LAS bf16x8*)(lds + K_OFF + (bf) * SHM + kws) = st_k0; *(LAS bf16x8*)(lds + K_OFF + (bf) * SHM + kws + 32 * 256) = st_k1; \
        if (PASS == 2) { *(LAS bf16x8*)(lds + V_OFF + (bf) * SHM + vst0) = st_v0; *(LAS bf16x8*)(lds + V_OFF + (bf) * SHM + vst1) = st_v1; } } while (0)
#define A_STEP(i, BUF) do { \
        const bool more_ = (i) + 1 < NT; const int kcur_ = KEY0(i); \
        if (more_) { const int kn_ = KEY0((i) + 1); A_LOAD(kn_); } else if (CHAIN) { prefetch_k(lds, Kp, kb0, (BUF) ^ 1, wave_s); } \
        bool rowok_ = true; bool act_ = true; \
        if (MODE == 2) { const int n_ = kcur_ >> 6; rowok_ = ((SELW[tokl * 4 + (n_ >> 5)] >> (n_ & 31)) & 1u) != 0u; act_ = __any(rowok_); } \
        if (act_) { \
            f32x16 e0, e1; qkt(e0, e1, lds + K_OFF + (BUF) * SHM, r32, hi, qr); SBAR(); \
              \
              \
            const int dq_ = (MODE == 1) ? (t_row - 31 - 1024 * (i) - 64 * hi) : 0; \
            const float slc_ = (MODE == 1) ? 16.0f * sl2 : 0.f; \
            const float b00_ = ((MODE == 1) ? -sl2 * (float)dq_ : 0.f) - sh_; \
            f32x2 bp_ = {b00_, b00_ + slc_}; const f32x2 s2_ = {2.0f * slc_, 2.0f * slc_}, s6_ = {6.0f * slc_, 6.0f * slc_}, dB_ = {32.0f * slc_, 32.0f * slc_}, c2v_ = {QK_C2, QK_C2}; \
            _Pragma("unroll") for (int r = 0; r < 16; r += 2) { \
                const f32x2 xa_ = __builtin_elementwise_fma((f32x2){e0[r], e0[r + 1]}, c2v_, bp_), xb_ = __builtin_elementwise_fma((f32x2){e1[r], e1[r + 1]}, c2v_, bp_ + dB_); \
                e0[r] = xa_[0]; e0[r + 1] = xa_[1]; e1[r] = xb_[0]; e1[r + 1] = xb_[1]; \
                if (MODE == 1) bp_ += ((r & 2) == 0) ? s2_ : s6_; } \
            if (MODE == 1 && __any(dq_ - 944 < 0)) { \
                const float NEG_ = -__builtin_inff(); \
                _Pragma("unroll") for (int r = 0; r < 16; ++r) { const int c = (r & 3) + 8 * (r >> 2); \
                    if (dq_ - 16 * c < 0) e0[r] = NEG_; \
                    if (dq_ - 512 - 16 * c < 0) e1[r] = NEG_; } } \
            if (PASS == 1) { \
                float tmax = e0[0]; _Pragma("unroll") for (int r = 1; r < 16; ++r) tmax = fmaxf(tmax, e0[r]); _Pragma("unroll") for (int r = 0; r < 16; ++r) tmax = fmaxf(tmax, e1[r]); \
                { auto rr = __builtin_amdgcn_permlane32_swap(__float_as_uint(tmax), __float_as_uint(tmax), false, false); tmax = fmaxf(__uint_as_float(rr[0]), __uint_as_float(rr[1])); } \
                const float mn = fmaxf(m, tmax); const f32x2 nm_ = {-mn, -mn}; f32x2 ps2_ = {0.f, 0.f}; \
                _Pragma("unroll") for (int r = 0; r < 16; r += 2) { const f32x2 ya_ = (f32x2){e0[r], e0[r + 1]} + nm_, yb_ = (f32x2){e1[r], e1[r + 1]} + nm_; \
                    ps2_ += (f32x2){__builtin_amdgcn_exp2f(ya_[0]), __builtin_amdgcn_exp2f(ya_[1])}; ps2_ += (f32x2){__builtin_amdgcn_exp2f(yb_[0]), __builtin_amdgcn_exp2f(yb_[1])}; } \
                float ps = ps2_[0] + ps2_[1]; \
                { auto rr = __builtin_amdgcn_permlane32_swap(__float_as_uint(ps), __float_as_uint(ps), false, false); ps = __uint_as_float(rr[0]) + __uint_as_float(rr[1]); } \
                l = l * __builtin_amdgcn_exp2f(m - mn) + ps; m = mn; \
            } else { \
                _Pragma("unroll") for (int r = 0; r < 16; ++r) { e0[r] = __builtin_amdgcn_exp2f(e0[r]); e1[r] = __builtin_amdgcn_exp2f(e1[r]); } \
                if (MODE == 1) {        \
                    f32x4 gav_, lav_, gbv_, lbv_; \
                    _Pragma("unroll") for (int rq = 0; rq < 4; ++rq) { \
                        float ga = (e0[4 * rq] + e0[4 * rq + 1]) + (e0[4 * rq + 2] + e0[4 * rq + 3]), la = e0[4 * rq + 3]; \
                        float gb = (e1[4 * rq] + e1[4 * rq + 1]) + (e1[4 * rq + 2] + e1[4 * rq + 3]), lb = e1[4 * rq + 3]; \
                        gav_[rq] = red8(ga); lav_[rq] = red8(la); gbv_[rq] = red8(gb); lbv_[rq] = red8(lb); } \
                      \
                    if ((r32 & 7) == 0) { const int sa_ = tokl * 128 + 16 * (i) + 4 * hi; \
                        *(LAS f32x4*)(SG + sa_) = gav_ * rg_; *(LAS f32x4*)(SL + sa_) = lav_ * rg_; *(LAS f32x4*)(SG + sa_ + 8) = gbv_ * rg_; *(LAS f32x4*)(SL + sa_ + 8) = lbv_ * rg_; } \
                } \
                bf16x8 pa0, pa1, pa2, pa3; \
                PK4(e0, 0, pa0); PK4(e0, 8, pa1); PK4(e1, 0, pa2); PK4(e1, 8, pa3); \
                SBAR(); pv_tile(o, vb0 + (BUF) * SHM, pa0, pa1, pa2, pa3); \
            } \
        } \
        if (more_) { VM_WAIT(); A_WRITE((BUF) ^ 1); } \
        __syncthreads(); } while (0)
#define PK4(P, B_, OUT) do { unsigned a0 = cvtpk(P[B_ + 0], P[B_ + 1]), a1 = cvtpk(P[B_ + 2], P[B_ + 3]); \
        unsigned b0 = cvtpk(P[B_ + 4], P[B_ + 5]), b1 = cvtpk(P[B_ + 6], P[B_ + 7]); \
        auto r0 = __builtin_amdgcn_permlane32_swap(a0, b0, false, false); auto r1 = __builtin_amdgcn_permlane32_swap(a1, b1, false, false); \
        u32x4 w = {r0[0], r1[0], r0[1], r1[1]}; OUT = *reinterpret_cast<bf16x8*>(&w); } while (0)
    if (NT <= 0) return;
    const float gc_ = fmaxf(gate, 1e-30f), sh_ = (PASS == 2) ? m - __builtin_amdgcn_logf(gc_ * invl) : 0.f, rg_ = __builtin_amdgcn_rcpf(gc_);
    if (!PRE) { const int k0 = KEY0(0); A_LOAD(k0); VM_WAIT(); A_WRITE(par0); } else { VM_WAIT(); }
    __syncthreads();
#pragma unroll 1
    for (int i = 0; i < NT; ++i) { const int buf = (i + par0) & 1; A_STEP(i, buf); }
#undef PK4
#undef A_STEP
#undef A_WRITE
#undef A_LOAD
#undef KEY0
}

template <int MODE, bool PRE = false, int PITCH = HD>
__device__ __forceinline__ void attn_online(LAS unsigned char* lds, const bf16_t* Kp, const bf16_t* Vp, int NT, int kb0,
                                            const bf16x8 (&qr)[8], float& m, float& l, f32x16 (&o)[4], int t_row, int tw0, float sl2, int tokl, int wave_s) {
    const int tid = otid_w(wave_s), lane = tid & 63, r32 = lane & 31, hi = lane >> 5, wave = __builtin_amdgcn_readfirstlane(tid >> 6);
    const int vb0 = (int)(uintptr_t)lds + V_OFF + v_rd_base(lane);
    const LAS int* TL = (const LAS int*)(lds + TL_OFF);
    const LAS unsigned* SELW = (const LAS unsigned*)(lds + SELW_OFF);
    constexpr int pitch = PITCH;
    unsigned gko[2], gvo[2];
#pragma unroll
    for (int j = 0; j < 2; ++j) { const int q = 512 * j + tid;
        { const int row = q >> 4, cc = (q & 15) ^ (row & 7); gko[j] = (unsigned)(row * pitch + cc * 8); }
        { const int sb = q >> 5, kk = (sb >> 2) * 8 + ((q & 31) >> 2), c = (sb & 3) * 32 + (q & 3) * 8, k = (kk & ~0xC) | ((kk & 4) << 1) | ((kk & 8) >> 1); gvo[j] = (unsigned)(k * pitch + c); } }
    const unsigned ldsw = (unsigned)wave * 1024u;
    bf16x8 kx0, kx1, qx;
    { const float kr = (float)r32, bh = sl2 * (1.0f / QK_C2); const unsigned bhb = cvtpk(bh, 0.f) & 0xffffu; const float bl = bh - __uint_as_float(bhb << 16);
      u32x4 a = {hi == 0 ? cvtpk(kr, kr) : 0u, 0u, 0u, 0u}, b = {hi == 0 ? cvtpk(kr + 32.f, kr + 32.f) : 0u, 0u, 0u, 0u}, c = {hi == 0 ? cvtpk(bh, bl) : 0u, 0u, 0u, 0u};
      kx0 = *reinterpret_cast<bf16x8*>(&a); kx1 = *reinterpret_cast<bf16x8*>(&b); qx = *reinterpret_cast<bf16x8*>(&c); }
#define KEY0(i) ((MODE == 2) ? 64 * TL[(i)] : kb0 + 64 * (i))
#define DMA_K(k0_, bf) do { _Pragma("unroll") for (int j_ = 0; j_ < 2; ++j_) \
        __builtin_amdgcn_global_load_lds((const unsigned*)(Kp + (size_t)(k0_) * pitch + gko[j_]), (LAS unsigned*)(lds + K_OFF + (bf) * SHM + j_ * 8192 + ldsw), 16, 0, 0); } while (0)
#define DMA_V(k0_, bf) do { _Pragma("unroll") for (int j_ = 0; j_ < 2; ++j_) \
        __builtin_amdgcn_global_load_lds((const unsigned*)(Vp + (size_t)(k0_) * pitch + gvo[j_]), (LAS unsigned*)(lds + V_OFF + (bf) * SHM + j_ * 8192 + ldsw), 16, 0, 0); } while (0)
#define PK4(P, B_, OUT) do { unsigned a0 = cvtpk(P[B_ + 0], P[B_ + 1]), a1 = cvtpk(P[B_ + 2], P[B_ + 3]); \
        unsigned b0 = cvtpk(P[B_ + 4], P[B_ + 5]), b1 = cvtpk(P[B_ + 6], P[B_ + 7]); \
        auto r0 = __builtin_amdgcn_permlane32_swap(a0, b0, false, false); auto r1 = __builtin_amdgcn_permlane32_swap(a1, b1, false, false); \
        u32x4 w = {r0[0], r1[0], r0[1], r1[1]}; OUT = *reinterpret_cast<bf16x8*>(&w); } while (0)
#define QK_TILE(i_, E0, E1, ROK, ACT) do { const int kc_ = KEY0(i_); ROK = true; ACT = true; \
        if (MODE == 2) { const int n_ = kc_ >> 6; ROK = ((SELW[tokl * 4 + (n_ >> 5)] >> (n_ & 31)) & 1u) != 0u; ACT = __any(ROK); } \
        if (ACT) { qkt(E0, E1, lds + K_OFF + ((i_) & 1) * SHM, r32, hi, qr); \
            E0 = __builtin_amdgcn_mfma_f32_32x32x16_bf16(kx0, qx, E0, 0, 0, 0); \
            E1 = __builtin_amdgcn_mfma_f32_32x32x16_bf16(kx1, qx, E1, 0, 0, 0); } } while (0)
#define PART_SM(i_, E0, E1, ROK, AL_) do { const int kcur = KEY0(i_); \
        const float NEG = -__builtin_inff(); \
        const float tb = (ROK) ? -sl2 * (float)(t_row - kcur) : NEG; \
        const bool interior = (MODE == 3) ? (kcur + 63 <= tw0 && kcur >= tw0 + 3 - 511) : (kcur + 63 <= tw0); \
        if (!interior) { \
            constexpr unsigned W = (MODE == 3) ? 512u : 0x7fffffffu; \
            const int dqa = t_row - kcur - 4 * hi, dqb = dqa - 32; \
            _Pragma("unroll") for (int r = 0; r < 16; ++r) { const int c = (r & 3) + 8 * (r >> 2); \
                if ((unsigned)(dqa - c) >= W) E0[r] = NEG; \
                if ((unsigned)(dqb - c) >= W) E1[r] = NEG; } \
        } \
        float pmax = E0[0];        \
        _Pragma("unroll") for (int r = 1; r < 16; ++r) pmax = fmaxf(pmax, E0[r]); \
        _Pragma("unroll") for (int r = 0; r < 16; ++r) pmax = fmaxf(pmax, E1[r]); \
        { auto rr = __builtin_amdgcn_permlane32_swap(__float_as_uint(pmax), __float_as_uint(pmax), false, false); pmax = fmaxf(__uint_as_float(rr[0]), __uint_as_float(rr[1])); } \
        pmax = fmaf(pmax, QK_C2, tb); \
        float mn; \
        if (__all((pmax - m) <= THR2)) { mn = m; AL_ = 1.f; } \
        else { mn = fmaxf(m, pmax); AL_ = __builtin_amdgcn_exp2f(m - mn); m = mn; } \
        const float c0_ = tb - mn; \
        _Pragma("unroll") for (int r = 0; r < 16; r += 2) { \
            const f32x2 xa_ = __builtin_elementwise_fma((f32x2){E0[r], E0[r + 1]}, (f32x2){QK_C2, QK_C2}, (f32x2){c0_, c0_}), xb_ = __builtin_elementwise_fma((f32x2){E1[r], E1[r + 1]}, (f32x2){QK_C2, QK_C2}, (f32x2){c0_, c0_}); \
            E0[r] = __builtin_amdgcn_exp2f(xa_[0]); E0[r + 1] = __builtin_amdgcn_exp2f(xa_[1]); E1[r] = xb_[0]; E1[r + 1] = xb_[1]; } \
        if (__any(AL_ < 1.f)) {        \
            _Pragma("unroll") for (int d0 = 0; d0 < 4; ++d0) \
                _Pragma("unroll") for (int r = 0; r < 16; ++r) o[d0][r] *= AL_; } } while (0)
#define FIN_SM(E0, E1, AL_) do { \
        f32x2 ps2 = {0.f, 0.f}; \
        _Pragma("unroll") for (int r = 0; r < 16; r += 2) { E1[r] = __builtin_amdgcn_exp2f(E1[r]); E1[r + 1] = __builtin_amdgcn_exp2f(E1[r + 1]); \
            ps2 += (f32x2){E0[r], E0[r + 1]}; ps2 += (f32x2){E1[r], E1[r + 1]}; } \
        float ps = ps2[0] + ps2[1]; \
        { auto rr = __builtin_amdgcn_permlane32_swap(__float_as_uint(ps), __float_as_uint(ps), false, false); ps = __uint_as_float(rr[0]) + __uint_as_float(rr[1]); } \
        l = l * AL_ + ps; \
        PK4(E0, 0, pa0); PK4(E0, 8, pa1); PK4(E1, 0, pa2); PK4(E1, 8, pa3); } while (0)
#define PSTEP(t_, X0, X1, ROKX, ACTX, ALX, Y0, Y1, ACTY, ALY) do { \
        if ((t_) + 1 < NT) { const int k1_ = KEY0((t_) + 1); DMA_K(k1_, ((t_) + 1) & 1); } \
        if ((t_) < NT) { const int k0_ = KEY0(t_); DMA_V(k0_, (t_) & 1); QK_TILE(t_, X0, X1, ROKX, ACTX); } else { ACTX = false; } \
        if ((t_) > 0 && ACTY) { bf16x8 pa0, pa1, pa2, pa3; FIN_SM(Y0, Y1, ALY); pv_tile(o, vb0 + (((t_) + 1) & 1) * SHM, pa0, pa1, pa2, pa3); } \
        if (ACTX) PART_SM(t_, X0, X1, ROKX, ALX); \
        VM_WAIT(); \
        __syncthreads(); } while (0)
    if (NT <= 0) return;
    { if (!PRE) { const int k0 = KEY0(0); DMA_K(k0, 0); } VM_WAIT(); }
    __syncthreads();
    f32x16 eA0, eA1, eB0, eB1; bool rokA = true, actA = false, rokB = true, actB = false; float alA = 1.f, alB = 1.f;
#pragma unroll
    for (int r = 0; r < 16; ++r) { eA0[r] = 0.f; eA1[r] = 0.f; eB0[r] = 0.f; eB1[r] = 0.f; }
#pragma unroll 1
    for (int t = 0; t <= NT; t += 2) {
        PSTEP(t, eA0, eA1, rokA, actA, alA, eB0, eB1, actB, alB);
        if (t + 1 <= NT) PSTEP(t + 1, eB0, eB1, rokB, actB, alB, eA0, eA1, actA, alA);
    }
#undef PART_SM
#undef FIN_SM
#undef PSTEP
#undef QK_TILE
#undef PK4
#undef DMA_V
#undef DMA_K
#undef KEY0
}
__device__ __forceinline__ void scale_rows(f32x16 (&o)[4], float fac) {
#pragma unroll
    for (int d0 = 0; d0 < 4; ++d0)
#pragma unroll
        for (int r = 0; r < 16; ++r) o[d0][r] *= fac;
}
#define ATT_STORE_O(ROWPTR) do { bf16_t* op_ = (ROWPTR) + (hi ? 8 : 0); \
    _Pragma("unroll") for (int d0 = 0; d0 < 4; ++d0) { \
        _Pragma("unroll") for (int rg = 0; rg < 4; rg += 2) { \
            unsigned ax = cvtpk(o[d0][4 * rg + 0], o[d0][4 * rg + 1]), ay = cvtpk(o[d0][4 * rg + 2], o[d0][4 * rg + 3]); \
            unsigned bx = cvtpk(o[d0][4 * rg + 4], o[d0][4 * rg + 5]), by = cvtpk(o[d0][4 * rg + 6], o[d0][4 * rg + 7]); \
            { auto rr = __builtin_amdgcn_permlane32_swap(ax, bx, false, false); ax = rr[0]; bx = rr[1]; } \
            { auto rr = __builtin_amdgcn_permlane32_swap(ay, by, false, false); ay = rr[0]; by = rr[1]; } \
            u32x4 w_ = {ax, ay, bx, by}; *(GAS u32x4*)(op_ + d0 * 32 + rg * 8) = w_; } } } while (0)
}

__device__ __forceinline__ void phase_xattn(Frame& F, int L) {
    unsigned char* const wsl = optr(F.ws);
    const bf16_t* QX = (const bf16_t*)(wsl + WS_QX); const bf16_t* KVM = (const bf16_t*)(wsl + WS_KVMEM) + (size_t)L * MMEM * 2 * XAW; bf16_t* OX = (bf16_t*)(wsl + WS_OX);
    for (int u = F.bid; u < BATCH * 4 * (SEQ / 256); u += F.G) {
        const int tid = otid(), lane = tid & 63, r32 = lane & 31, hi = lane >> 5, wave = __builtin_amdgcn_readfirstlane(tid >> 6);
        const int qb = u % (SEQ / 256), hd = (u / (SEQ / 256)) & 3, b = u / (4 * (SEQ / 256));
        const int t = qb * 256 + wave * 32 + r32; const size_t row = (size_t)b * SEQ + t;
        bf16x8 qr[8];
#pragma unroll
        for (int d0 = 0; d0 < 8; ++d0) qr[d0] = *(const GAS bf16x8*)(QX + row * XAW + hd * HD + d0 * 16 + hi * 8);
        const bf16_t* Kp = KVM + (size_t)b * MEMLEN * 2 * XAW + hd * HD; const bf16_t* Vp = Kp + XAW;
        f32x16 o[4];
#pragma unroll
        for (int d0 = 0; d0 < 4; ++d0)
#pragma unroll
            for (int r = 0; r < 16; ++r) o[d0][r] = 0.f;
        float m = -1e30f, l = 0.f;
        att::attn_online<3, false, 2 * XAW>(F.lds, Kp, Vp, MEMLEN / 64, 0, qr, m, l, o, 0, 300, 0.f, 0, F.wv);
        att::scale_rows(o, l > 0.f ? 1.0f / l : 0.f);
        ATT_STORE_O(OX + ((size_t)b * SEQ + qb * 256 + wave * 32 + r32) * XAW + hd * HD);
    }
}

#ifndef TP_NSA_SEC
#define TP_NSA_SEC 0
#endif
__device__ __forceinline__ void phase_nsa(Frame& F, unsigned long long& tp_acc, const Args& A) {
    unsigned char* const wsl = optr(F.ws);
    unsigned long long tp_s = 0ull;
#define NSEC_B(k) do { if (TP_NSA_SEC == (k)) tp_s = __builtin_amdgcn_s_memrealtime(); } while (0)
#define NSEC_E(k) do { if (TP_NSA_SEC == (k)) tp_acc += __builtin_amdgcn_s_memrealtime() - tp_s; } while (0)
    const bf16_t* NQ = (const bf16_t*)(wsl + WS_NQ); const bf16_t* NKV = (const bf16_t*)(wsl + WS_NKV); const bf16_t* KVC = (const bf16_t*)(wsl + WS_KVC);
    const float* GT = (const float*)(wsl + WS_GATES); bf16_t* NO = (bf16_t*)(wsl + WS_NO);
    LAS unsigned char* lds = F.lds;
    LAS float* SG = (LAS float*)(lds + att::SG_OFF); LAS float* SL = (LAS float*)(lds + att::SL_OFF);
    LAS unsigned* SELW = (LAS unsigned*)(lds + att::SELW_OFF); LAS int* TL = (LAS int*)(lds + att::TL_OFF); LAS unsigned* WUN = (LAS unsigned*)(lds + att::WUN_OFF);
    constexpr int NQB = SEQ / 32, NUNITS = BATCH * NSA_G * NQB;
    bf16x8 qr[8];
#define NSA_SEAM(u_) do { const int tid_ = otid(), ln_ = tid_ & 63, wv_ = __builtin_amdgcn_readfirstlane(tid_ >> 6); \
        const int qb_ = NQB - 1 - (u_) / (BATCH * NSA_G), bg_ = (u_) % (BATCH * NSA_G), b_ = bg_ >> 2, g_ = bg_ & 3, t0_ = qb_ * 32; \
        const size_t row_ = (size_t)b_ * SEQ + t0_ + 4 * wv_ + ((ln_ & 31) >> 3); const int head_ = g_ * 8 + (ln_ & 7); \
        _Pragma("unroll") for (int d0 = 0; d0 < 8; ++d0) qr[d0] = *(const GAS bf16x8*)(NQ + row_ * QW + head_ * HD + d0 * 16 + (ln_ >> 5) * 8); \
        att::prefetch_k0(lds, NKV + ((size_t)((((2 * 2 + 0) * 2 + b_) * 4 + g_)) * SEQ) * HD, ((t0_ - 511 > 0 ? t0_ - 511 : 0) >> 6) * 64, F.wv); } while (0)
    LAS int* NXT = (LAS int*)(lds + att::TL_OFF + 600);
    unsigned* qctr = F.ctl + 1024;
    if (F.bid < NUNITS) NSA_SEAM(F.bid);
    constexpr int CV_NGU = (DM / 64) * (DFF2 / 64), CV_NDN = TAILFILL ? 0 : (DFF / 64) * (DM / 64), CV_NNO = (QW / 64) * (DM / 64), CV_NXQ = (DM / 64) * (XAW / 64), CV_NXO = (XAW / 64) * (DM / 64);
    constexpr int CV_E1 = CV_NGU + CV_NDN, CV_E2 = CV_E1 + CV_NNO, CV_E3 = CV_E2 + CV_NXQ, CV_ALL = CV_E3 + CV_NXO;
    int cv_it = DEFER_CONV ? F.bid * NWAVES + F.wv : CV_ALL;
#define NSA_CONV(maxn_) do { LAS unsigned* scr_ = (LAS unsigned*)(lds + F.wv * 8448); const int ln_c = otid() & 63; \
        _Pragma("unroll 1") for (int c_ = 0; c_ < (maxn_) && cv_it < CV_ALL; ++c_, cv_it += F.G * NWAVES) { \
            if (cv_it < CV_NGU) p0_transpose_item<1>(A.in[IN_FFN_WGU] + (size_t)DM * DFF2, DM, DFF2, (bf16_t*)(wsl + WS_WGU + (size_t)DFF2 * DM * 2), A.in[IN_LN_FFN] + (size_t)2 * DM, scr_, cv_it, ln_c); \
            else if (cv_it < CV_E1) p0_transpose_item<0>(A.in[IN_FFN_WDN] + (size_t)DFF * DM, DFF, DM, (bf16_t*)(wsl + WS_WDN + (size_t)DM * DFF * 2), nullptr, scr_, cv_it - CV_NGU, ln_c); \
            else if (cv_it < CV_E2) p0_transpose_item<0>(A.in[IN_NSA_W_OUT], QW, DM, (bf16_t*)(wsl + WS_NSAOUT), nullptr, scr_, cv_it - CV_E1, ln_c); \
            else if (cv_it < CV_E3) p0_transpose_item<0>(A.in[IN_XA_WQ] + (size_t)DM * XAW, DM, XAW, (bf16_t*)(wsl + WS_XAQ + (size_t)XAW * DM * 2), A.in[IN_LN_XA] + (size_t)2 * DM, scr_, cv_it - CV_E2, ln_c); \
            else p0_transpose_item<0>(A.in[IN_XA_WO] + (size_t)XAW * DM, XAW, DM, (bf16_t*)(wsl + WS_XAO + (size_t)DM * XAW * 2), nullptr, scr_, cv_it - CV_E3, ln_c); } } while (0)
    int it_ = 0;
    for (int u = F.bid; u < NUNITS; ) {
        const int tid = otid(), lane = tid & 63, r32 = lane & 31, hi = lane >> 5, wave = __builtin_amdgcn_readfirstlane(tid >> 6);
        if (tid == 0) NXT[it_ & 1] = F.G + (int)__hip_atomic_fetch_add(qctr, 1u, __ATOMIC_RELAXED, __HIP_MEMORY_SCOPE_AGENT);
        const int qb = NQB - 1 - u / (BATCH * NSA_G), bg = u % (BATCH * NSA_G), b = bg >> 2, g = bg & 3;
        const int t0 = qb * 32, tokl = 4 * wave + (r32 >> 3), j = r32 & 7, t = t0 + tokl, head = g * 8 + j;
        const float sl2 = __builtin_amdgcn_exp2f(-0.25f * (float)(head + 1)) * LOG2E;
        f32x16 o[4];
#pragma unroll
        for (int d0 = 0; d0 < 4; ++d0)
#pragma unroll
            for (int r = 0; r < 16; ++r) o[d0][r] = 0.f;
        const int tw0 = t0 + 4 * wave;
        NSEC_B(1);
        { const int jlo = (t0 - 511 > 0 ? t0 - 511 : 0) >> 6, jhi = (t0 + 31) >> 6, NTw = jhi - jlo + 1;
          const bf16_t* Kw = NKV + ((size_t)((((2 * 2 + 0) * 2 + b) * 4 + g)) * SEQ) * HD; const bf16_t* Vw = NKV + ((size_t)((((2 * 2 + 1) * 2 + b) * 4 + g)) * SEQ) * HD;
          float m = -1e30f, l = 0.f;
          att::attn_online<3, true>(lds, Kw, Vw, NTw, jlo * 64, qr, m, l, o, t, tw0, sl2, tokl, F.wv);
          att::prefetch_k(lds, KVC + (size_t)(bg * 512) * HD, 0, 0, F.wv);
          int tg_g_w = t; asm volatile("" : "+v"(tg_g_w)); const float g_w = *(const GAS float*)(GT + ((size_t)b * SEQ + tg_g_w) * GW_ + 64 + head); att::scale_rows(o, l > 0.f ? g_w / l : 0.f); }
        NSEC_E(1); NSEC_B(2);
        { const bf16_t* Kc = KVC + (size_t)(bg * 512) * HD; const bf16_t* Vc = KVC + (size_t)(4096 + bg * 512) * HD;
          const int NTc = t0 / 1024 + 1; float m = -1e30f, l = 0.f; int tg_g_c = t; asm volatile("" : "+v"(tg_g_c)); const float g_c = *(const GAS float*)(GT + ((size_t)b * SEQ + tg_g_c) * GW_ + head);
          const int p2 = NTc & 1;
          att::prefetch_v(lds, Vc, 0, p2, F.wv);
          att::attn_pass<1, 1, true, true>(lds, Kc, Vc, HD, NTc, 0, qr, m, l, g_c, 0.f, o, t, sl2, tokl, F.wv, 0);
          const float invl = l > 0.f ? 1.0f / l : 0.f;
          att::attn_pass<1, 2, true>(lds, Kc, Vc, HD, NTc, 0, qr, m, l, g_c, invl, o, t, sl2, tokl, F.wv, p2); }
        att::prefetch_k0(lds, NKV + ((size_t)((((1 * 2 + 0) * 2 + b) * 4 + g)) * SEQ) * HD, 0, F.wv);
        NSEC_E(2); NSEC_B(3);
        {
            unsigned wsel[4][4];
#pragma unroll
            for (int i4 = 0; i4 < 4; ++i4) {
                const int tk = 4 * wave + i4, cur = (t0 + tk) >> 6, n0 = lane, n1 = lane + 64;
                const int nlim = 16 * (t0 / 1024 + 1);
#define SGSLOT(n_) (((n_) & ~15) | (((((n_) >> 3) & 1) * 2 + ((n_) & 1)) << 2) | (((n_) >> 1) & 3))
                const float s0 = (n0 < nlim ? SG[tk * 128 + SGSLOT(n0)] : 0.f) + ((n0 > 0 && n0 <= nlim) ? SL[tk * 128 + SGSLOT(n0 - 1)] : 0.f), s1 = (n1 < nlim ? SG[tk * 128 + SGSLOT(n1)] : 0.f) + (n1 <= nlim ? SL[tk * 128 + SGSLOT(n1 - 1)] : 0.f);
#undef SGSLOT
                const float v0 = (n0 == 0 || n0 == cur || n0 == cur - 1) ? 1e6f : fmaxf(s0, 0.f), v1 = (n1 == cur || n1 == cur - 1) ? 1e6f : fmaxf(s1, 0.f);
                const unsigned k0 = n0 > cur ? 0u : __float_as_uint(v0) + 1u, k1 = n1 > cur ? 0u : __float_as_uint(v1) + 1u;
                unsigned T = 0u;
#pragma unroll
                for (int bit = 30; bit >= 0; --bit) { const unsigned cand = T | (1u << bit);
                    const int cnt = __builtin_popcountll(__ballot(k0 >= cand)) + __builtin_popcountll(__ballot(k1 >= cand));
                    T = cnt >= 16 ? cand : T; }
                unsigned long long g0 = __ballot(k0 > T), g1 = __ballot(k1 > T);
                unsigned long long q0 = T ? __ballot(k0 == T) : 0ull, q1 = T ? __ballot(k1 == T) : 0ull;
                int need = 16 - __builtin_popcountll(g0) - __builtin_popcountll(g1);
                while (need > 0 && q0) { const unsigned long long lb = q0 & (0ull - q0); g0 |= lb; q0 ^= lb; --need; }
                while (need > 0 && q1) { const unsigned long long lb = q1 & (0ull - q1); g1 |= lb; q1 ^= lb; --need; }
                wsel[i4][0] = (unsigned)g0; wsel[i4][1] = (unsigned)(g0 >> 32); wsel[i4][2] = (unsigned)g1; wsel[i4][3] = (unsigned)(g1 >> 32);
            }
            if (lane == 0) {
#pragma unroll
                for (int i4 = 0; i4 < 4; ++i4) { const int tk = 4 * wave + i4; SELW[tk * 4 + 0] = wsel[i4][0]; SELW[tk * 4 + 1] = wsel[i4][1]; SELW[tk * 4 + 2] = wsel[i4][2]; SELW[tk * 4 + 3] = wsel[i4][3]; }
#pragma unroll
                for (int q = 0; q < 4; ++q) WUN[wave * 4 + q] = wsel[0][q] | wsel[1][q] | wsel[2][q] | wsel[3][q];
            }
        }
        asm volatile("s_waitcnt lgkmcnt(0)" ::: "memory"); __builtin_amdgcn_s_barrier(); asm volatile("" ::: "memory");
        if (wave == 0) {
            unsigned u0 = 0u, u1 = 0u;
#pragma unroll
            for (int wv = 0; wv < 8; ++wv) { u0 |= (WUN[wv * 4 + (lane >> 5)] >> (lane & 31)) & 1u; u1 |= (WUN[wv * 4 + 2 + (lane >> 5)] >> (lane & 31)) & 1u; }
            const unsigned long long b0 = __ballot(u0 != 0u), b1 = __ballot(u1 != 0u), lt = (1ull << lane) - 1ull; const int c0 = __builtin_popcountll(b0);
            if (u0) TL[__builtin_popcountll(b0 & lt)] = lane;
            if (u1) TL[c0 + __builtin_popcountll(b1 & lt)] = 64 + lane;
            if (lane == 0) TL[128] = c0 + __builtin_popcountll(b1);
        }
        { const int ln_ = otid() & 63; u32x4* stash = (u32x4*)((float*)(wsl + WS_STASH) + ((size_t)(F.bid * NWAVES + wave) * 64) * 64) + ln_;
#pragma unroll
        for (int d0 = 0; d0 < 4; ++d0)
#pragma unroll
            for (int rp = 0; rp < 2; ++rp) { u32x4 w_; w_.x = cvtpk(o[d0][8 * rp], o[d0][8 * rp + 1]); w_.y = cvtpk(o[d0][8 * rp + 2], o[d0][8 * rp + 3]); w_.z = cvtpk(o[d0][8 * rp + 4], o[d0][8 * rp + 5]); w_.w = cvtpk(o[d0][8 * rp + 6], o[d0][8 * rp + 7]);
                *(GAS u32x4*)(stash + (d0 * 2 + rp) * 64) = w_;
#pragma unroll
                for (int r = 0; r < 8; ++r) o[d0][8 * rp + r] = 0.f; } }
        asm volatile("s_waitcnt lgkmcnt(0)" ::: "memory"); __builtin_amdgcn_s_barrier(); asm volatile("" ::: "memory");
        NSEC_E(3); NSEC_B(4);
        { const int NTs = TL[128]; if (TP_NSA_SEC == 9) tp_acc += (unsigned long long)NTs * 100ull; if (TP_NSA_SEC == 10) { const LAS unsigned* SW_ = (const LAS unsigned*)(lds + att::SELW_OFF); int na_ = 0; for (int i_ = 0; i_ < NTs; ++i_) { const int n_ = ((const LAS int*)(lds + att::TL_OFF))[i_]; unsigned any_ = 0u; for (int k_ = 0; k_ < 4; ++k_) any_ |= (SW_[(4 * wave + k_) * 4 + (n_ >> 5)] >> (n_ & 31)) & 1u; na_ += (int)any_; } tp_acc += (unsigned long long)na_ * 100ull; } const bf16_t* Ks = NKV + ((size_t)((((1 * 2 + 0) * 2 + b) * 4 + g)) * SEQ) * HD; const bf16_t* Vs = NKV + ((size_t)((((1 * 2 + 1) * 2 + b) * 4 + g)) * SEQ) * HD;
          float m = -1e30f, l = 0.f;
          att::attn_online<2, true>(lds, Ks, Vs, NTs, 0, qr, m, l, o, t, tw0, sl2, tokl, F.wv);
          int tg_g_s = t; asm volatile("" : "+v"(tg_g_s)); const float g_s = *(const GAS float*)(GT + ((size_t)b * SEQ + tg_g_s) * GW_ + 32 + head); att::scale_rows(o, l > 0.f ? g_s / l : 0.f); }
        NSEC_E(4);
        if (DEFER_CONV) { NSA_CONV(3); __syncthreads(); }
        const int un = __builtin_amdgcn_readfirstlane(NXT[it_ & 1]);
        if (un < NUNITS) NSA_SEAM(un);
        { const int ln_ = otid() & 63, r32 = ln_ & 31, hi = ln_ >> 5; const u32x4* stash = (const u32x4*)((const float*)(wsl + WS_STASH) + ((size_t)(F.bid * NWAVES + wave) * 64) * 64) + ln_;
#pragma unroll
        for (int d0 = 0; d0 < 4; ++d0)
#pragma unroll
            for (int rp = 0; rp < 2; ++rp) { const u32x4 w_ = *(const GAS u32x4*)(stash + (d0 * 2 + rp) * 64);
                o[d0][8 * rp + 0] += __uint_as_float(w_.x << 16); o[d0][8 * rp + 1] += __uint_as_float(w_.x & 0xffff0000u); o[d0][8 * rp + 2] += __uint_as_float(w_.y << 16); o[d0][8 * rp + 3] += __uint_as_float(w_.y & 0xffff0000u);
                o[d0][8 * rp + 4] += __uint_as_float(w_.z << 16); o[d0][8 * rp + 5] += __uint_as_float(w_.z & 0xffff0000u); o[d0][8 * rp + 6] += __uint_as_float(w_.w << 16); o[d0][8 * rp + 7] += __uint_as_float(w_.w & 0xffff0000u); }
        ATT_STORE_O(NO + ((size_t)b * SEQ + t0 + 4 * wave + (r32 >> 3)) * QW + (g * 8 + (r32 & 7)) * HD); }
        u = un; ++it_;
    }
    if (DEFER_CONV) { __syncthreads(); NSA_CONV(1 << 30); }
#undef NSA_CONV
}

constexpr int NPH = 30;
#ifndef HALFM
#define HALFM 1
#endif
__global__ void __launch_bounds__(NTHR, 2) mk_fwd(Args args) {
    extern __shared__ __attribute__((aligned(16))) unsigned char lds_raw[];
    Frame F;
    F.lds = (LAS unsigned char*)lds_raw;
    F.MISC = (volatile LAS unsigned*)(F.lds + MISC_OFF);
    F.wv = __builtin_amdgcn_readfirstlane((int)threadIdx.x >> 6);
    F.G = gridDim.x; F.bid = blockIdx.x; F.ws = args.ws; F.out = args.out;
    F.ctl = (unsigned*)(args.ws + WS_CTL);
    for (int u = threadIdx.x; u < (LDS_BYTES - LDSCTL_OFF) / 4; u += NTHR) ((LAS unsigned*)(F.lds + LDSCTL_OFF))[u] = 0u;
    __syncthreads();
    const int lo = args.ph_lo, hi = args.ph_hi;
    XcdBarrier bar; bar.bar = F.ctl + CW_BAR; bar.x = 0; bar.st = nullptr;
    if (hi - lo > 1) bar = xcd_barrier_post(F.ctl + CW_BAR, F.MISC + 8);
#ifndef PH_MASK
#define PH_MASK 0xffffffffu
#endif
#define EN(i) ((PH_MASK >> (i)) & 1u)
#ifndef REP_MASK
#define REP_MASK 0u
#endif
#define REPS(i) (1 + (int)((REP_MASK >> (i)) & 1u))
#define IN(k) (lo <= (k) && (k) < hi)
#ifndef TP_MODE
#define TP_MODE 0
#endif
#ifndef TP_AMP
#define TP_AMP 3
#endif
    unsigned long long tp_acc = 0ull, tp_t0 = 0ull;
#ifndef TP_MASK
#define TP_MASK 0u
#endif
#define TPS(i) ((TP_MASK >> (i)) & 1u)
#define TP_BEGIN(mode) do { if (TP_MODE == (mode)) tp_t0 = __builtin_amdgcn_s_memrealtime(); } while (0)
#define TP_END(mode) do { if (TP_MODE == (mode)) tp_acc += __builtin_amdgcn_s_memrealtime() - tp_t0; } while (0)
#define HN ((bf16_t*)(ws + WS_HN))
#define Yb ((bf16_t*)(ws + WS_Y))
#define SSP ((float*)(ws + WS_SSP))
#define SEAM(k) do { if ((k) + 1 < hi) { TP_BEGIN(1); xcd_barrier(bar); TP_END(1); } } while (0)
    unsigned char* const ws_k = args.ws;

    if (EN(0) && IN(0)) { if (TPS(0)) tp_t0 = __builtin_amdgcn_s_memrealtime(); for (int rep_ = 0; rep_ < REPS(0); ++rep_) { phase_p0(F, args); } if (TPS(0)) tp_acc += __builtin_amdgcn_s_memrealtime() - tp_t0; SEAM(0); }
    if (EN(1) && IN(1)) { if (TPS(1)) tp_t0 = __builtin_amdgcn_s_memrealtime();
        _Pragma("unroll 1") for (int rep_ = 0; rep_ < REPS(1); ++rep_) { unsigned char* const ws = optr(ws_k);
        phase_poolprep(F, args);
        }
        if (TPS(1)) tp_acc += __builtin_amdgcn_s_memrealtime() - tp_t0;
        SEAM(1);
    }
#pragma unroll 1
    for (int L = 0; L < 2; ++L) {
        const int pb = 2 + 14 * L;
        const float* ln_mix = args.in[IN_LN_MIX] + (size_t)L * 2 * DM; const float* ln_xa = args.in[IN_LN_XA] + (size_t)L * 2 * DM; const float* ln_ffn = args.in[IN_LN_FFN] + (size_t)L * 2 * DM;
        if (L == 0) {
            if (EN(2) && IN(pb)) { if (TPS(2)) tp_t0 = __builtin_amdgcn_s_memrealtime();
                _Pragma("unroll 1") for (int rep_ = 0; rep_ < REPS(2); ++rep_) { unsigned char* const ws = optr(ws_k);
                pg8::Gemm g{HN, (const bf16_t*)(ws + WS_POOLW), DM, PGC, 4, (size_t)PGC}; pg8::PanelOrder S; S.init(F.G, F.bid);
                pg8::EpiY E{Yb, DM, args.in[IN_POOL_SCALE], SSP, 64};
                pg8::gemm_phase<pg8::EpiY, pg8::PanelOrder>(F.lds, g, S, E, F.wv);
                }
                if (TPS(2)) tp_acc += __builtin_amdgcn_s_memrealtime() - tp_t0;
                SEAM(pb);
            }
        } else {
            if (EN(3) && IN(pb)) { if (TPS(3)) tp_t0 = __builtin_amdgcn_s_memrealtime();
                _Pragma("unroll 1") for (int rep_ = 0; rep_ < REPS(3); ++rep_) { unsigned char* const ws = optr(ws_k);
                pg8::Gemm g{HN, (const bf16_t*)(ws + WS_NSAIN), DM, DM, 0, 0}; pg8::StaticOrder S; S.init(MTOK, QW + KVW, F.G, F.bid);
                pg8::EpiNsaIn E{(bf16_t*)(ws + WS_NQ), (bf16_t*)(ws + WS_NKV), (const float*)(ws + WS_RS)};
                pg8::gemm_phase<pg8::EpiNsaIn>(F.lds, g, S, E, F.wv);
                }
                if (TPS(3)) tp_acc += __builtin_amdgcn_s_memrealtime() - tp_t0;
                SEAM(pb);
            }
            if (EN(4) && IN(pb + 1)) { if (TPS(4)) tp_t0 = __builtin_amdgcn_s_memrealtime();
                _Pragma("unroll 1") for (int rep_ = 0; rep_ < REPS(4); ++rep_) { unsigned char* const ws = optr(ws_k);
#if HALFM
                if (F.G >= 256) {
                    pg8::Gemm g{(const bf16_t*)(ws + WS_NKV), (const bf16_t*)(ws + WS_CMPW1), 2048, 4096, 2, (size_t)8 * SEQ * HD}; pg8::HalfOrder S; S.init(4096, 2 * CMP_HID, F.bid);
                    pg8::EpiGeluT<true> E{(bf16_t*)(ws + WS_HID), CMP_HID, (const float*)(ws + WS_CMPB), CMP_HID, (size_t)4096 * CMP_HID};
                    pg8::gemm_phase<pg8::EpiGeluT<true>, pg8::HalfOrder, true, true, true>(F.lds, g, S, E, F.wv);
                    pg8::Gemm g2{HN, (const bf16_t*)(ws + WS_NSAIN) + (size_t)(QW + KVW) * DM, DM, DM, 0, 0}; pg8::HalfOrder S2; S2.init(MTOK, 256, F.bid - 128);
                    pg8::EpiGatesT<true> E2{(float*)(ws + WS_GATES), (const float*)(ws + WS_RS)};
                    pg8::gemm_phase<pg8::EpiGatesT<true>, pg8::HalfOrder, true, true, true>(F.lds, g2, S2, E2, F.wv);
                } else
#endif
                {
                pg8::Gemm g{(const bf16_t*)(ws + WS_NKV), (const bf16_t*)(ws + WS_CMPW1), 2048, 4096, 2, (size_t)8 * SEQ * HD}; pg8::StaticOrder S; S.init(4096, 2 * CMP_HID, F.G, F.bid);
                pg8::EpiGelu E{(bf16_t*)(ws + WS_HID), CMP_HID, (const float*)(ws + WS_CMPB), CMP_HID, (size_t)4096 * CMP_HID};
                pg8::gemm_phase<pg8::EpiGelu>(F.lds, g, S, E, F.wv);
                }
                if (F.bid >= 64 && (!HALFM || F.G < 256)) {
                    pg8::Gemm g2{HN, (const bf16_t*)(ws + WS_NSAIN) + (size_t)(QW + KVW) * DM, DM, DM, 0, 0}; pg8::StaticOrder S2; S2.init(MTOK, 256, F.G, F.bid - 64);
                    pg8::EpiGates E2{(float*)(ws + WS_GATES), (const float*)(ws + WS_RS)};
                    pg8::gemm_phase<pg8::EpiGates>(F.lds, g2, S2, E2, F.wv);
                }
                }
                if (TPS(4)) tp_acc += __builtin_amdgcn_s_memrealtime() - tp_t0;
                SEAM(pb + 1);
            }
            if (EN(5) && IN(pb + 2)) { if (TPS(5)) tp_t0 = __builtin_amdgcn_s_memrealtime(); _Pragma("unroll 1") for (int rep_ = 0; rep_ < REPS(5); ++rep_) { unsigned char* const ws = optr(ws_k);
                pg8::Gemm g{(const bf16_t*)(ws + WS_HID), (const bf16_t*)(ws + WS_CMPW2), CMP_HID, CMP_HID, 1, (size_t)4096 * CMP_HID}; pg8::StaticOrder S; S.init(4096, 512, F.G, F.bid);
                pg8::EpiKvc E{(bf16_t*)(ws + WS_KVC)};
                pg8::gemm_phase<pg8::EpiKvc>(F.lds, g, S, E, F.wv); } if (TPS(5)) tp_acc += __builtin_amdgcn_s_memrealtime() - tp_t0; SEAM(pb + 2); }
            if (EN(6) && IN(pb + 3)) { if (TPS(6)) tp_t0 = __builtin_amdgcn_s_memrealtime(); for (int rep_ = 0; rep_ < REPS(6); ++rep_) { phase_nsa(F, tp_acc, args); } if (TPS(6)) tp_acc += __builtin_amdgcn_s_memrealtime() - tp_t0; SEAM(pb + 3); }
            if (EN(7) && IN(pb + 4)) { if (TPS(7)) tp_t0 = __builtin_amdgcn_s_memrealtime();
                _Pragma("unroll 1") for (int rep_ = 0; rep_ < REPS(7); ++rep_) { unsigned char* const ws = optr(ws_k);
                pg8::Gemm g{(const bf16_t*)(ws + WS_NO), (const bf16_t*)(ws + WS_NSAOUT), QW, QW, 0, 0}; pg8::PanelOrder S; S.init(F.G, F.bid);
                pg8::EpiY E{Yb, DM, nullptr, SSP, 64};
                pg8::gemm_phase<pg8::EpiY, pg8::PanelOrder>(F.lds, g, S, E, F.wv);
                }
                if (TPS(7)) tp_acc += __builtin_amdgcn_s_memrealtime() - tp_t0;
                SEAM(pb + 4);
            }
        }
        if (EN(8) && IN(pb + 5)) { if (TPS(8)) tp_t0 = __builtin_amdgcn_s_memrealtime(); for (int rep_ = 0; rep_ < REPS(8); ++rep_) { if (L == 0) phase_resid<true, false>(F, args.in[IN_X], ln_mix + DM); else phase_resid<false, false>(F, nullptr, ln_mix + DM); } if (TPS(8)) tp_acc += __builtin_amdgcn_s_memrealtime() - tp_t0; SEAM(pb + 5); }
        if (EN(9) && IN(pb + 6)) { if (TPS(9)) tp_t0 = __builtin_amdgcn_s_memrealtime();
            _Pragma("unroll 1") for (int rep_ = 0; rep_ < REPS(9); ++rep_) { unsigned char* const ws = optr(ws_k);
#if HALFM
            if (L == 1 && F.G >= 256) {
                pg8::Gemm g{HN, (const bf16_t*)(ws + WS_XAQ) + (size_t)L * XAW * DM, DM, DM, 0, 0}; pg8::HalfOrder S; S.init(MTOK, XAW, F.bid);
                pg8::EpiPlainT<true> E{(bf16_t*)(ws + WS_QX), XAW, 0, 0, (const float*)(ws + WS_RS)};
                pg8::gemm_phase<pg8::EpiPlainT<true>, pg8::HalfOrder, true, true, true>(F.lds, g, S, E, F.wv);
            } else
#endif
            {
            pg8::Gemm g{HN, (const bf16_t*)(ws + WS_XAQ) + (size_t)L * XAW * DM, DM, DM, 0, 0}; pg8::StaticOrder S; S.init(MTOK, XAW, F.G, F.bid);
            pg8::EpiPlain E{(bf16_t*)(ws + WS_QX), XAW, 0, 0, (const float*)(ws + WS_RS)};
            pg8::gemm_phase<pg8::EpiPlain>(F.lds, g, S, E, F.wv);
            }
            if (L == 0) {
                if (F.bid >= 128) {
                    pg8::Gemm g2{(const bf16_t*)(ws + WS_MEMN), (const bf16_t*)(ws + WS_XAKV), DM, DM, 0, 0}; pg8::StaticOrder S2; S2.init(MMEM, 2 * 2 * XAW, F.G, F.bid - 128);
                    pg8::EpiPlain E2{(bf16_t*)(ws + WS_KVMEM), 2 * XAW, 2 * XAW, (size_t)MMEM * 2 * XAW, nullptr};
                    pg8::gemm_phase<pg8::EpiPlain>(F.lds, g2, S2, E2, F.wv);
                }
                const int idx = (F.bid - 160) * NTHR + otid();
                if (idx >= 0 && idx < 2 * CMP_HID) { const float* part = (const float*)(ws + WS_CMPB + 65536); float sacc = args.in[IN_CMP_B1][idx];
                    for (int ks = 0; ks < 16; ++ks) sacc += part[((idx >> 9) * 16 + ks) * CMP_HID + (idx & 511)];
                    ((float*)(ws + WS_CMPB))[idx] = sacc; }
                if (XQFILL && F.G == 256 && F.bid >= 144) {
                    LAS unsigned* scr = (LAS unsigned*)(F.lds + F.wv * 8448); const int lane_ = otid() & 63;
                    _Pragma("unroll 1") for (int it = ((int)F.bid - 144) * NWAVES + F.wv; it < XQF_N; it += 112 * NWAVES)
                        p0_transpose_item<1>(args.in[IN_FFN_WGU], DM, DFF2, (bf16_t*)(ws + WS_WGU), args.in[IN_LN_FFN], scr, it, lane_); }
            }
            }
            if (TPS(9)) tp_acc += __builtin_amdgcn_s_memrealtime() - tp_t0;
            SEAM(pb + 6);
        }
        if (EN(10) && IN(pb + 7)) { if (TPS(10)) tp_t0 = __builtin_amdgcn_s_memrealtime(); for (int rep_ = 0; rep_ < REPS(10); ++rep_) { phase_xattn(F, L); } if (TPS(10)) tp_acc += __builtin_amdgcn_s_memrealtime() - tp_t0; SEAM(pb + 7); }
        if (EN(11) && IN(pb + 8)) { if (TPS(11)) tp_t0 = __builtin_amdgcn_s_memrealtime();
            _Pragma("unroll 1") for (int rep_ = 0; rep_ < REPS(11); ++rep_) { unsigned char* const ws = optr(ws_k);
            pg8::Gemm g{(const bf16_t*)(ws + WS_OX), (const bf16_t*)(ws + WS_XAO) + (size_t)L * DM * XAW, XAW, XAW, 0, 0}; pg8::PanelOrder S; S.init(F.G, F.bid);
            pg8::EpiY E{Yb, DM, nullptr, SSP, 64};
            pg8::gemm_phase<pg8::EpiY, pg8::PanelOrder>(F.lds, g, S, E, F.wv);
            }
            if (TPS(11)) tp_acc += __builtin_amdgcn_s_memrealtime() - tp_t0;
            SEAM(pb + 8);
        }
        if (EN(12) && IN(pb + 9)) { if (TPS(12)) tp_t0 = __builtin_amdgcn_s_memrealtime(); for (int rep_ = 0; rep_ < REPS(12); ++rep_) { phase_resid<false, false>(F, nullptr, ln_xa + DM); } if (TPS(12)) tp_acc += __builtin_amdgcn_s_memrealtime() - tp_t0; SEAM(pb + 9); }
        if (EN(13) && IN(pb + 10)) { if (TPS(13)) tp_t0 = __builtin_amdgcn_s_memrealtime();
            _Pragma("unroll 1") for (int rep_ = 0; rep_ < REPS(13); ++rep_) { unsigned char* const ws = optr(ws_k);
            pg8::Gemm g{HN, (const bf16_t*)(ws + WS_WGU) + (size_t)L * DFF2 * DM, DM, DM, 0, 0}; pg8::StaticOrder S; S.init(MTOK, DFF2, F.G, F.bid);
            pg8::EpiGateUp E{(bf16_t*)(ws + WS_ACT), args.in[IN_FFN_CONVW] + (size_t)L * 3 * DFF, args.in[IN_FFN_CONVB] + (size_t)L * DFF, (float*)(ws + WS_HALO), (float*)(ws + WS_EDGE), F.lds, (const float*)(ws + WS_RS)};
            pg8::gemm_phase<pg8::EpiGateUp>(F.lds, g, S, E, F.wv);
            if (TAILFILL) {
                const int nb0 = (F.G == 256) ? 128 : 0, nbk = F.G - nb0;
                if ((int)F.bid >= nb0) { LAS unsigned* scr = (LAS unsigned*)(F.lds + F.wv * 8448); const int lane_ = otid() & 63;
                    _Pragma("unroll 1") for (int it = ((int)F.bid - nb0) * NWAVES + F.wv; it < (DFF / 64) * (DM / 64); it += nbk * NWAVES)
                        p0_transpose_item<0>(args.in[IN_FFN_WDN] + (size_t)L * DFF * DM, DFF, DM, (bf16_t*)(ws + WS_WDN + (size_t)L * DM * DFF * 2), nullptr, scr, it, lane_); } }
            }
            if (TPS(13)) tp_acc += __builtin_amdgcn_s_memrealtime() - tp_t0;
            SEAM(pb + 10);
        }
        if (EN(14) && IN(pb + 11)) { if (TPS(14)) tp_t0 = __builtin_amdgcn_s_memrealtime(); for (int rep_ = 0; rep_ < REPS(14); ++rep_) { phase_actfix(F, args.in[IN_FFN_CONVW] + (size_t)L * 3 * DFF, args.in[IN_FFN_CONVB] + (size_t)L * DFF); } if (TPS(14)) tp_acc += __builtin_amdgcn_s_memrealtime() - tp_t0; SEAM(pb + 11); }
        if (EN(15) && IN(pb + 12)) { if (TPS(15)) tp_t0 = __builtin_amdgcn_s_memrealtime();
            _Pragma("unroll 1") for (int rep_ = 0; rep_ < REPS(15); ++rep_) { unsigned char* const ws = optr(ws_k);
            pg8::Gemm g{(const bf16_t*)(ws + WS_ACT), (const bf16_t*)(ws + WS_WDN) + (size_t)L * DM * DFF, DFF, DFF, 0, 0}; pg8::PanelOrder S; S.init(F.G, F.bid);
            pg8::EpiY E{Yb, DM, nullptr, SSP, 64};
            pg8::gemm_phase<pg8::EpiY, pg8::PanelOrder>(F.lds, g, S, E, F.wv);
            }
            if (TPS(15)) tp_acc += __builtin_amdgcn_s_memrealtime() - tp_t0;
            SEAM(pb + 12);
        }
        if (EN(16) && IN(pb + 13)) { if (TPS(16)) tp_t0 = __builtin_amdgcn_s_memrealtime(); for (int rep_ = 0; rep_ < REPS(16); ++rep_) { if (L == 0) phase_resid<false, false>(F, nullptr, ln_ffn + DM); else phase_resid<false, true>(F, nullptr, ln_ffn + DM); } if (TPS(16)) tp_acc += __builtin_amdgcn_s_memrealtime() - tp_t0; SEAM(pb + 13); }
    }
    if ((TP_MODE != 0 || TP_MASK != 0u || TP_NSA_SEC != 0) && blockIdx.x == 0) { const unsigned long long t1 = __builtin_amdgcn_s_memrealtime(); while (__builtin_amdgcn_s_memrealtime() - t1 < (unsigned long long)TP_AMP * tp_acc) __builtin_amdgcn_s_sleep(8); }
#undef HN
#undef Yb
#undef SSP
#undef IN
#undef EN
#undef SEAM
}

extern "C" void kernel_launch(void* const* d_in, const int* in_sizes, int n_in, void* d_out, int out_size, void* d_ws, size_t ws_size, hipStream_t stream) {
    static int grid = 0;
    if (grid == 0) {
        if (n_in != 21 || in_sizes[0] != MTOK * DM || out_size != MTOK * DM || ws_size < WS_END) {
            fprintf(stderr, "kernel_launch: unexpected shapes (n_in %d, in0 %d, out %d, ws %zu; need ws >= %zu); nothing launched\n", n_in, n_in > 0 ? in_sizes[0] : -1, out_size, ws_size, (size_t)WS_END); grid = -1; return; }
        int dev = 0, cus = 0, per_cu = 0;
        if (hipGetDevice(&dev) != hipSuccess || hipDeviceGetAttribute(&cus, hipDeviceAttributeMultiprocessorCount, dev) != hipSuccess) { fprintf(stderr, "kernel_launch: device query failed\n"); grid = -1; return; }
        if (hipFuncSetAttribute((const void*)mk_fwd, hipFuncAttributeMaxDynamicSharedMemorySize, LDS_BYTES) != hipSuccess) { fprintf(stderr, "kernel_launch: hipFuncSetAttribute failed\n"); grid = -1; return; }
        if (hipOccupancyMaxActiveBlocksPerMultiprocessor(&per_cu, (const void*)mk_fwd, NTHR, LDS_BYTES) != hipSuccess || per_cu < 1)
            fprintf(stderr, "kernel_launch: note: occupancy query reports %d workgroups per CU\n", per_cu);
        (void)hipGetLastError();
        grid = cus;
    }
    if (grid < 0) return;
    if (hipMemsetAsync((char*)d_ws + WS_CTL, 0, CTL_ZERO_BYTES, stream) != hipSuccess) { fprintf(stderr, "kernel_launch: memset failed\n"); return; }
    Args a{};
    for (int i = 0; i < 21; ++i) a.in[i] = (const float*)d_in[i];
    a.out = (float*)d_out; a.ws = (unsigned char*)d_ws;
#if MK_N_LAUNCHES == 1
    a.ph_lo = 0; a.ph_hi = NPH;
    hipLaunchKernelGGL(mk_fwd, dim3(grid), dim3(NTHR), LDS_BYTES, stream, a);
#else
    for (int ph = 0; ph < NPH; ++ph) {
        if (ph >= 3 && ph <= 6) continue;
        a.ph_lo = ph; a.ph_hi = ph + 1;
        hipLaunchKernelGGL(mk_fwd, dim3(grid), dim3(NTHR), LDS_BYTES, stream, a);
    }
#endif
    const hipError_t le = hipPeekAtLastError();
    if (le != hipSuccess) fprintf(stderr, "kernel_launch: launch failed: %s\n", hipGetErrorName(le));
}
```
